# Optimizing an MI355X kernel written in HIP

```python
import math
import jax, jax.numpy as jnp
from jax import lax
import numpy as np

D_MODEL = 2048
BATCH = 4
SEQ = 8192
DEPTH = 1

D_MIX = D_MODEL
ATT_WIDTH = D_MIX // 2
ATT_HEADS = 16
ATT_HEAD_DIM = ATT_WIDTH // ATT_HEADS
DILATED_PATTERNS = ((128, 1), (512, 4), (2048, 16))
GLA_WIDTH = D_MIX - ATT_WIDTH
GLA_HEADS = 4
GLA_KEY_WIDTH = GLA_WIDTH // 2
GLA_DK = GLA_KEY_WIDTH // GLA_HEADS
GLA_DV = GLA_WIDTH // GLA_HEADS
GLA_GATE_RANK = 16
GLA_GATE_NORM = 16.0
GLA_CHUNK = 64
REL_BUCKETS = 32
REL_MAX_DIST = 1024
EPS = 1e-6
NEG_INF = -1e30

PROJ_SIZES = (ATT_WIDTH, ATT_WIDTH, ATT_WIDTH, ATT_WIDTH,
              GLA_KEY_WIDTH, GLA_KEY_WIDTH, GLA_WIDTH, GLA_WIDTH,
              GLA_GATE_RANK, GLA_GATE_RANK)
PROJ_COLS = int(sum(PROJ_SIZES))
PROJ_SPLITS = [int(s) for s in np.cumsum(PROJ_SIZES)[:-1]]

kernel_name = "hybrid_dilated_attn_gla_block"


def rms_norm(x):
    xf = x.astype(jnp.float32)
    return (xf * lax.rsqrt(jnp.mean(xf * xf, axis=-1, keepdims=True) + EPS)).astype(x.dtype)


def t5_bucket_np(rel):
    nb = REL_BUCKETS // 2
    max_exact = nb // 2
    n = np.abs(rel)
    large = max_exact + (np.log(np.maximum(n, 1) / max_exact)
                         / np.log(REL_MAX_DIST / max_exact) * (nb - max_exact)).astype(np.int32)
    large = np.minimum(large, nb - 1)
    return (np.where(rel > 0, nb, 0) + np.where(n < max_exact, n, large)).astype(np.int32)


def dilated_window_attention(q, k, v, rel_bias, window, dilation):
    B, S, H, E = q.shape
    w = window // (2 * dilation)
    L = S // dilation
    nb = -(-L // w)
    Lp = nb * w

    def residue_layout(t, pad_lo, pad_hi):
        t = t.reshape(B, L, dilation, H, E)
        return jnp.pad(t, ((0, 0), (pad_lo, pad_hi), (0, 0), (0, 0), (0, 0)))

    qb = residue_layout(q, 0, Lp - L).reshape(B, nb, w, dilation, H, E)

    def key_windows(t):
        tb = residue_layout(t, w, Lp - L + w).reshape(B, nb + 2, w, dilation, H, E)
        return jnp.concatenate([tb[:, :-2], tb[:, 1:-1], tb[:, 2:]], axis=2)

    kw = key_windows(k)
    vw = key_windows(v)
    s = jnp.einsum('bnqrhe,bnkrhe->bhrnqk', qb, kw).astype(jnp.float32) * (E ** -0.5)

    qi = np.arange(w)[:, None]
    kj = np.arange(3 * w)[None, :]
    step = kj - w - qi
    in_window = np.abs(step) <= w
    bucket = t5_bucket_np(step * dilation)
    kpos = np.arange(nb)[:, None] * w + np.arange(3 * w)[None, :] - w
    key_ok = (kpos >= 0) & (kpos < L)
    mask = in_window[None] & key_ok[:, None, :]

    bias = jnp.transpose(rel_bias[bucket], (2, 0, 1)).astype(jnp.float32)
    s = s + bias[None, :, None, None]
    s = jnp.where(mask, s, NEG_INF)
    m = jnp.max(s, axis=-1, keepdims=True)
    p = jnp.exp(s - m)
    den = jnp.sum(p, axis=-1, keepdims=True)
    o = jnp.einsum('bhrnqk,bnkrhe->bhrnqe', (p / den).astype(v.dtype), vw)
    lse = (m + jnp.log(den))[..., 0]
    o = o.transpose(0, 3, 4, 2, 1, 5).reshape(B, Lp, dilation, H, E)[:, :L].reshape(B, S, H, E)
    lse = lse.transpose(0, 3, 4, 2, 1).reshape(B, Lp, dilation, H)[:, :L].reshape(B, S, H)
    return o, lse


def gla_chunked(q, k, v, log_g):
    B, S, H, dk = q.shape
    dv = v.shape[-1]
    C = GLA_CHUNK
    N = S // C

    def chunks(t):
        return t.reshape(B, N, C, H, t.shape[-1]).transpose(0, 3, 1, 2, 4)

    q, k, v, log_g = chunks(q), chunks(k), chunks(v), chunks(log_g)
    b = jnp.cumsum(log_g.astype(jnp.float32), axis=3)
    b_last = b[:, :, :, -1:]
    qf = q.astype(jnp.float32) * jnp.exp(b) * (dk ** -0.5)
    kf = k.astype(jnp.float32)
    vf = v.astype(jnp.float32)
    causal = np.tril(np.ones((C, C), dtype=bool))
    att = jnp.einsum('bhnid,bhnjd->bhnij', qf, kf * jnp.exp(-b))
    att = jnp.where(causal, att, 0.0)
    o_intra = jnp.einsum('bhnij,bhnjv->bhniv', att, vf)
    kv = jnp.einsum('bhnjd,bhnjv->bhndv', kf * jnp.exp(b_last - b), vf)
    decay = jnp.exp(b_last[:, :, :, 0])

    def step(state, inp):
        kv_n, g_n = inp
        return g_n[..., None] * state + kv_n, state

    init = jnp.zeros((B, H, dk, dv), jnp.float32)
    _, states = lax.scan(step, init, (jnp.moveaxis(kv, 2, 0), jnp.moveaxis(decay, 2, 0)))
    states = jnp.moveaxis(states, 0, 2)
    o = o_intra + jnp.einsum('bhnid,bhndv->bhniv', qf, states)
    return o.transpose(0, 2, 3, 1, 4).reshape(B, S, H, dv).astype(v.dtype)


def setup_inputs(seed: int = 0) -> dict:
    key = jax.random.key(seed)
    ks = jax.random.split(key, 14)
    f32 = jnp.float32
    x = jax.random.normal(ks[0], (BATCH, SEQ, D_MODEL), f32)
    c = jax.random.normal(ks[1], (BATCH, D_MODEL), f32)
    w_cond = jax.random.normal(ks[2], (DEPTH, D_MODEL, 3 * D_MODEL), f32) * (0.5 * D_MODEL ** -0.5)
    b_cond = jax.random.normal(ks[3], (DEPTH, 3 * D_MODEL), f32) * 0.02
    w_in = jax.random.normal(ks[4], (DEPTH, D_MODEL, PROJ_COLS), f32) * (D_MODEL ** -0.5)
    gla_gate_up_fwd = jax.random.normal(ks[5], (DEPTH, GLA_GATE_RANK, GLA_KEY_WIDTH), f32) * (GLA_GATE_RANK ** -0.5)
    gla_gate_bias_fwd = jax.random.normal(ks[6], (DEPTH, GLA_KEY_WIDTH), f32) * 0.01
    gla_gate_up_bwd = jax.random.normal(ks[7], (DEPTH, GLA_GATE_RANK, GLA_KEY_WIDTH), f32) * (GLA_GATE_RANK ** -0.5)
    gla_gate_bias_bwd = jax.random.normal(ks[8], (DEPTH, GLA_KEY_WIDTH), f32) * 0.01
    gla_norm_gain = 1.0 + 0.02 * jax.random.normal(ks[9], (DEPTH, GLA_WIDTH), f32)
    rel_bias = jax.random.normal(ks[10], (REL_BUCKETS, ATT_HEADS), f32) * 0.5
    w_out = jax.random.normal(ks[11], (DEPTH, D_MIX, D_MODEL), f32) * (D_MIX ** -0.5)
    final_gain = 1.0 + 0.02 * jax.random.normal(ks[12], (D_MODEL,), f32)
    return {"x": x, "c": c, "w_cond": w_cond, "b_cond": b_cond, "w_in": w_in,
            "gla_gate_up_fwd": gla_gate_up_fwd, "gla_gate_bias_fwd": gla_gate_bias_fwd,
            "gla_gate_up_bwd": gla_gate_up_bwd, "gla_gate_bias_bwd": gla_gate_bias_bwd,
            "gla_norm_gain": gla_norm_gain, "rel_bias": rel_bias, "w_out": w_out,
            "final_gain": final_gain}


def reference(x, c, w_cond, b_cond, w_in, gla_gate_up_fwd, gla_gate_bias_fwd,
              gla_gate_up_bwd, gla_gate_bias_bwd, gla_norm_gain, rel_bias, w_out, final_gain):
    B, S, _ = x.shape
    for layer in range(DEPTH):
        mod = jax.nn.silu(c) @ w_cond[layer] + b_cond[layer]
        shift, scale, gate = jnp.split(mod, 3, axis=-1)
        h = rms_norm(x) * (1.0 + scale[:, None]) + shift[:, None]

        proj = h @ w_in[layer]
        aq, ak, av, ag, gq, gk, gv, gg, lr_f, lr_b = jnp.split(proj, PROJ_SPLITS, axis=-1)

        hs = (B, S, ATT_HEADS, ATT_HEAD_DIM)
        aq, ak, av = aq.reshape(hs), ak.reshape(hs), av.reshape(hs)
        outs, lses = [], []
        for window, dilation in DILATED_PATTERNS:
            o_p, lse_p = dilated_window_attention(aq, ak, av, rel_bias, window, dilation)
            outs.append(o_p)
            lses.append(lse_p)
        mix_w = jax.nn.softmax(jnp.stack(lses, axis=0), axis=0)
        att = jnp.einsum('pbsh,pbshe->bshe', mix_w.astype(av.dtype), jnp.stack(outs, axis=0))
        a_out = att.reshape(B, S, ATT_WIDTH) * jax.nn.silu(ag)

        ks_ = (B, S, GLA_HEADS, GLA_DK)
        gq, gk = gq.reshape(ks_), gk.reshape(ks_)
        gv = gv.reshape(B, S, GLA_HEADS, GLA_DV)
        log_g_f = (jax.nn.log_sigmoid((lr_f @ gla_gate_up_fwd[layer] + gla_gate_bias_fwd[layer]).astype(jnp.float32))
                   / GLA_GATE_NORM).reshape(ks_)
        log_g_b = (jax.nn.log_sigmoid((lr_b @ gla_gate_up_bwd[layer] + gla_gate_bias_bwd[layer]).astype(jnp.float32))
                   / GLA_GATE_NORM).reshape(ks_)
        o_fwd = gla_chunked(gq, gk, gv, log_g_f)
        o_bwd = jnp.flip(gla_chunked(jnp.flip(gq, 1), jnp.flip(gk, 1), jnp.flip(gv, 1),
                                     jnp.flip(log_g_b, 1)), 1)
        g_o = rms_norm(o_fwd + o_bwd).reshape(B, S, GLA_WIDTH) * gla_norm_gain[layer]
        g_out = g_o * jax.nn.silu(gg)

        y = jnp.concatenate([a_out, g_out], axis=-1) @ w_out[layer]
        x = x + gate[:, None] * y
    return rms_norm(x) * final_gain
```

```cpp
#define PROBE_K 256
#include <hip/hip_runtime.h>
#include <stdint.h>
#include <cstdio>
#include <type_traits>

typedef unsigned short bf16;
constexpr int BATCH = 4, SEQ = 8192, DM = 2048, T = BATCH * SEQ;
constexpr int NPROJ = 7200, NPAD = 7424;
constexpr float EPS = 1e-6f;
constexpr float LOG2E = 1.4426950408889634f;
constexpr float C2 = 0.125f * LOG2E;
constexpr size_t MiB = 1u << 20;
constexpr size_t WS_CTL = 0, CTL_ZERO_BYTES = 1 * MiB, WS_MOD = 1 * MiB, WS_SSP = 1 * MiB + 512 * 1024  , WS_WINT = 2 * MiB, WS_WOUTT = 32 * MiB,
                 WS_H = 40 * MiB  ,
                 WS_AQ = 168 * MiB, WS_AK = 232 * MiB, WS_AV = 296 * MiB, WS_SAG = 360 * MiB, WS_GQ = 424 * MiB, WS_GK = 456 * MiB, WS_GV = 488 * MiB,
                 WS_SGG = 552 * MiB, WS_LR = 616 * MiB, WS_OP = 620 * MiB  , WS_LSE = 812 * MiB  , WS_OF = 818 * MiB, WS_OB = 882 * MiB,
                 WS_SS = 946 * MiB  , WS_ATT = 950 * MiB  ,
                 WS_Y = WS_AQ  ,
                 WS_END = 986 * MiB;

__device__ __forceinline__ unsigned f2bf(float f) { unsigned u = __builtin_bit_cast(unsigned, f); return (u + 0x7fffu + ((u >> 16) & 1u)) >> 16; }
__device__ __forceinline__ unsigned pk2(float lo, float hi) { typedef float f2_ __attribute__((ext_vector_type(2))); typedef __bf16 b2_ __attribute__((ext_vector_type(2))); f2_ v = {lo, hi}; b2_ b = __builtin_convertvector(v, b2_); return __builtin_bit_cast(unsigned, b); }
__device__ __forceinline__ float bf2f(bf16 h) { return __builtin_bit_cast(float, (unsigned)h << 16); }
__device__ __forceinline__ float silu_f(float x) { return x / (1.f + __expf(-x)); }
__device__ __forceinline__ float log_sigmoid_f(float x) { return fminf(x, 0.f) - log1pf(__expf(-fabsf(x))); }
__device__ __forceinline__ int t5_bucket(int rel) {
    const int n = rel < 0 ? -rel : rel;
    int v;
    if (n < 8) v = n;
    else v = 8 + (n >= 15) + (n >= 27) + (n >= 50) + (n >= 91) + (n >= 166) + (n >= 305) + (n >= 559);
    return (rel > 0 ? 16 : 0) + v;
}
struct ProjOut { bf16 *aq, *ak, *av, *sag, *gq, *gk, *gv, *sgg; float* lr; };
namespace pg8 {
#define PG8_LAS __attribute__((address_space(3)))
typedef unsigned short bf16_t;
typedef short bf16x8 __attribute__((ext_vector_type(8)));
typedef float f32x4 __attribute__((ext_vector_type(4)));
typedef unsigned u32x4 __attribute__((ext_vector_type(4)));
constexpr int BM = 256, BK = 64, HALF = 128, HTB = HALF * BK * 2  , STAGE_BYTES = 8 * HTB, NXCD = 8, WGM = 8;

__host__ __device__ __forceinline__ int lds_byte(int r, int c) { const int st = (r >> 4) * 2 + (c >> 5), rr = r & 15, cc = c & 31, ob = rr * 64 + cc * 2; return st * 1024 + (ob ^ (((ob >> 9) & 1) << 5)); }
__host__ __device__ __forceinline__ void stage_rc(int b, int& R, int& C) { const int st = b / 1024, sb = b % 1024, swz = sb ^ (((sb >> 9) & 1) << 5); R = (st >> 1) * 16 + swz / 64; C = (st & 1) * 32 + (swz % 64) / 2; }
__host__ __device__ __forceinline__ int perm32(int rho) { const int n = rho >> 4, i = rho & 15; return 8 * (i >> 2) + 4 * n + (i & 3); }

struct Unit { int pm, pn; };
struct Gemm { const bf16_t* A; const bf16_t* Bt; int M, N, K; };

struct StaticOrder {
    int nM, nN, nwg, G, c, reps;
    __host__ __device__ void init(int M, int N, int G_, int c_) { nM = M / BM; nN = N / BM; nwg = nM * nN; G = G_; c = c_; reps = 1; }
    __host__ __device__ bool next(int i, Unit& u) const {
        const long L = (long)i * G + c; if (L >= (long)nwg * reps) return false;
        int wgid = (int)(L % nwg); { const int q = nwg / NXCD, r = nwg % NXCD, xcd = wgid % NXCD, off = wgid / NXCD; wgid = (xcd < r ? xcd * (q + 1) : r * (q + 1) + (xcd - r) * q) + off; }
        const int nig = WGM * nN, gid = wgid / nig, fm = gid * WGM, gsz = (nM - fm) < WGM ? (nM - fm) : WGM;
        u.pm = fm + ((wgid % nig) % gsz); u.pn = (wgid % nig) / gsz; return true;
    }
    __device__ __forceinline__ void a_ready(const Unit&) const {}
    __device__ __forceinline__ void done(const Unit&) const {}
};

__device__ __forceinline__ unsigned cvt_pk_bf16(float lo, float hi) { unsigned r; asm volatile("v_cvt_pk_bf16_f32 %0, %1, %2" : "=v"(r) : "v"(lo), "v"(hi)); return r; }
__device__ __forceinline__ void store_lines(bf16_t* base16  , size_t ld, u32x4 w0, u32x4 w1, int fr) {
    const bool lo = fr < 8; const u32x4 give = lo ? w1 : w0; u32x4 got;
    got.x = (unsigned)__builtin_amdgcn_update_dpp(0, (int)give.x, 0x128, 0xf, 0xf, false); got.y = (unsigned)__builtin_amdgcn_update_dpp(0, (int)give.y, 0x128, 0xf, 0xf, false);
    got.z = (unsigned)__builtin_amdgcn_update_dpp(0, (int)give.z, 0x128, 0xf, 0xf, false); got.w = (unsigned)__builtin_amdgcn_update_dpp(0, (int)give.w, 0x128, 0xf, 0xf, false);
    *(u32x4*)(base16) = lo ? w0 : got;
    *(u32x4*)(base16 + 8 * ld) = lo ? got : w1;
}
struct EpiProj {
    static constexpr bool PERM = true, PERM2 = true, AFTER_DRAIN = false;
    ProjOut P;
    __device__ __forceinline__ void operator()(const f32x4 (&acc)[2][2][4][2], const Unit& u, int wr, int wc, int fr, int fq) const {
        const int row0 = u.pm * BM + wr * 64 + fr; const int pn = u.pn;
        if (pn == 28) {
            if (wc == 0) {
#pragma unroll
                for (int ai = 0; ai < 2; ++ai)
#pragma unroll
                    for (int m = 0; m < 4; ++m) { float* rowp = P.lr + (size_t)(row0 + ai * HALF + m * 16) * 32 + 8 * fq;
                        *(f32x4*)(rowp) = acc[ai][0][m][0]; *(f32x4*)(rowp + 4) = acc[ai][0][m][1]; }
            }
            return;
        }
        bf16_t* base; int ld, ct; int act = 0; float sc = 1.f;
        if (pn < 4) { base = P.aq; ld = 1024; ct = pn; sc = C2; }
        else if (pn < 8) { base = P.ak; ld = 1024; ct = pn - 4; }
        else if (pn < 12) { base = P.av; ld = 1024; ct = pn - 8; }
        else if (pn < 16) { base = P.sag; ld = 1024; ct = pn - 12; act = 1; }
        else if (pn < 18) { base = P.gq; ld = 512; ct = pn - 16; }
        else if (pn < 20) { base = P.gk; ld = 512; ct = pn - 18; }
        else if (pn < 24) { base = P.gv; ld = 1024; ct = pn - 20; }
        else { base = P.sgg; ld = 1024; ct = pn - 24; act = 1; }
        const int col0 = ct * BM + wc * 64 + 8 * fq + (fr < 8 ? 0 : 32);
#pragma unroll
        for (int ai = 0; ai < 2; ++ai)
#pragma unroll
            for (int m = 0; m < 4; ++m) { bf16_t* rowp = base + (size_t)(u.pm * BM + wr * 64 + ai * HALF + m * 16 + (fr & 7)) * ld + col0; u32x4 w[2];
#pragma unroll
                for (int bj = 0; bj < 2; ++bj) { f32x4 v0 = acc[ai][bj][m][0], v1 = acc[ai][bj][m][1];
                    if (act) {
#pragma unroll
                        for (int e = 0; e < 4; ++e) { v0[e] = v0[e] * __builtin_amdgcn_rcpf(1.f + __expf(-v0[e])); v1[e] = v1[e] * __builtin_amdgcn_rcpf(1.f + __expf(-v1[e])); } }
                    v0 = v0 * sc; v1 = v1 * sc; w[bj].x = cvt_pk_bf16(v0[0], v0[1]); w[bj].y = cvt_pk_bf16(v0[2], v0[3]); w[bj].z = cvt_pk_bf16(v1[0], v1[1]); w[bj].w = cvt_pk_bf16(v1[2], v1[3]); }
                store_lines(rowp, (size_t)ld, w[0], w[1], fr); }
    }
};
struct EpiY {
    static constexpr bool PERM = true, PERM2 = true, AFTER_DRAIN = false;
    bf16_t* Y;
    __device__ __forceinline__ void operator()(const f32x4 (&acc)[2][2][4][2], const Unit& u, int wr, int wc, int fr, int fq) const {
        const int col0 = u.pn * BM + wc * 64 + 8 * fq + (fr < 8 ? 0 : 32);
#pragma unroll
        for (int ai = 0; ai < 2; ++ai)
#pragma unroll
            for (int m = 0; m < 4; ++m) { bf16_t* rowp = Y + (size_t)(u.pm * BM + wr * 64 + ai * HALF + m * 16 + (fr & 7)) * DM + col0; u32x4 w[2];
#pragma unroll
                for (int bj = 0; bj < 2; ++bj) { const f32x4 v0 = acc[ai][bj][m][0], v1 = acc[ai][bj][m][1];
                    w[bj].x = cvt_pk_bf16(v0[0], v0[1]); w[bj].y = cvt_pk_bf16(v0[2], v0[3]); w[bj].z = cvt_pk_bf16(v1[0], v1[1]); w[bj].w = cvt_pk_bf16(v1[2], v1[3]); }
                store_lines(rowp, (size_t)DM, w[0], w[1], fr); }
    }
};
template <class Epi, class Sched, bool ALIGN_EPI = false, bool SP2 = false>
__device__ __forceinline__ void gemm_phase(PG8_LAS unsigned char* lds, const Gemm g, const Sched& S, const Epi& E) {
    const int tid = threadIdx.x, wid = __builtin_amdgcn_readfirstlane(tid >> 6), lane = tid & 63, wr = wid >> 2, wc = wid & 3, fr = lane & 15, fq = lane >> 4;
    const int K = g.K, nt = K / BK;
    unsigned voffA[2], voffB[2], voffB1[2];
#pragma unroll
    for (int i = 0; i < 2; ++i) { int R, C; stage_rc(tid * 16 + i * 8192, R, C);
        voffA[i] = (unsigned)(R * K + C) * 2u;
        if constexpr (Epi::PERM2) { const int col0 = 64 * (R >> 5) + perm32(R & 31); voffB[i] = (unsigned)(col0 * K + C) * 2u; voffB1[i] = (unsigned)((col0 + 32) * K + C) * 2u; }
        else { const int Rb = Epi::PERM ? ((R & ~31) + perm32(R & 31)) : R; voffB[i] = (unsigned)(Rb * K + C) * 2u; voffB1[i] = voffB[i]; } }
    const size_t kstep = (size_t)(BK * 2);
    const size_t hstep = (size_t)HALF * K * 2;
    const size_t hstepB = Epi::PERM2 ? 0 : hstep;
    const size_t tstep = 2 * hstep;
    const unsigned ldsw = (unsigned)wid * 1024u;
    const int aoff = lds_byte(wr * 64 + fr, fq * 8), boff = lds_byte(wc * 32 + fr, fq * 8);
#define PG8_SA(b, h) (((b) * 2 + (h)) * HTB)
#define PG8_SB(b, h) ((4 + (b) * 2 + (h)) * HTB)
#define PG8_STAGE(bufoff, gbase, voff) do { _Pragma("unroll") for (int _i = 0; _i < 2; ++_i) \
        __builtin_amdgcn_global_load_lds((const unsigned*)((const char*)(gbase) + (voff)[_i]), (PG8_LAS unsigned*)(lds + (bufoff) + ldsw + _i * 8192), 16, 0, 0); } while (0)
#define PG8_LDA(dst, b, h) do { _Pragma("unroll") for (int m = 0; m < 4; ++m) _Pragma("unroll") for (int k = 0; k < 2; ++k) dst[m][k] = *(const PG8_LAS bf16x8*)(lds + PG8_SA(b, h) + aoff + m * 2048 + k * 1024); } while (0)
#define PG8_LDB(dst, b, h) do { _Pragma("unroll") for (int n = 0; n < 2; ++n) _Pragma("unroll") for (int k = 0; k < 2; ++k) dst[n][k] = *(const PG8_LAS bf16x8*)(lds + PG8_SB(b, h) + boff + n * 2048 + k * 1024); } while (0)
#define PG8_MMA(ai, bj, At, Bt) do { __builtin_amdgcn_s_setprio(1); _Pragma("unroll") for (int m = 0; m < 4; ++m) _Pragma("unroll") for (int n = 0; n < 2; ++n) _Pragma("unroll") for (int k = 0; k < 2; ++k) \
        acc[ai][bj][m][n] = __builtin_amdgcn_mfma_f32_16x16x32_bf16(Bt[n][k], At[m][k], acc[ai][bj][m][n], 0, 0, 0); __builtin_amdgcn_s_setprio(0); } while (0)
#define PG8_WAIT_V(n) asm volatile("s_waitcnt vmcnt(" #n ")" ::: "memory")
#define PG8_WAIT_L(n) asm volatile("s_waitcnt lgkmcnt(" #n ")" ::: "memory")
#define PG8_BAR __builtin_amdgcn_s_barrier()
#define PG8_SCHED __builtin_amdgcn_sched_barrier(0)
    Unit cur, nxt; int ui = 0;
    if (!S.next(0, cur)) return;
    f32x4 acc[2][2][4][2];
#pragma unroll
    for (int a = 0; a < 2; ++a)
#pragma unroll
        for (int b = 0; b < 2; ++b)
#pragma unroll
            for (int m = 0; m < 4; ++m)
#pragma unroll
                for (int n = 0; n < 2; ++n) acc[a][b][m][n] = (f32x4){0.f, 0.f, 0.f, 0.f};
    bf16x8 At[4][2], B0[2][2], B1[2][2];
    const char* cA = (const char*)g.A + (size_t)cur.pm * tstep; const char* cB = (const char*)g.Bt + (size_t)cur.pn * tstep;
    S.a_ready(cur);
    if constexpr (SP2) {
        PG8_STAGE(PG8_SB(0, 0), cB, voffB); PG8_STAGE(PG8_SB(0, 1), cB + hstepB, voffB1); PG8_STAGE(PG8_SA(0, 0), cA, voffA); PG8_STAGE(PG8_SA(0, 1), cA + hstep, voffA);
        if (wr == 1) PG8_BAR;
        PG8_WAIT_V(2); PG8_BAR;
        PG8_STAGE(PG8_SB(1, 0), cB + kstep, voffB); PG8_STAGE(PG8_SA(1, 0), cA + kstep, voffA); PG8_STAGE(PG8_SB(1, 1), cB + hstepB + kstep, voffB1);
        PG8_WAIT_V(6); PG8_BAR;
    } else {
        PG8_STAGE(PG8_SB(0, 0), cB, voffB); PG8_STAGE(PG8_SA(0, 0), cA, voffA); PG8_STAGE(PG8_SB(0, 1), cB + hstepB, voffB1); PG8_STAGE(PG8_SA(0, 1), cA + hstep, voffA);
        if (wr == 1) PG8_BAR;
        PG8_WAIT_V(4); PG8_BAR;
        PG8_STAGE(PG8_SB(1, 0), cB + kstep, voffB); PG8_STAGE(PG8_SA(1, 0), cA + kstep, voffA); PG8_STAGE(PG8_SB(1, 1), cB + hstepB + kstep, voffB1);
        PG8_WAIT_V(6); PG8_BAR;
    }
    for (;;) {
        const bool has_next = S.next(ui + 1, nxt);
        const char* nA = has_next ? (const char*)g.A + (size_t)nxt.pm * tstep : cA; const char* nB = has_next ? (const char*)g.Bt + (size_t)nxt.pn * tstep : cB;
        for (int t = 0; t < nt; t += 2) {
            const bool last = (t == nt - 2);
            const char* a1 = cA + (size_t)(t + 1) * kstep;
            const char* a2 = last ? nA : cA + (size_t)(t + 2) * kstep; const char* b2 = last ? nB : cB + (size_t)(t + 2) * kstep;
            const char* a3 = a2 + kstep; const char* b3 = b2 + kstep;
            if (last && has_next) S.a_ready(nxt);
            if constexpr (SP2) {
            PG8_LDB(B0, 0, 0); PG8_LDB(B1, 0, 1); PG8_SCHED; PG8_LDA(At, 0, 0); PG8_STAGE(PG8_SA(1, 1), a1 + hstep, voffA);
            PG8_WAIT_V(8); PG8_WAIT_L(0); PG8_BAR; PG8_MMA(0, 0, At, B0); PG8_MMA(0, 1, At, B1); PG8_BAR; PG8_SCHED;
            PG8_LDA(At, 0, 1); PG8_STAGE(PG8_SB(0, 0), b2, voffB); PG8_STAGE(PG8_SB(0, 1), b2 + hstepB, voffB1); PG8_STAGE(PG8_SA(0, 0), a2, voffA);
            PG8_WAIT_V(8); PG8_WAIT_L(0); PG8_BAR; PG8_MMA(1, 0, At, B0); PG8_MMA(1, 1, At, B1); PG8_BAR; PG8_SCHED;
            PG8_LDB(B0, 1, 0); PG8_LDB(B1, 1, 1); PG8_SCHED; PG8_LDA(At, 1, 0); PG8_STAGE(PG8_SA(0, 1), a2 + hstep, voffA);
            PG8_WAIT_V(8); PG8_WAIT_L(0); PG8_BAR; PG8_MMA(0, 0, At, B0); PG8_MMA(0, 1, At, B1); PG8_BAR; PG8_SCHED;
            PG8_LDA(At, 1, 1); PG8_STAGE(PG8_SB(1, 0), b3, voffB); PG8_STAGE(PG8_SB(1, 1), b3 + hstepB, voffB1); PG8_STAGE(PG8_SA(1, 0), a3, voffA);
            PG8_WAIT_V(8); PG8_WAIT_L(0); PG8_BAR; PG8_MMA(1, 0, At, B0); PG8_MMA(1, 1, At, B1); PG8_BAR; PG8_SCHED;
            } else {
            PG8_LDB(B0, 0, 0); PG8_SCHED; PG8_LDA(At, 0, 0); PG8_STAGE(PG8_SA(1, 1), a1 + hstep, voffA);
            PG8_WAIT_L(8); PG8_BAR; PG8_WAIT_L(0); PG8_MMA(0, 0, At, B0); PG8_BAR; PG8_SCHED;
            PG8_LDB(B1, 0, 1); PG8_STAGE(PG8_SB(0, 0), b2, voffB);
            PG8_BAR; PG8_WAIT_L(0); PG8_MMA(0, 1, At, B1); PG8_BAR;
            PG8_LDA(At, 0, 1); PG8_STAGE(PG8_SA(0, 0), a2, voffA);
            PG8_BAR; PG8_WAIT_L(0); PG8_MMA(1, 0, At, B0); PG8_BAR; PG8_SCHED;
            PG8_STAGE(PG8_SB(0, 1), b2 + hstepB, voffB1);
            PG8_WAIT_V(6); PG8_BAR; PG8_MMA(1, 1, At, B1); PG8_BAR;
            PG8_LDB(B0, 1, 0); PG8_SCHED; PG8_LDA(At, 1, 0); PG8_STAGE(PG8_SA(0, 1), a2 + hstep, voffA);
            PG8_WAIT_L(8); PG8_BAR; PG8_WAIT_L(0); PG8_MMA(0, 0, At, B0); PG8_BAR; PG8_SCHED;
            PG8_LDB(B1, 1, 1); PG8_STAGE(PG8_SB(1, 0), b3, voffB);
            PG8_BAR; PG8_WAIT_L(0); PG8_MMA(0, 1, At, B1); PG8_BAR;
            PG8_LDA(At, 1, 1); PG8_STAGE(PG8_SA(1, 0), a3, voffA);
            PG8_BAR; PG8_WAIT_L(0); PG8_MMA(1, 0, At, B0); PG8_BAR; PG8_SCHED;
            PG8_STAGE(PG8_SB(1, 1), b3 + hstepB, voffB1);
            PG8_WAIT_V(6); PG8_BAR; PG8_MMA(1, 1, At, B1); PG8_BAR;
            }
        }
        if constexpr (ALIGN_EPI) { if (wr == 0) PG8_BAR; }
        if constexpr (!Epi::AFTER_DRAIN) { E(acc, cur, wr, wc, fr, fq); S.done(cur); }
        if (!has_next) break;
#pragma unroll
        for (int a = 0; a < 2; ++a)
#pragma unroll
            for (int b = 0; b < 2; ++b)
#pragma unroll
                for (int m = 0; m < 4; ++m)
#pragma unroll
                    for (int n = 0; n < 2; ++n) acc[a][b][m][n] = (f32x4){0.f, 0.f, 0.f, 0.f};
        cur = nxt; cA = nA; cB = nB; ++ui;
        if constexpr (ALIGN_EPI) { if (wr == 1) PG8_BAR; }
    }
    PG8_WAIT_V(0);
    if constexpr (!ALIGN_EPI) { if (wr == 0) PG8_BAR; }
    PG8_BAR;
    if constexpr (Epi::AFTER_DRAIN) { E.fused(acc, cur, wr, wc, fr, fq, lds, wid, lane); S.done(cur); }
#undef PG8_SA
#undef PG8_SB
#undef PG8_STAGE
#undef PG8_LDA
#undef PG8_LDB
#undef PG8_MMA
#undef PG8_WAIT_V
#undef PG8_WAIT_L
#undef PG8_BAR
#undef PG8_SCHED
}
}
constexpr int NWAVES = 8;
constexpr int RING_OFF = 0, RING_BYTES = 153600;
constexpr int LDSCTL_OFF = RING_BYTES, MISC_OFF = LDSCTL_OFF + 320;
constexpr int LDS_BYTES = 154624;
constexpr int CW_TMO = 0, CW_CODE = 1, CW_BAR = 4096, CW_GRP = 16384;
#ifndef NCOMB
#define NCOMB 0
#endif
constexpr int N_COMB = NCOMB;
#define GAS __attribute__((address_space(1)))
#define LAS __attribute__((address_space(3)))
typedef unsigned v4u __attribute__((ext_vector_type(4)));
typedef unsigned v2u __attribute__((ext_vector_type(2)));
typedef float f32x4 __attribute__((ext_vector_type(4)));
typedef float f32x16 __attribute__((ext_vector_type(16)));
typedef short bf16x8 __attribute__((ext_vector_type(8)));
typedef short s16x4 __attribute__((ext_vector_type(4)));
typedef GAS unsigned gu32;
typedef GAS unsigned long long gu64;
#define RLX_AGENT __ATOMIC_RELAXED, __HIP_MEMORY_SCOPE_AGENT
#define LDS_WAIT() asm volatile("s_waitcnt lgkmcnt(0)" ::: "memory")
#define VM_WAIT() asm volatile("s_waitcnt vmcnt(0)" ::: "memory")
__device__ __forceinline__ void glds16(const void* gsrc, unsigned lds_dst) { unsigned keep; const unsigned dst = (unsigned)__builtin_amdgcn_readfirstlane((int)lds_dst);
    asm volatile("s_mov_b32 %0, m0\n\ts_mov_b32 m0, %2\n\ts_nop 0\n\tglobal_load_lds_dwordx4 %1, off\n\ts_mov_b32 m0, %0" : "=&s"(keep) : "v"(gsrc), "s"(dst) : "memory"); }
__device__ __forceinline__ void glds16s(const void* sbase, unsigned voff, unsigned lds_dst) { unsigned keep; const unsigned dst = (unsigned)__builtin_amdgcn_readfirstlane((int)lds_dst);
    const unsigned long long b = (unsigned long long)sbase; const unsigned blo = (unsigned)__builtin_amdgcn_readfirstlane((int)(unsigned)b), bhi = (unsigned)__builtin_amdgcn_readfirstlane((int)(unsigned)(b >> 32));
    const unsigned long long bs = ((unsigned long long)bhi << 32) | blo;
    asm volatile("s_mov_b32 %0, m0\n\ts_mov_b32 m0, %3\n\ts_nop 0\n\tglobal_load_lds_dwordx4 %1, %2\n\ts_mov_b32 m0, %0" : "=&s"(keep) : "v"(voff), "s"(bs), "s"(dst) : "memory"); }
#define XB_TMO      128
#define XB_XCNT(j)  (256  + 64 * (j))
#define XB_XSUB(j)  (1280 + 64 * (j))
#define XB_XGEN(j)  (2304 + 64 * (j))
#define XB_TOP      3328
#define XB_TOPGEN   3392
#define XCD_BAR_WORDS 3456
#define XB_SPIN_CAP (1u << 18)

__device__ __forceinline__ unsigned xb_ld(unsigned* p)              { return __hip_atomic_load(p, __ATOMIC_RELAXED, __HIP_MEMORY_SCOPE_AGENT); }
__device__ __forceinline__ unsigned xb_add(unsigned* p, unsigned v) { return __hip_atomic_fetch_add(p, v, __ATOMIC_RELAXED, __HIP_MEMORY_SCOPE_AGENT); }
__device__ __forceinline__ unsigned xb_xcc_id() { return (unsigned)__builtin_amdgcn_s_getreg((3 << 11) | 20) & 0xFu; }
#define XB_SPIN(cond, bar) do { unsigned _sp = 0; while (cond) { __builtin_amdgcn_s_sleep(1); \
    if ((++_sp & 255u) == 0u) { if (xb_ld(&(bar)[XB_TMO])) break; if (_sp > XB_SPIN_CAP) { atomicAdd(&(bar)[XB_TMO], 1u); break; } } } } while (0)

struct XcdBarrier {
    unsigned* bar; unsigned x;
    volatile LAS unsigned* st;
};

__device__ __forceinline__ XcdBarrier xcd_barrier_post(unsigned* bar, volatile LAS unsigned* st) {
    XcdBarrier b; b.bar = bar; b.x = xb_xcc_id(); b.st = st;
    if (threadIdx.x == 0) (void)xb_add(&bar[XB_XCNT(b.x)], 1u);
    return b;
}
__device__ __forceinline__ void xcd_barrier_complete(unsigned* bar, unsigned x, unsigned& nloc, unsigned& nx) {
    const unsigned G = gridDim.x * gridDim.y * gridDim.z;
    unsigned sum, cnt, mine, sp = 0u;
    for (;;) {
        sum = 0u; cnt = 0u; mine = 0u;
#pragma unroll
        for (unsigned j = 0; j < 16; ++j) { const unsigned c = xb_ld(&bar[XB_XCNT(j)]); sum += c; cnt += (c > 0u) ? 1u : 0u; mine = (j == x) ? c : mine; }
        if (sum == G) break;
        __builtin_amdgcn_s_sleep(1);
        if ((++sp & 255u) == 0u) { if (xb_ld(&bar[XB_TMO])) break; if (sp > XB_SPIN_CAP) { atomicAdd(&bar[XB_TMO], 1u); break; } }
    }
    nloc = mine > 0u ? mine : 1u; nx = cnt > 0u ? cnt : 1u;
}

__device__ __forceinline__ void xcd_barrier(const XcdBarrier& b) {
    asm volatile("s_waitcnt vmcnt(0)" ::: "memory");
    __syncthreads();
    if (threadIdx.x == 0) {
        unsigned* bar = b.bar;
        __builtin_amdgcn_s_waitcnt(0);
        unsigned nloc = b.st[0], nx = b.st[1];
        if (nloc == 0u) { xcd_barrier_complete(bar, b.x, nloc, nx); b.st[0] = nloc; b.st[1] = nx; }
        const unsigned old = xb_add(&bar[XB_XSUB(b.x)], 1u);
        const unsigned gen = old / nloc;
        if (old + 1u == (gen + 1u) * nloc) {
            __builtin_amdgcn_fence(__ATOMIC_RELEASE, "agent");
            asm volatile("s_waitcnt vmcnt(0)" ::: "memory");
            const unsigned og = xb_add(&bar[XB_TOP], 1u);
            const unsigned tg = og / nx;
            if (og + 1u == (tg + 1u) * nx) xb_add(&bar[XB_TOPGEN], 1u);
            else XB_SPIN(xb_ld(&bar[XB_TOPGEN]) == tg, bar);
            __builtin_amdgcn_fence(__ATOMIC_ACQUIRE, "agent");
            xb_add(&bar[XB_XGEN(b.x)], 1u);
            asm volatile("s_waitcnt vmcnt(0)" ::: "memory");
        } else {
            XB_SPIN(xb_ld(&bar[XB_XGEN(b.x)]) == gen, bar);
            __builtin_amdgcn_fence(__ATOMIC_ACQUIRE, "agent");
            asm volatile("s_waitcnt vmcnt(0)" ::: "memory");
        }
    }
    __syncthreads();
}

struct Args { const float* in[13]; float* out; unsigned char* ws; int ph_lo, ph_hi, li, dup_phase, dup_reps, dup_sub; };
struct Frame {
    LAS unsigned char* lds; volatile LAS unsigned* MISC; gu32* ctl;
    int tid, lane, wave, vcu, G;
};
__device__ __forceinline__ float wave_sum(float v) {
#pragma unroll
    for (int o = 1; o < 64; o <<= 1) v += __shfl_xor(v, o);
    return v;
}
__device__ __forceinline__ void p0_transpose_item(const float* W, int K, int N, bf16* WT, LAS float* scr, int item, int lane) {
    const int nblk = N / 32, kb = item / nblk, nb = item % nblk, k0 = 64 * kb, n0 = 32 * nb;
#pragma unroll 8
    for (int i = 0; i < 32; ++i) { const int kk = 2 * i + (lane >> 5); scr[kk * 33 + (lane & 31)] = W[(size_t)(k0 + kk) * N + n0 + (lane & 31)]; }
    LDS_WAIT(); asm volatile("" ::: "memory");
    const int c = lane & 7;
#pragma unroll
    for (int j = 0; j < 4; ++j) { const int n = (lane >> 3) + 8 * j; const LAS float* s = scr + (8 * c) * 33 + n;
        v4u o; o.x = pk2(s[0 * 33], s[1 * 33]); o.y = pk2(s[2 * 33], s[3 * 33]); o.z = pk2(s[4 * 33], s[5 * 33]); o.w = pk2(s[6 * 33], s[7 * 33]);
        *(GAS v4u*)(WT + (size_t)(n0 + n) * K + k0 + 8 * c) = o; }
    LDS_WAIT(); asm volatile("" ::: "memory");
}
__device__ __forceinline__ void p0_mod(Frame& F, const Args& a) {
    const float* c = a.in[1]; const float* w_cond = a.in[2]; const float* b_cond = a.in[3];
    float* mod = (float*)(a.ws + WS_MOD);
    if (F.vcu < 192) {
        LAS float* sc = (LAS float*)(F.lds);
        LAS float* red = (LAS float*)(F.lds + 32768);
        for (int i = F.tid; i < 4 * DM; i += NWAVES * 64) sc[i] = silu_f(c[i]);
        __syncthreads();
        const int cg = F.lane & 7, kr = F.lane >> 3, n0 = 32 * F.vcu + 4 * cg;
        f32x4 acc[4];
#pragma unroll
        for (int b = 0; b < 4; ++b) acc[b] = (f32x4){0.f, 0.f, 0.f, 0.f};
#pragma unroll 8
        for (int it = 0; it < 32; ++it) { const int k = 256 * F.wave + 8 * it + kr;
            const f32x4 w = *(const GAS f32x4*)(w_cond + (size_t)k * (3 * DM) + n0);
#pragma unroll
            for (int b = 0; b < 4; ++b) acc[b] += w * sc[b * DM + k]; }
#pragma unroll
        for (int b = 0; b < 4; ++b)
#pragma unroll
            for (int e = 0; e < 4; ++e) { float v = acc[b][e]; v += __shfl_xor(v, 8); v += __shfl_xor(v, 16); v += __shfl_xor(v, 32); acc[b][e] = v; }
        if (kr == 0) {
#pragma unroll
            for (int b = 0; b < 4; ++b) *(LAS f32x4*)(red + (F.wave * 4 + b) * 32 + 4 * cg) = acc[b]; }
        __syncthreads();
        if (F.tid < 128) { const int b = F.tid >> 5, col = F.tid & 31; float s = b_cond[32 * F.vcu + col];
#pragma unroll
            for (int w = 0; w < 8; ++w) s += red[(w * 4 + b) * 32 + col];
            mod[b * 3 * DM + 32 * F.vcu + col] = s; }
        __syncthreads();
    }
}
__device__ __forceinline__ void p1_weights(Frame& F, const Args& a) {
    LAS float* scr = (LAS float*)(F.lds + RING_OFF + F.wave * 16384);
    const int gw = F.vcu * NWAVES + F.wave, NGW = F.G * NWAVES;
    bf16* wint = (bf16*)(a.ws + WS_WINT); bf16* woutt = (bf16*)(a.ws + WS_WOUTT);
    constexpr int I_IN = (DM / 64) * (NPROJ / 32), I_OUT = (DM / 64) * (DM / 32);
    for (int it = gw; it < I_IN + I_OUT; it += NGW) {
        if (it < I_IN) p0_transpose_item(a.in[4], DM, NPROJ, wint, scr, it, F.lane);
        else p0_transpose_item(a.in[11], DM, DM, woutt, scr, it - I_IN, F.lane);
    }
}
__device__ __forceinline__ void p1_h(Frame& F, const Args& a) {
    const float* x = a.in[0]; const float* mod = (const float*)(a.ws + WS_MOD); bf16* h = (bf16*)(a.ws + WS_H);
    const int gw = F.vcu * NWAVES + F.wave, NGW = F.G * NWAVES;
    for (int blk = gw; blk < T / 16; blk += NGW) {
        const int b = (blk * 16) / SEQ;
        const GAS f32x4* shp = (const GAS f32x4*)(mod + b * 3 * DM) + F.lane; const GAS f32x4* scp = (const GAS f32x4*)(mod + b * 3 * DM + DM) + F.lane;
        f32x4 sh[8], sc[8];
#pragma unroll
        for (int j = 0; j < 8; ++j) { sh[j] = shp[64 * j]; sc[j] = scp[64 * j] + 1.0f; }
        for (int r = 0; r < 16; ++r) { const int m = blk * 16 + r;
            const GAS f32x4* xr = (const GAS f32x4*)(x + (size_t)m * DM) + F.lane;
            f32x4 v[8]; float s = 0.f;
#pragma unroll
            for (int j = 0; j < 8; ++j) { v[j] = xr[64 * j]; s += (v[j].x * v[j].x + v[j].y * v[j].y) + (v[j].z * v[j].z + v[j].w * v[j].w); }
            const float rs = rsqrtf(wave_sum(s) * (1.f / DM) + EPS);
            GAS unsigned long long* o8 = (GAS unsigned long long*)(h + (size_t)m * DM) + F.lane;
#pragma unroll
            for (int j = 0; j < 8; ++j) { const f32x4 o = v[j] * rs * sc[j] + sh[j];
                o8[64 * j] = (unsigned long long)pk2(o.x, o.y) | ((unsigned long long)pk2(o.z, o.w) << 32); } }
    }
}
__device__ __forceinline__ void lr_tail(Frame& F, const Args& a) {
    const bf16* h = (const bf16*)(a.ws + WS_H); const unsigned char* wl = a.ws + WS_WINT + (size_t)7168 * DM * 2; float* lr = (float*)(a.ws + WS_LR);
    constexpr int WROW = 4096 + 32;
    for (int i = F.tid; i < 32 * 256; i += NWAVES * 64) { const int r = i >> 8, c = i & 255; *(LAS v4u*)(F.lds + r * WROW + c * 16) = *(const GAS v4u*)(wl + (size_t)r * 4096 + c * 16); }
    __syncthreads();
    const int gw = F.vcu * NWAVES + F.wave, NGW = F.G * NWAVES, li = F.lane & 15, g = F.lane >> 4;
    const LAS unsigned char* bp0 = F.lds + li * WROW + g * 16; const LAS unsigned char* bp1 = bp0 + 16 * WROW;
    for (int rb = gw; rb < T / 16; rb += NGW) {
        const bf16* ap = h + (size_t)(rb * 16 + li) * DM + 8 * g;
        f32x4 c0 = (f32x4){0.f, 0.f, 0.f, 0.f}, c1 = c0;
        bf16x8 avA[16], avB[16];
#define LRLOAD(D, kb) do { _Pragma("unroll") for (int i_ = 0; i_ < 16; ++i_) D[i_] = *(const GAS bf16x8*)(ap + 32 * (16 * (kb) + i_)); } while (0)
#define LRMMA(D, kb) do { _Pragma("unroll") for (int i_ = 0; i_ < 16; ++i_) { const bf16x8 b0_ = *(const LAS bf16x8*)(bp0 + 64 * (16 * (kb) + i_)), b1_ = *(const LAS bf16x8*)(bp1 + 64 * (16 * (kb) + i_)); \
            c0 = __builtin_amdgcn_mfma_f32_16x16x32_bf16(D[i_], b0_, c0, 0, 0, 0); c1 = __builtin_amdgcn_mfma_f32_16x16x32_bf16(D[i_], b1_, c1, 0, 0, 0); } } while (0)
        LRLOAD(avA, 0); __builtin_amdgcn_sched_barrier(0); LRLOAD(avB, 1); __builtin_amdgcn_sched_barrier(0); LRMMA(avA, 0); __builtin_amdgcn_sched_barrier(0);
        LRLOAD(avA, 2); __builtin_amdgcn_sched_barrier(0); LRMMA(avB, 1); __builtin_amdgcn_sched_barrier(0); LRLOAD(avB, 3); __builtin_amdgcn_sched_barrier(0);
        LRMMA(avA, 2); __builtin_amdgcn_sched_barrier(0); LRMMA(avB, 3); __builtin_amdgcn_sched_barrier(0);
#undef LRLOAD
#undef LRMMA
#pragma unroll
        for (int rg = 0; rg < 4; ++rg) { float* o = lr + (size_t)(rb * 16 + 4 * g + rg) * 32 + li; o[0] = c0[rg]; o[16] = c1[rg]; }
    }
    __syncthreads();
}
__device__ __forceinline__ void unpack8(const v4u w, float (&f)[8]) {
    f[0] = __builtin_bit_cast(float, w.x << 16); f[1] = __builtin_bit_cast(float, w.x & 0xffff0000u); f[2] = __builtin_bit_cast(float, w.y << 16); f[3] = __builtin_bit_cast(float, w.y & 0xffff0000u);
    f[4] = __builtin_bit_cast(float, w.z << 16); f[5] = __builtin_bit_cast(float, w.z & 0xffff0000u); f[6] = __builtin_bit_cast(float, w.w << 16); f[7] = __builtin_bit_cast(float, w.w & 0xffff0000u);
}
__device__ __forceinline__ v4u pack8(const float (&f)[8]) { v4u w; w.x = pk2(f[0], f[1]); w.y = pk2(f[2], f[3]); w.z = pk2(f[4], f[5]); w.w = pk2(f[6], f[7]); return w; }
__device__ __forceinline__ void p5_combine(Frame& F, const Args& a, const int ncomb  ) {
    const bf16* op = (const bf16*)(a.ws + WS_OP); const float* lse = (const float*)(a.ws + WS_LSE); const bf16* sag = (const bf16*)(a.ws + WS_SAG);
    const bf16* of = (const bf16*)(a.ws + WS_OF); const bf16* ob = (const bf16*)(a.ws + WS_OB); const bf16* sgg = (const bf16*)(a.ws + WS_SGG); const float* gain = a.in[9];
    bf16* cat = (bf16*)a.out;
    const int gw = F.vcu * NWAVES + F.wave, NGW = F.G * NWAVES, lane = F.lane;
    float gn[16];
#pragma unroll
    for (int j = 0; j < 4; ++j) { const f32x4 g = *(const GAS f32x4*)(gain + 16 * lane + 4 * j); gn[4 * j] = g.x; gn[4 * j + 1] = g.y; gn[4 * j + 2] = g.z; gn[4 * j + 3] = g.w; }
    for (int t = gw; t < T; t += NGW) {
        const size_t e = (size_t)t * 1024 + 16 * lane; const int hh = lane >> 2;
        if (((((t / SEQ) * 16) + hh) & 7) >= ncomb) {
        const float l0 = lse[(size_t)t * 16 + hh], l1 = lse[(size_t)T * 16 + (size_t)t * 16 + hh], l2 = lse[(size_t)2 * T * 16 + (size_t)t * 16 + hh];
        const float mx = fmaxf(l0, fmaxf(l1, l2)); float w0 = exp2f(l0 - mx), w1 = exp2f(l1 - mx), w2 = exp2f(l2 - mx); const float wi = 1.f / (w0 + w1 + w2); w0 *= wi; w1 *= wi; w2 *= wi;
#pragma unroll
        for (int hf = 0; hf < 2; ++hf) { float p0[8], p1[8], p2[8], g[8], o[8];
            unpack8(*(const GAS v4u*)(op + e + 8 * hf), p0); unpack8(*(const GAS v4u*)(op + (size_t)T * 1024 + e + 8 * hf), p1); unpack8(*(const GAS v4u*)(op + (size_t)2 * T * 1024 + e + 8 * hf), p2);
            unpack8(*(const GAS v4u*)(sag + e + 8 * hf), g);
#pragma unroll
            for (int i = 0; i < 8; ++i) o[i] = (w0 * p0[i] + w1 * p1[i] + w2 * p2[i]) * g[i];
            *(GAS v4u*)(cat + (size_t)t * 2048 + 16 * lane + 8 * hf) = pack8(o); }
        }
        float xv[16], ss = 0.f;
#pragma unroll
        for (int hf = 0; hf < 2; ++hf) { float f[8], b[8]; unpack8(*(const GAS v4u*)(of + e + 8 * hf), f); unpack8(*(const GAS v4u*)(ob + e + 8 * hf), b);
#pragma unroll
            for (int i = 0; i < 8; ++i) { xv[8 * hf + i] = f[i] + b[i]; ss += xv[8 * hf + i] * xv[8 * hf + i]; } }
        ss += __shfl_xor(ss, 1); ss += __shfl_xor(ss, 2); ss += __shfl_xor(ss, 4); ss += __shfl_xor(ss, 8);
        const float r = rsqrtf(ss * (1.f / 256.f) + EPS);
#pragma unroll
        for (int hf = 0; hf < 2; ++hf) { float g[8], o[8]; unpack8(*(const GAS v4u*)(sgg + e + 8 * hf), g);
#pragma unroll
            for (int i = 0; i < 8; ++i) o[i] = xv[8 * hf + i] * r * gn[8 * hf + i] * g[i];
            *(GAS v4u*)(cat + (size_t)t * 2048 + 1024 + 16 * lane + 8 * hf) = pack8(o); }
    }
}
__device__ __forceinline__ void p7_final(Frame& F, const Args& a) {
    float* out = a.out; const float* x = a.in[0]; const float* fg = a.in[12]; const float* mod = (const float*)(a.ws + WS_MOD); const bf16* Y = (const bf16*)(a.ws + WS_Y);
    const int gw = F.vcu * NWAVES + F.wave, NGW = F.G * NWAVES;
    f32x4 g[8];
#pragma unroll
    for (int j = 0; j < 8; ++j) g[j] = *((const GAS f32x4*)fg + F.lane + 64 * j);
    for (int blk = gw; blk < T / 16; blk += NGW) {
        const int b = (blk * 16) / SEQ;
        f32x4 gt[8];
#pragma unroll
        for (int j = 0; j < 8; ++j) gt[j] = *((const GAS f32x4*)(mod + b * 3 * DM + 2 * DM) + F.lane + 64 * j);
        for (int r = 0; r < 16; ++r) { const int m = blk * 16 + r;
            const GAS f32x4* xr = (const GAS f32x4*)(x + (size_t)m * DM) + F.lane; const GAS v2u* yr = (const GAS v2u*)(Y + (size_t)m * DM) + F.lane;
            f32x4 v[8]; float s = 0.f;
#pragma unroll
            for (int j = 0; j < 8; ++j) { const f32x4 xv = xr[64 * j]; const v2u yw = yr[64 * j];
                const f32x4 yv = (f32x4){__builtin_bit_cast(float, yw.x << 16), __builtin_bit_cast(float, yw.x & 0xffff0000u), __builtin_bit_cast(float, yw.y << 16), __builtin_bit_cast(float, yw.y & 0xffff0000u)};
                v[j] = xv + gt[j] * yv; s += (v[j].x * v[j].x + v[j].y * v[j].y) + (v[j].z * v[j].z + v[j].w * v[j].w); }
            const float rs = rsqrtf(wave_sum(s) * (1.f / DM) + EPS);
            GAS f32x4* orow = (GAS f32x4*)(out + (size_t)m * DM) + F.lane;
#pragma unroll
            for (int j = 0; j < 8; ++j) orow[64 * j] = v[j] * rs * g[j]; }
    }
}

namespace att {
constexpr int KCH = 384 * 16, VDH = 384 * 64, K_OFF = 0, V_OFF = 8 * KCH, VBUF = 2 * VDH, BIAS_OFF = V_OFF + 2 * VBUF, BCOPY = 832, RB_OFF = BIAS_OFF + 4 * BCOPY, ATT_LDS = RB_OFF + 2048;
static_assert(ATT_LDS <= RING_BYTES && (V_OFF % 1024) == 0 && (BIAS_OFF % 16) == 0, "attention LDS map");
constexpr int NUNITS = BATCH * 16 * 3 * 32;
__device__ __forceinline__ int crow(int r, int hi) { return (r & 3) + 8 * (r >> 2) + 4 * hi; }
typedef short v4i16_t __attribute__((ext_vector_type(4)));
__device__ __forceinline__ s16x4 vtr(const LAS unsigned char* p) { return __builtin_bit_cast(s16x4, __builtin_amdgcn_ds_read_tr16_b64_v4i16((LAS v4i16_t*)p)); }
__device__ __forceinline__ unsigned cvtpk(float lo, float hi) { typedef float f2 __attribute__((ext_vector_type(2))); typedef __bf16 b2 __attribute__((ext_vector_type(2))); f2 v = {lo, hi}; b2 b = __builtin_convertvector(v, b2); return __builtin_bit_cast(unsigned, b); }
#define ATT_BAR() asm volatile("s_waitcnt lgkmcnt(0)\n\ts_barrier" ::: "memory")

struct UnitGeo { int b, h, p, d, r, L, m0; unsigned rowb; size_t base; };
__device__ __forceinline__ UnitGeo decode(int uid) {
    UnitGeo u; const int bh = uid / 96, w96 = uid % 96, rs = w96 & 31; u.p = w96 >> 5; u.b = bh >> 4; u.h = bh & 15;
    u.d = (u.p == 0) ? 1 : (u.p == 1 ? 4 : 16);
    u.r = (u.p == 0) ? 0 : (u.p == 1 ? (rs >> 3) : (rs >> 1)); const int seg = (u.p == 0) ? rs : (u.p == 1 ? (rs & 7) : (rs & 1));
    u.L = SEQ / u.d; u.m0 = seg * 256; u.rowb = (unsigned)u.d * 2048u; u.base = ((size_t)u.b * SEQ + u.r) * 2048 + u.h * 128; return u;
}
__device__ __forceinline__ void dma_k(const Args& a, const UnitGeo& u, LAS unsigned char* lds, int wid, int lane) {
    const unsigned char* Kb = a.ws + WS_AK + u.base + (lane >> 3) * 16; const unsigned rowb = u.rowb;
#pragma unroll
    for (int j = 0; j < 6; ++j) { const int blk = wid + 8 * j; int m = u.m0 - 64 + 8 * blk + (lane & 7); m = m < 0 ? 0 : (m > u.L - 1 ? u.L - 1 : m);
        glds16(Kb + (size_t)m * rowb, (unsigned)(size_t)lds + K_OFF + blk * 1024); }
}
__device__ __forceinline__ void dma_v(const Args& a, const UnitGeo& u, LAS unsigned char* lds, int vbuf, int wid, int lane) {
    const unsigned char* Vb = a.ws + WS_AV + u.base + (lane >> 5) * 64 + (lane & 3) * 16; const unsigned rowb = u.rowb;
#pragma unroll
    for (int j = 0; j < 6; ++j) { const int blk = wid + 8 * j; int m = u.m0 - 64 + 8 * blk + ((lane >> 2) & 7); m = m < 0 ? 0 : (m > u.L - 1 ? u.L - 1 : m);
        glds16(Vb + (size_t)m * rowb, (unsigned)(size_t)lds + V_OFF + vbuf * VBUF + blk * 1024); }
}
__device__ __forceinline__ void load_q(bf16x8 (&q)[4], const Args& a, const UnitGeo& u, int wid, int r32, int hi) {
    const unsigned char* Qb = a.ws + WS_AQ + u.base + (size_t)(u.m0 + 32 * wid + r32) * u.rowb + hi * 16;
    asm volatile("global_load_dwordx4 %0, %1, off" : "=&v"(q[0]) : "v"(Qb) : "memory");
    asm volatile("global_load_dwordx4 %0, %1, off offset:32" : "=&v"(q[1]) : "v"(Qb) : "memory");
    asm volatile("global_load_dwordx4 %0, %1, off offset:64" : "=&v"(q[2]) : "v"(Qb) : "memory");
    asm volatile("global_load_dwordx4 %0, %1, off offset:96" : "=&v"(q[3]) : "v"(Qb) : "memory");
}
__device__ __forceinline__ void write_bias(const Args& a, const UnitGeo& u, LAS unsigned char* lds, int tid) {
    for (int e = tid; e < 4 * 192; e += 512) { const int s = e / 192, i = e % 192, sp = i + s - 95;
        *(LAS float*)(lds + BIAS_OFF + s * BCOPY + i * 4) = (sp >= -64 && sp <= 64) ? ((const LAS float*)(lds + RB_OFF))[t5_bucket(sp * u.d) * 16 + u.h] : -1e30f; }
}
#define DECODE(x) decode(unit_of(x))
__device__ __forceinline__ UnitGeo decode_p(int uid, bool contig) { UnitGeo u = decode(uid); if (contig) { u.rowb = 128u; u.base = (size_t)(uid / 96) * SEQ * 128 + (size_t)((uid % 96) >> 5) * 16 * 2048; } return u; }
__device__ __forceinline__ void attn_phase(Frame& F, const Args& a, int c, int ncu, const int knobs = 0) {
    const bool nodma = knobs & 1, nomath = knobs & 2, nostore = knobs & 4, noq = knobs & 16;
    if (c < 0 || c >= ncu) return;
    const bool coop = (ncu == 192);
    const int per = coop ? 32 : (NUNITS + ncu - 1) / ncu, u0 = coop ? 0 : c * per, u1 = coop ? 32 : ((u0 + per < NUNITS) ? u0 + per : NUNITS);
    if (u0 >= u1) return;
    const int cx = c / 24, cj = c % 24;
    auto unit_of = [&](int i) -> int { return coop ? ((8 * cx + (i >> 2)) * 96 + cj + 24 * (i & 3)) : i; };
    LAS unsigned char* lds = F.lds;
    const int tid = F.tid, lane = F.lane, wid = F.wave, r32 = lane & 31, hi = lane >> 5;
    UnitGeo cur = DECODE(u0);
    __builtin_amdgcn_s_waitcnt(0);
    asm volatile("s_waitcnt vmcnt(0) lgkmcnt(0)\n\ts_barrier" ::: "memory");
    ((LAS float*)(lds + RB_OFF))[tid] = a.in[10][tid] * LOG2E;
    asm volatile("s_waitcnt vmcnt(0) lgkmcnt(0)\n\ts_barrier" ::: "memory");
    dma_k(a, cur, lds, wid, lane); dma_v(a, cur, lds, 0, wid, lane); write_bias(a, cur, lds, tid);
    bf16x8 qr[4]; load_q(qr, a, cur, wid, r32, hi);
    int vb = 0;
    float* pl = nullptr; float plv = 0.f; GAS unsigned char* po = nullptr; size_t postep = 0; v4u pov[4] = {};
    const int e31 = 31 - r32;
    const LAS unsigned char* bias_b = lds + BIAS_OFF + (e31 & 3) * BCOPY + ((e31 >> 2) + hi) * 16;
    const LAS unsigned char* kb0 = lds + K_OFF + (4 * wid + (r32 >> 3)) * 1024 + hi * 128 + (r32 & 7) * 16;
    for (int uid = u0; uid < u1; ++uid) {
        asm volatile("s_waitcnt vmcnt(0) lgkmcnt(0)\n\ts_barrier" : "+v"(qr[0]), "+v"(qr[1]), "+v"(qr[2]), "+v"(qr[3]) :: "memory");
        if (uid != u0 && !nostore) {
            if (hi == 0) *pl = plv;
#pragma unroll
            for (int i = 0; i < 4; ++i) *(GAS v4u*)(po + i * postep) = pov[i]; }
        const bool has_next = uid + 1 < u1; UnitGeo nxt = cur;
        if (has_next) { nxt = DECODE(uid + 1); if (!nodma) dma_v(a, nxt, lds, vb ^ 1, wid, lane); }
        const int b = cur.b, h = cur.h, d = cur.d, r = cur.r, L = cur.L, m0 = cur.m0;
        {
        f32x16 pS[5];
#define SB() __builtin_amdgcn_sched_barrier(0)
#define LOADKB(KF, kb) do { _Pragma("unroll") for (int k_ = 0; k_ < 4; ++k_) { const f32x4 t_ = *(const LAS f32x4*)(bias_b + 32 * k_ + 128 * (kb)); pS[kb][4 * k_] = t_.x; pS[kb][4 * k_ + 1] = t_.y; pS[kb][4 * k_ + 2] = t_.z; pS[kb][4 * k_ + 3] = t_.w; } \
                            _Pragma("unroll") for (int d_ = 0; d_ < 4; ++d_) KF[d_] = *(const LAS bf16x8*)(kb0 + d_ * 256 + (kb) * 4096); } while (0)
#define MMAKB(KF, kb) do { _Pragma("unroll") for (int d_ = 0; d_ < 4; ++d_) pS[kb] = __builtin_amdgcn_mfma_f32_32x32x16_bf16(KF[d_], qr[d_], pS[kb], 0, 0, 0); } while (0)
        { bf16x8 ka[4], kc[4];
          LOADKB(ka, 0); SB(); LOADKB(kc, 1); SB(); MMAKB(ka, 0); SB(); LOADKB(ka, 2); SB(); MMAKB(kc, 1); SB(); LOADKB(kc, 3); SB(); MMAKB(ka, 2); SB(); LOADKB(ka, 4); SB(); MMAKB(kc, 3); SB(); MMAKB(ka, 4); SB(); }
#undef LOADKB
#undef MMAKB
        {
        ATT_BAR();
        if (has_next) { if (!nodma) dma_k(a, nxt, lds, wid, lane); if (nxt.p != cur.p || nxt.h != cur.h) write_bias(a, nxt, lds, tid); if (!noq) load_q(qr, a, nxt, wid, r32, hi); }
        }
        const int mb = m0 - 64 + 32 * wid;
        if (mb < 0 || mb + 160 > L) {
            const int mbl = mb + 4 * hi;
#pragma unroll
            for (int kb = 0; kb < 5; ++kb)
#pragma unroll
                for (int rg = 0; rg < 16; ++rg) { const int kr0 = 32 * kb + crow(rg, 0); pS[kb][rg] = ((unsigned)(mbl + kr0) < (unsigned)L) ? pS[kb][rg] : -1e30f; }
        }
        float mx = -1e30f;
#pragma unroll
        for (int kb = 0; kb < 5; ++kb)
#pragma unroll
            for (int rg = 0; rg < 16; rg += 2) mx = fmaxf(fmaxf(mx, pS[kb][rg]), pS[kb][rg + 1]);
        mx = fmaxf(mx, __shfl_xor(mx, 32));
        float l = 0.f;
#pragma unroll
        for (int kb = 0; kb < 5; ++kb)
#pragma unroll
            for (int rg = 0; rg < 16; ++rg) { const float e = __builtin_amdgcn_exp2f(pS[kb][rg] - mx); pS[kb][rg] = e; l += e; }
        l += __shfl_xor(l, 32);
        f32x16 o[2];
        o[0] = (f32x16){0.f, 0.f, 0.f, 0.f, 0.f, 0.f, 0.f, 0.f, 0.f, 0.f, 0.f, 0.f, 0.f, 0.f, 0.f, 0.f}; o[1] = o[0];
        const LAS unsigned char* vb0 = lds + V_OFF + vb * VBUF + (4 * wid) * 1024 + (4 * hi + ((lane & 15) >> 2)) * 64 + ((lane >> 4) & 1) * 32 + (lane & 3) * 8;
#define LOADV(VF, kb) do { _Pragma("unroll") for (int s_ = 0; s_ < 2; ++s_) _Pragma("unroll") for (int d_ = 0; d_ < 2; ++d_) { \
            const s16x4 lo_ = vtr(vb0 + d_ * 512 + (2 * (kb) + s_) * 2048), hh_ = vtr(vb0 + d_ * 512 + (2 * (kb) + s_) * 2048 + 1024); \
            VF[s_ * 2 + d_] = (bf16x8){lo_[0], lo_[1], lo_[2], lo_[3], hh_[0], hh_[1], hh_[2], hh_[3]}; } } while (0)
#define MMAV(VF, kb) do { _Pragma("unroll") for (int s_ = 0; s_ < 2; ++s_) { v4u pw_; pw_.x = cvtpk(pS[kb][8 * s_ + 0], pS[kb][8 * s_ + 1]); pw_.y = cvtpk(pS[kb][8 * s_ + 2], pS[kb][8 * s_ + 3]); \
            pw_.z = cvtpk(pS[kb][8 * s_ + 4], pS[kb][8 * s_ + 5]); pw_.w = cvtpk(pS[kb][8 * s_ + 6], pS[kb][8 * s_ + 7]); const bf16x8 pa_ = __builtin_bit_cast(bf16x8, pw_); \
            _Pragma("unroll") for (int d_ = 0; d_ < 2; ++d_) o[d_] = __builtin_amdgcn_mfma_f32_32x32x16_bf16(VF[s_ * 2 + d_], pa_, o[d_], 0, 0, 0); } } while (0)
        { bf16x8 va[4], vc[4];
          LOADV(va, 0); SB(); LOADV(vc, 1); SB(); MMAV(va, 0); SB(); LOADV(va, 2); SB(); MMAV(vc, 1); SB(); LOADV(vc, 3); SB(); MMAV(va, 2); SB(); LOADV(va, 4); SB(); MMAV(vc, 3); SB(); MMAV(va, 4); SB(); }
#undef LOADV
#undef MMAV
#undef SB
        const float li = 1.f / l;
        const size_t tq = (size_t)b * SEQ + (size_t)(m0 + 32 * wid + r32) * d + r;
        {
        pl = (float*)(a.ws + WS_LSE) + (size_t)cur.p * T * 16 + tq * 16 + h; plv = mx + __builtin_amdgcn_logf(l);
        ATT_BAR();
        LAS unsigned char* stg = lds + V_OFF + vb * VBUF + wid * (32 * 144);
#pragma unroll
        for (int d0 = 0; d0 < 2; ++d0)
#pragma unroll
            for (int k = 0; k < 4; ++k)
                *(LAS v2u*)(stg + r32 * 144 + (32 * d0 + 8 * k + 4 * hi) * 2) = (v2u){cvtpk(o[d0][4 * k] * li, o[d0][4 * k + 1] * li), cvtpk(o[d0][4 * k + 2] * li, o[d0][4 * k + 3] * li)};
        LDS_WAIT();
        { const int row = lane >> 3, ch = lane & 7;
          po = (GAS unsigned char*)(a.ws + WS_OP) + ((size_t)cur.p * T + (size_t)b * SEQ + (size_t)(m0 + 32 * wid + row) * d + r) * 2048 + h * 128 + ch * 16; postep = (size_t)8 * d * 2048;
#pragma unroll
          for (int i = 0; i < 4; ++i) pov[i] = *(const LAS v4u*)(stg + (row + 8 * i) * 144 + ch * 16); }
        LDS_WAIT();
        }
        }
        vb ^= 1; cur = nxt;
    }
    { if (hi == 0) *pl = plv;
#pragma unroll
        for (int i = 0; i < 4; ++i) *(GAS v4u*)(po + i * postep) = pov[i]; }
    asm volatile("s_waitcnt vmcnt(0) lgkmcnt(0)\n\ts_barrier" ::: "memory");
    if (!coop || N_COMB == 0) return;
    if (tid == 0) { gu32* cnt = F.ctl + CW_GRP + 64 * cx;
        __builtin_amdgcn_fence(__ATOMIC_RELEASE, "agent"); asm volatile("s_waitcnt vmcnt(0)" ::: "memory");
        __hip_atomic_fetch_add(cnt, 1u, __ATOMIC_RELAXED, __HIP_MEMORY_SCOPE_AGENT);
        unsigned sp = 0;
        while (__hip_atomic_load(cnt, __ATOMIC_RELAXED, __HIP_MEMORY_SCOPE_AGENT) < 24u) { __builtin_amdgcn_s_sleep(2); if (++sp > (1u << 22)) { __hip_atomic_store(F.ctl + CW_TMO, 1u, __ATOMIC_RELAXED, __HIP_MEMORY_SCOPE_AGENT); break; } }
        __builtin_amdgcn_fence(__ATOMIC_ACQUIRE, "agent"); asm volatile("s_waitcnt vmcnt(0)" ::: "memory"); }
    __syncthreads();
    { const bf16* op = (const bf16*)(a.ws + WS_OP); const float* lse = (const float*)(a.ws + WS_LSE); const bf16* sag = (const bf16*)(a.ws + WS_SAG); bf16* cat = (bf16*)a.out;
      const int ch = lane & 7;
      for (int r8 = cj * 8 + wid; r8 < N_COMB * 1024; r8 += 24 * 8) { const int rho = r8 * 8 + (lane >> 3), k = rho >> 13, sidx = rho & 8191, bh = 8 * cx + k, bb = bh >> 4, hh = bh & 15;
          const size_t t = (size_t)bb * SEQ + sidx;
          const float l0 = lse[t * 16 + hh], l1 = lse[(size_t)T * 16 + t * 16 + hh], l2 = lse[(size_t)2 * T * 16 + t * 16 + hh];
          const float mxl = fmaxf(l0, fmaxf(l1, l2)); float w0 = __builtin_amdgcn_exp2f(l0 - mxl), w1 = __builtin_amdgcn_exp2f(l1 - mxl), w2 = __builtin_amdgcn_exp2f(l2 - mxl); const float wi = 1.f / (w0 + w1 + w2); w0 *= wi; w1 *= wi; w2 *= wi;
          const size_t e = t * 1024 + hh * 64 + ch * 8;
          float p0[8], p1[8], p2[8], g[8], o[8];
          unpack8(*(const GAS v4u*)(op + e), p0); unpack8(*(const GAS v4u*)(op + (size_t)T * 1024 + e), p1); unpack8(*(const GAS v4u*)(op + (size_t)2 * T * 1024 + e), p2); unpack8(*(const GAS v4u*)(sag + e), g);
#pragma unroll
          for (int i = 0; i < 8; ++i) o[i] = (w0 * p0[i] + w1 * p1[i] + w2 * p2[i]) * g[i];
          *(GAS v4u*)(cat + t * 2048 + hh * 64 + ch * 8) = pack8(o); }
    }
}
#undef ATT_BAR
#undef DECODE
}
namespace gla {
constexpr int PACK_QK = 32768, PACK_ATT = 9216;
constexpr float DKS = 0.08838834764831845f;
__device__ __forceinline__ unsigned cvtpk(float lo, float hi) { typedef float f2 __attribute__((ext_vector_type(2))); typedef __bf16 b2 __attribute__((ext_vector_type(2))); f2 v = {lo, hi}; b2 b = __builtin_convertvector(v, b2); return __builtin_bit_cast(unsigned, b); }
__device__ __forceinline__ int idx32(int g, int jj) { return 16 * (jj >> 2) + 4 * g + (jj & 3); }
__device__ __forceinline__ float fexp(float x) { return __builtin_amdgcn_exp2f(x * LOG2E); }
__device__ __forceinline__ float logsig16(float x) { return (fminf(x, 0.f) - __builtin_amdgcn_logf(1.f + fexp(-fabsf(x))) * 0.6931471805599453f) * (1.f / 16.f); }
typedef short v4i16_t __attribute__((ext_vector_type(4)));
__device__ __forceinline__ s16x4 vtr(const LAS unsigned char* p) { return __builtin_bit_cast(s16x4, __builtin_amdgcn_ds_read_tr16_b64_v4i16((LAS v4i16_t*)p)); }
constexpr int ROWB = 272  , GROW = 136  ;
constexpr int LRROW = 36  ;
constexpr int L_QT = 0, L_KT = 64 * ROWB, L_LR = 2 * 64 * ROWB, L_G = L_LR + 64 * LRROW * 4, L_GT = L_G + 2 * 64 * GROW * 4, L_TOT = L_GT + 4096, L_KBM = L_TOT + 1024  , L_PREP_END = L_KBM + 32768;
static_assert(L_PREP_END <= RING_BYTES, "prep LDS map");

__device__ __forceinline__ void prep_unit(Frame& F, const Args& a, int uid, const int knobs = 0) {
    const int b = uid >> 9, h = (uid >> 7) & 3, n = uid & 127; const size_t t0 = (size_t)b * SEQ + 64 * n;
    const bf16* gq = (const bf16*)(a.ws + WS_GQ); const bf16* gk = (const bf16*)(a.ws + WS_GK); const float* lr = (const float*)(a.ws + WS_LR);
    LAS unsigned char* lds = F.lds; const int tid = F.tid, lane = F.lane, wid = F.wave;
    float upb[2][4], bsv[2];
#pragma unroll
    for (int dir = 0; dir < 2; ++dir) { const float* up = a.in[dir ? 7 : 5] + h * 128 + 16 * wid + (lane & 15); bsv[dir] = a.in[dir ? 8 : 6][h * 128 + 16 * wid + (lane & 15)];
#pragma unroll
        for (int ks = 0; ks < 4; ++ks) upb[dir][ks] = up[(4 * ks + (lane >> 4)) * 512]; }
#pragma unroll
    for (int i = 0; i < 2; ++i) { const int pid = tid + 512 * i, row = pid >> 4, c16 = pid & 15; const size_t off = (t0 + row) * 512 + h * 128 + c16 * 8;
        *(LAS v4u*)(lds + L_QT + row * ROWB + c16 * 16) = *(const GAS v4u*)(gq + off); *(LAS v4u*)(lds + L_KT + row * ROWB + c16 * 16) = *(const GAS v4u*)(gk + off); }
    { const int row = tid >> 3, c16 = tid & 7; *(LAS v4u*)(lds + L_LR + row * (LRROW * 4) + c16 * 16) = *(const GAS v4u*)(lr + (t0 + row) * 32 + c16 * 4); }
    __syncthreads();
    LAS float* G = (LAS float*)(lds + L_G); LAS float* TOT = (LAS float*)(lds + L_TOT); const LAS float* LR = (const LAS float*)(lds + L_LR);
    if (!(knobs & 1)) { const int li2 = lane & 15, g2 = lane >> 4, c = 16 * wid + li2;
#pragma unroll
      for (int dir = 0; dir < 2; ++dir) { f32x4 gl[4];
#pragma unroll
          for (int mt = 0; mt < 4; ++mt) { f32x4 acc = (f32x4){0.f, 0.f, 0.f, 0.f};
#pragma unroll
              for (int ks = 0; ks < 4; ++ks) acc = __builtin_amdgcn_mfma_f32_16x16x4f32(LR[(16 * mt + li2) * LRROW + dir * 16 + 4 * ks + g2], upb[dir][ks], acc, 0, 0, 0);
#pragma unroll
              for (int rg = 0; rg < 4; ++rg) gl[mt][rg] = logsig16(acc[rg] + bsv[dir]); }
          float off = 0.f;
#pragma unroll
          for (int m2 = 0; m2 < 4; ++m2) { const int mt = dir ? 3 - m2 : m2; f32x4 p; float t;
              if (!dir) { p[0] = gl[mt][0]; p[1] = p[0] + gl[mt][1]; p[2] = p[1] + gl[mt][2]; p[3] = p[2] + gl[mt][3]; t = p[3]; }
              else      { p[3] = gl[mt][3]; p[2] = p[3] + gl[mt][2]; p[1] = p[2] + gl[mt][1]; p[0] = p[1] + gl[mt][0]; t = p[0]; }
              float sc = t, u;
              if (!dir) { u = __shfl_up(sc, 16); if (g2 >= 1) sc += u; u = __shfl_up(sc, 32); if (g2 >= 2) sc += u; }
              else      { u = __shfl_down(sc, 16); if (g2 <= 2) sc += u; u = __shfl_down(sc, 32); if (g2 <= 1) sc += u; }
              const float add = sc - t + off;
#pragma unroll
              for (int rg = 0; rg < 4; ++rg) G[(dir * 64 + 16 * mt + 4 * g2 + rg) * GROW + c] = p[rg] + add;
              off += __shfl(sc, (dir ? 0 : 48) + li2); }
          if (g2 == 0) TOT[dir * 128 + c] = off; } }
    __syncthreads();
    if (knobs & 2) { __syncthreads(); return; }
    const int dir = wid >> 2, it = wid & 3, li = lane & 15, g = lane >> 4;
    const int cid = ((b * 4 + h) * 2 + dir) * 128 + n;
    unsigned char* qk_pack = a.ws + WS_H + (size_t)cid * PACK_QK; unsigned char* att_pack = a.ws + WS_ATT + (size_t)cid * PACK_ATT;
    const LAS float* Gd = G + dir * 64 * GROW;
    auto frag = [&](int tile_off, int row, int ks, float sgn, float mul) -> bf16x8 {
        float v[8];
#pragma unroll
        for (int hf = 0; hf < 2; ++hf) { const int c = 32 * ks + 16 * hf + 4 * g;
            const v2u xw = *(const LAS v2u*)(lds + tile_off + row * ROWB + c * 2); const f32x4 bb = *(const LAS f32x4*)(Gd + row * GROW + c);
            v[4 * hf + 0] = __builtin_bit_cast(float, xw.x << 16) * fexp(sgn * bb.x) * mul; v[4 * hf + 1] = __builtin_bit_cast(float, xw.x & 0xffff0000u) * fexp(sgn * bb.y) * mul;
            v[4 * hf + 2] = __builtin_bit_cast(float, xw.y << 16) * fexp(sgn * bb.z) * mul; v[4 * hf + 3] = __builtin_bit_cast(float, xw.y & 0xffff0000u) * fexp(sgn * bb.w) * mul; }
        v4u w; w.x = cvtpk(v[0], v[1]); w.y = cvtpk(v[2], v[3]); w.z = cvtpk(v[4], v[5]); w.w = cvtpk(v[6], v[7]); return __builtin_bit_cast(bf16x8, w); };
    bf16x8 qf[4];
#pragma unroll
    for (int ks = 0; ks < 4; ++ks) { qf[ks] = frag(L_QT, 16 * it + li, ks, 1.f, DKS); *(GAS v4u*)(qk_pack + ((it * 4 + ks) * 64 + lane) * 16) = __builtin_bit_cast(v4u, qf[ks]); }
#pragma unroll
    for (int ks = 0; ks < 4; ++ks) *(LAS v4u*)(lds + L_KBM + (((dir * 4 + it) * 4 + ks) * 64 + lane) * 16) = __builtin_bit_cast(v4u, frag(L_KT, 16 * it + li, ks, -1.f, 1.f));
    __syncthreads();
    f32x4 at[4];
#pragma unroll
    for (int jt = 0; jt < 4; ++jt) { at[jt] = (f32x4){0.f, 0.f, 0.f, 0.f};
#pragma unroll
        for (int ks = 0; ks < 4; ++ks) { const bf16x8 kf = *(const LAS bf16x8*)(lds + L_KBM + (((dir * 4 + jt) * 4 + ks) * 64 + lane) * 16); at[jt] = __builtin_amdgcn_mfma_f32_16x16x32_bf16(kf, qf[ks], at[jt], 0, 0, 0); }
#pragma unroll
        for (int rg = 0; rg < 4; ++rg) { const int j = 16 * jt + 4 * g + rg, i = 16 * it + li; const bool keep = dir ? (j >= i) : (j <= i); at[jt][rg] = keep ? at[jt][rg] : 0.f; } }
#pragma unroll
    for (int ks2 = 0; ks2 < 2; ++ks2) { v4u w; w.x = cvtpk(at[2 * ks2][0], at[2 * ks2][1]); w.y = cvtpk(at[2 * ks2][2], at[2 * ks2][3]); w.z = cvtpk(at[2 * ks2 + 1][0], at[2 * ks2 + 1][1]); w.w = cvtpk(at[2 * ks2 + 1][2], at[2 * ks2 + 1][3]);
        *(GAS v4u*)(att_pack + ((it * 2 + ks2) * 64 + lane) * 16) = w; }
#pragma unroll
    for (int q2 = 0; q2 < 4; ++q2) { const int ct = 2 * it + (q2 >> 1), ks2 = q2 & 1, c = 16 * ct + li; const float te = TOT[dir * 128 + c]; float v[8];
#pragma unroll
        for (int jj = 0; jj < 8; ++jj) { const int j = 32 * ks2 + idx32(g, jj); const float kx = bf2f(*(const LAS bf16*)(lds + L_KT + j * ROWB + c * 2)); v[jj] = kx * fexp(te - Gd[j * GROW + c]); }
        v4u w; w.x = cvtpk(v[0], v[1]); w.y = cvtpk(v[2], v[3]); w.z = cvtpk(v[4], v[5]); w.w = cvtpk(v[6], v[7]);
        *(GAS v4u*)(qk_pack + 16384 + ((ct * 2 + ks2) * 64 + lane) * 16) = w; }
    if (tid < 256) { const int d2 = tid >> 7, c = tid & 127; *(float*)(a.ws + WS_ATT + (size_t)(((b * 4 + h) * 2 + d2) * 128 + n) * PACK_ATT + 8192 + c * 4) = fexp(TOT[d2 * 128 + c]); }
    __syncthreads();
}
__device__ __forceinline__ void prep_phase(Frame& F, const Args& a, int set, int c, int ncu, const int knobs = 0) {
    for (int u = c; u < 1024; u += ncu) { const int nn = u & 63, n = set == 0 ? (nn < 32 ? nn : 64 + nn) : 32 + nn; prep_unit(F, a, ((u >> 6) << 7) | n, knobs); }
}

constexpr int S_ATT = 0, S_DEC = 8192, S_QK = 9216, S_V = 9216 + 32768, S_BUF = S_V + 16384;
constexpr int S_O = 2 * S_BUF, OROW = 272, S_OT = 64 * OROW;
static_assert(S_O + 2 * S_OT <= RING_BYTES && (S_BUF % 1024) == 0, "scan LDS map");
template <class MidFn> __device__ __forceinline__ void scan_unit(Frame& F, const Args& a, int su, const MidFn& mid, const int knobs = 0) {
    const bool nodma = knobs & 1, nomath = knobs & 2, nostore = knobs & 4;
    const int bh = su >> 2, dir = (su >> 1) & 1, half = su & 1, b = bh >> 2, h = bh & 3;
    const int cid0 = ((b * 4 + h) * 2 + dir) * 128;
    LAS unsigned char* lds = F.lds; const int tid = F.tid, lane = F.lane, wid = F.wave, li = lane & 15, g = lane >> 4;
    const unsigned char* gvb = a.ws + WS_GV + (size_t)b * SEQ * 2048 + h * 512 + half * 256;
    unsigned char* ob = a.ws + (dir ? WS_OB : WS_OF) + (size_t)b * SEQ * 2048 + h * 512 + half * 256 + (size_t)(tid >> 4) * 2048 + (tid & 15) * 16;
    const int ow = (16 * wid + 4 * g) * 2 + li * OROW;
    const unsigned lds0 = (unsigned)(size_t)lds;
    int pk[8]; unsigned pvo[8], plo[8];
#pragma unroll
    for (int j = 0; j < 8; ++j) { const int p = wid + 8 * j;
        if (p < 9) { pk[j] = 0; pvo[j] = p * 1024 + lane * 16; plo[j] = S_ATT + p * 1024; }
        else if (p < 41) { pk[j] = 1; pvo[j] = (p - 9) * 1024 + lane * 16; plo[j] = S_QK + (p - 9) * 1024; }
        else if (p < 57) { const int pv = p - 41, row = 4 * pv + (lane >> 4), c = (lane & 15) ^ (2 * (row & 7)); pk[j] = 2; pvo[j] = row * 2048 + c * 16; plo[j] = S_V + pv * 1024; }
        else { pk[j] = 3; pvo[j] = 0; plo[j] = 0; } }
    auto issue = [&](int n, int bufoff) {
        const int cid = cid0 + n; const unsigned char* b0 = a.ws + WS_ATT + (size_t)cid * PACK_ATT; const unsigned char* b1 = a.ws + WS_H + (size_t)cid * PACK_QK; const unsigned char* b2 = gvb + (size_t)(64 * n) * 2048;
#pragma unroll
        for (int j = 0; j < 8; ++j) if (pk[j] != 3) glds16s(pk[j] == 0 ? b0 : (pk[j] == 1 ? b1 : b2), pvo[j], lds0 + bufoff + plo[j]);
    };
    f32x4 S[8];
#pragma unroll
    for (int ct = 0; ct < 8; ++ct) S[ct] = (f32x4){0.f, 0.f, 0.f, 0.f};
    const int vq = li >> 2, vp = li & 3;
    const int voff = (4 * g + vq) * 256 + (((2 * wid + (vp >> 1)) ^ (2 * ((4 * (g & 1) + vq)))) * 16) + 8 * (vp & 1);
    __builtin_amdgcn_s_waitcnt(0);
    auto step = [&](int s, int sb, int se) __attribute__((always_inline)) {
        const int n = dir ? 127 - s : s; const int bufoff = (s & 1) * S_BUF;
        if (!nostore && s > sb) { unsigned char* op = ob + (size_t)(64 * (dir ? n + 1 : n - 1)) * 2048; const LAS unsigned char* ot = lds + S_O + ((s - 1) & 1) * S_OT + (tid >> 4) * OROW + (tid & 15) * 16;
#pragma unroll
          for (int p = 0; p < 2; ++p) *(GAS v4u*)(op + (size_t)(32 * p) * 2048) = *(const LAS v4u*)(ot + 32 * p * OROW); }
        if (s + 1 < se && !nodma) issue(dir ? 126 - s : s + 1, S_BUF - bufoff);
        const LAS unsigned char* B = lds + bufoff;
        if (!nomath) {
        bf16x8 vf[2];
#pragma unroll
        for (int ks2 = 0; ks2 < 2; ++ks2) { const s16x4 lo = vtr(B + S_V + voff + ks2 * 8192), hh = vtr(B + S_V + voff + ks2 * 8192 + 4096); vf[ks2] = (bf16x8){lo[0], lo[1], lo[2], lo[3], hh[0], hh[1], hh[2], hh[3]}; }
        bf16x8 sf[4];
#pragma unroll
        for (int ks = 0; ks < 4; ++ks) { v4u w; w.x = cvtpk(S[2 * ks][0], S[2 * ks][1]); w.y = cvtpk(S[2 * ks][2], S[2 * ks][3]); w.z = cvtpk(S[2 * ks + 1][0], S[2 * ks + 1][1]); w.w = cvtpk(S[2 * ks + 1][2], S[2 * ks + 1][3]); sf[ks] = __builtin_bit_cast(bf16x8, w); }
#define SB() __builtin_amdgcn_sched_barrier(0)
#define LOADO(D, mt) do { _Pragma("unroll") for (int k_ = 0; k_ < 4; ++k_) D[k_] = *(const LAS bf16x8*)(B + S_QK + (((mt) * 4 + k_) * 64 + lane) * 16); \
                          _Pragma("unroll") for (int k_ = 0; k_ < 2; ++k_) D[4 + k_] = *(const LAS bf16x8*)(B + S_ATT + (((mt) * 2 + k_) * 64 + lane) * 16); } while (0)
#define MMAO(D, mt) do { f32x4 o_ = (f32x4){0.f, 0.f, 0.f, 0.f}; _Pragma("unroll") for (int k_ = 0; k_ < 4; ++k_) o_ = __builtin_amdgcn_mfma_f32_16x16x32_bf16(sf[k_], D[k_], o_, 0, 0, 0); \
                         _Pragma("unroll") for (int k_ = 0; k_ < 2; ++k_) o_ = __builtin_amdgcn_mfma_f32_16x16x32_bf16(vf[k_], D[4 + k_], o_, 0, 0, 0); *(LAS v2u*)(otile + (16 * (mt)) * OROW) = (v2u){cvtpk(o_[0], o_[1]), cvtpk(o_[2], o_[3])}; } while (0)
#define LOADS(D, V, c2) do { _Pragma("unroll") for (int k_ = 0; k_ < 4; ++k_) D[k_] = *(const LAS bf16x8*)(B + S_QK + 16384 + (((c2) * 4 + k_) * 64 + lane) * 16); \
                             V[0] = *(const LAS f32x4*)(B + S_DEC + (32 * (c2) + 4 * g) * 4); V[1] = *(const LAS f32x4*)(B + S_DEC + (32 * (c2) + 16 + 4 * g) * 4); } while (0)
#define MMAS(D, V, c2) do { _Pragma("unroll") for (int t_ = 0; t_ < 2; ++t_) { S[2 * (c2) + t_] = S[2 * (c2) + t_] * V[t_]; \
                            _Pragma("unroll") for (int k_ = 0; k_ < 2; ++k_) S[2 * (c2) + t_] = __builtin_amdgcn_mfma_f32_16x16x32_bf16(D[2 * t_ + k_], vf[k_], S[2 * (c2) + t_], 0, 0, 0); } } while (0)
        LAS unsigned char* otile = lds + S_O + (s & 1) * S_OT + ow;
        bf16x8 fa[6], fb[6]; f32x4 da[2], db[2];
        LOADO(fa, 0); SB(); LOADO(fb, 1); SB(); MMAO(fa, 0); SB(); LOADO(fa, 2); SB(); MMAO(fb, 1); SB(); LOADO(fb, 3); SB(); MMAO(fa, 2); SB();
        LOADS(fa, da, 0); SB(); MMAO(fb, 3); SB(); LOADS(fb, db, 1); SB(); MMAS(fa, da, 0); SB(); LOADS(fa, da, 2); SB(); MMAS(fb, db, 1); SB(); LOADS(fb, db, 3); SB(); MMAS(fa, da, 2); SB(); MMAS(fb, db, 3); SB();
#undef LOADO
#undef MMAO
#undef LOADS
#undef MMAS
#undef SB
        }
        asm volatile("s_waitcnt vmcnt(0) lgkmcnt(0)\n\ts_barrier" ::: "memory");
    };
    for (int seg = 0; seg < 2; ++seg) { const int sb = seg ? 32 : 0, se = seg ? 128 : 32;
        asm volatile("s_waitcnt vmcnt(0) lgkmcnt(0)\n\ts_barrier" ::: "memory");
        issue(dir ? 127 - sb : sb, (sb & 1) * S_BUF);
        asm volatile("s_waitcnt vmcnt(0) lgkmcnt(0)\n\ts_barrier" ::: "memory");
        for (int s = sb; s < se; ++s) step(s, sb, se);
        if (!nostore) { unsigned char* op = ob + (size_t)(64 * (dir ? 128 - se : se - 1)) * 2048; const LAS unsigned char* ot = lds + S_O + ((se - 1) & 1) * S_OT + (tid >> 4) * OROW + (tid & 15) * 16;
#pragma unroll
          for (int p = 0; p < 2; ++p) *(GAS v4u*)(op + (size_t)(32 * p) * 2048) = *(const LAS v4u*)(ot + 32 * p * OROW); }
        asm volatile("s_waitcnt vmcnt(0)" ::: "memory");
        if (seg == 0) mid();
    }
}
}
__global__ void __launch_bounds__(NWAVES * 64, 2) mega(Args args) {
    extern __shared__ __attribute__((aligned(16))) unsigned char lds[];
    Frame F;
    F.lds = (LAS unsigned char*)lds; F.MISC = (volatile LAS unsigned*)(F.lds + MISC_OFF);
    F.tid = threadIdx.x; F.lane = F.tid & 63; F.wave = __builtin_amdgcn_readfirstlane(F.tid >> 6);
    F.G = gridDim.x; { const int bx = blockIdx.x; F.vcu = (F.G % 8 == 0) ? (bx % 8) * (F.G / 8) + bx / 8 : bx; }
    unsigned char* ws = args.ws;
    F.ctl = (gu32*)(ws + WS_CTL);
    for (int u = F.tid; u < (LDS_BYTES - LDSCTL_OFF) / 4; u += NWAVES * 64) ((LAS unsigned*)(F.lds + LDSCTL_OFF))[u] = 0u;
    __syncthreads();
    XcdBarrier bar = xcd_barrier_post((unsigned*)(F.ctl + CW_BAR) + args.li * XCD_BAR_WORDS, F.MISC + 8);
    const int lo = args.ph_lo, hi = args.ph_hi;
#define IN(k) (lo <= (k) && (k) < hi)
#define BOTH(k) (IN(k) && IN((k) + 1))
    ProjOut P{(bf16*)(ws + WS_AQ), (bf16*)(ws + WS_AK), (bf16*)(ws + WS_AV), (bf16*)(ws + WS_SAG), (bf16*)(ws + WS_GQ), (bf16*)(ws + WS_GK), (bf16*)(ws + WS_GV), (bf16*)(ws + WS_SGG), (float*)(ws + WS_LR)};
    if (IN(0)) { p0_mod(F, args); if (BOTH(0)) xcd_barrier(bar); }
    if (IN(1)) { p1_h(F, args); p1_weights(F, args); if (BOTH(1)) xcd_barrier(bar); }
    if (IN(2)) {
        pg8::Gemm g{(const bf16*)(ws + WS_H), (const bf16*)(ws + WS_WINT), T, 7168, DM}; pg8::StaticOrder S; S.init(T, 7168, F.G, (int)blockIdx.x);
#ifdef PROBE_G2
        S.reps = 2;
#endif
        pg8::EpiProj E{P};
#ifdef PROBE_K
        { pg8::Gemm g2{(const bf16*)(ws + WS_H), (const bf16*)(ws + WS_WINT), T, 7168, PROBE_K}; pg8::gemm_phase<pg8::EpiProj, pg8::StaticOrder, true, true>(F.lds + RING_OFF, g2, S, E); }
#endif
        pg8::gemm_phase<pg8::EpiProj, pg8::StaticOrder, true, true>(F.lds + RING_OFF, g, S, E);
        lr_tail(F, args);
        if (BOTH(2)) xcd_barrier(bar);
    }
    if (IN(3)) {
#ifdef PROBE_P
        { int q = F.vcu; asm volatile("" : "+s"(q)); gla::prep_phase(F, args, 0, q, F.G, PROBE_P); }
#endif
        gla::prep_phase(F, args, 0, F.vcu, F.G); if (BOTH(3)) xcd_barrier(bar); }
    if (IN(4)) {
        const int ac = (F.vcu >> 2) * 3 + (F.vcu & 3) - 1, anc = (F.G >> 2) * 3;
#ifdef PROBE_S
        if ((F.vcu & 3) == 0) { int q = F.vcu >> 2; asm volatile("" : "+s"(q)); gla::scan_unit(F, args, q, [&]() {}, PROBE_S); }
#endif
        if ((F.vcu & 3) == 0) gla::scan_unit(F, args, F.vcu >> 2, [&]() { xcd_barrier(bar); });
        else { gla::prep_phase(F, args, 1, ac, anc); xcd_barrier(bar);
#ifdef PROBE_A2
            { int q = ac; asm volatile("" : "+s"(q)); att::attn_phase(F, args, q, anc, PROBE_A2); }
#endif
            att::attn_phase(F, args, ac, anc);
        }
        if (BOTH(4)) xcd_barrier(bar); }
    if (IN(5)) { p5_combine(F, args, (((F.G >> 2) * 3) == 192) ? N_COMB : 0); if (BOTH(5)) xcd_barrier(bar); }
    if (IN(6)) {
        pg8::Gemm g{(const bf16*)args.out, (const bf16*)(ws + WS_WOUTT), T, DM, DM}; pg8::StaticOrder S; S.init(T, DM, F.G, (int)blockIdx.x);
#ifdef PROBE_G6
        S.reps = 2;
#endif
        pg8::EpiY E{(bf16*)(ws + WS_Y)};
        pg8::gemm_phase<pg8::EpiY, pg8::StaticOrder, true, true>(F.lds + RING_OFF, g, S, E);
        if (BOTH(6)) xcd_barrier(bar);
    }
    if (IN(7)) { p7_final(F, args); }
#undef IN
#undef BOTH
}
extern "C" void kernel_launch(void* const* d_in, const int* in_sizes, int n_in, void* d_out, int out_size, void* d_ws, size_t ws_size, hipStream_t stream) {
    static int grid = 0;
    if (grid == 0) {
        if (n_in != 13 || ws_size < WS_END || out_size != T * DM) { fprintf(stderr, "kernel_launch: unexpected problem (n_in %d, ws %zu, out %d)\n", n_in, ws_size, out_size); grid = -1; return; }
        int dev = 0, cus = 0, per_cu = 0;
        if (hipGetDevice(&dev) != hipSuccess || hipDeviceGetAttribute(&cus, hipDeviceAttributeMultiprocessorCount, dev) != hipSuccess) { grid = -1; return; }
        if (hipFuncSetAttribute((const void*)mega, hipFuncAttributeMaxDynamicSharedMemorySize, LDS_BYTES) != hipSuccess) { fprintf(stderr, "kernel_launch: hipFuncSetAttribute failed\n"); grid = -1; return; }
        if (hipOccupancyMaxActiveBlocksPerMultiprocessor(&per_cu, (const void*)mega, NWAVES * 64, LDS_BYTES) != hipSuccess || per_cu < 1) { fprintf(stderr, "kernel_launch: occupancy query says %d\n", per_cu); }
        (void)hipGetLastError();
        grid = cus;
    }
    if (grid < 0) return;
    (void)hipMemsetAsync((char*)d_ws + WS_CTL, 0, CTL_ZERO_BYTES, stream);
    Args a{};
    for (int i = 0; i < 13; ++i) a.in[i] = (const float*)d_in[i];
    a.out = (float*)d_out; a.ws = (unsigned char*)d_ws;
    unsigned char* ws = (unsigned char*)d_ws;
#ifndef PROBE_DUP
#define PROBE_DUP -1
#endif
#ifndef PROBE_REPS
#define PROBE_REPS 2
#endif
#ifndef PROBE_SUB
#define PROBE_SUB 2
#endif
    a.ph_lo = 0; a.ph_hi = 8; a.li = 0; a.dup_phase = PROBE_DUP; a.dup_reps = PROBE_REPS; a.dup_sub = PROBE_SUB;
    hipLaunchKernelGGL(mega, dim3(grid), dim3(NWAVES * 64), LDS_BYTES, stream, a);
}
```

```cpp
#include <hip/hip_runtime.h>
#include <stdint.h>
#include <cstdio>
#include <type_traits>

typedef unsigned short bf16;
constexpr int BATCH = 4, SEQ = 8192, DM = 2048, T = BATCH * SEQ;
constexpr int NPROJ = 7200, NPAD = 7424;
constexpr float EPS = 1e-6f;
constexpr float LOG2E = 1.4426950408889634f;
constexpr float C2 = 0.125f * LOG2E;
constexpr size_t MiB = 1u << 20;
constexpr size_t WS_CTL = 0, CTL_ZERO_BYTES = 1 * MiB, WS_MOD = 1 * MiB, WS_SSP = 1 * MiB + 512 * 1024  , WS_WINT = 2 * MiB, WS_WOUTT = 32 * MiB,
                 WS_H = 40 * MiB  ,
                 WS_AQ = 168 * MiB, WS_AK = 232 * MiB, WS_AV = 296 * MiB, WS_SAG = 360 * MiB, WS_GQ = 424 * MiB, WS_GK = 456 * MiB, WS_GV = 488 * MiB,
                 WS_SGG = 552 * MiB, WS_LR = 616 * MiB, WS_OP = 620 * MiB  , WS_LSE = 812 * MiB  , WS_OF = 818 * MiB, WS_OB = 882 * MiB,
                 WS_SS = 946 * MiB  , WS_ATT = 950 * MiB  ,
                 WS_Y = WS_AQ  ,
                 WS_END = 986 * MiB;

__device__ __forceinline__ unsigned f2bf(float f) { unsigned u = __builtin_bit_cast(unsigned, f); return (u + 0x7fffu + ((u >> 16) & 1u)) >> 16; }
__device__ __forceinline__ unsigned pk2(float lo, float hi) { typedef float f2_ __attribute__((ext_vector_type(2))); typedef __bf16 b2_ __attribute__((ext_vector_type(2))); f2_ v = {lo, hi}; b2_ b = __builtin_convertvector(v, b2_); return __builtin_bit_cast(unsigned, b); }
__device__ __forceinline__ float bf2f(bf16 h) { return __builtin_bit_cast(float, (unsigned)h << 16); }
__device__ __forceinline__ float silu_f(float x) { return x / (1.f + __expf(-x)); }
__device__ __forceinline__ float log_sigmoid_f(float x) { return fminf(x, 0.f) - log1pf(__expf(-fabsf(x))); }
__device__ __forceinline__ int t5_bucket(int rel) {
    const int n = rel < 0 ? -rel : rel;
    int v;
    if (n < 8) v = n;
    else v = 8 + (n >= 15) + (n >= 27) + (n >= 50) + (n >= 91) + (n >= 166) + (n >= 305) + (n >= 559);
    return (rel > 0 ? 16 : 0) + v;
}
struct ProjOut { bf16 *aq, *ak, *av, *sag, *gq, *gk, *gv, *sgg; float* lr; };
namespace pg8 {
#define PG8_LAS __attribute__((address_space(3)))
typedef unsigned short bf16_t;
typedef short bf16x8 __attribute__((ext_vector_type(8)));
typedef float f32x4 __attribute__((ext_vector_type(4)));
typedef unsigned u32x4 __attribute__((ext_vector_type(4)));
constexpr int BM = 256, BK = 64, HALF = 128, HTB = HALF * BK * 2  , STAGE_BYTES = 8 * HTB, NXCD = 8, WGM = 8;

__host__ __device__ __forceinline__ int lds_byte(int r, int c) { const int st = (r >> 4) * 2 + (c >> 5), rr = r & 15, cc = c & 31, ob = rr * 64 + cc * 2; return st * 1024 + (ob ^ (((ob >> 9) & 1) << 5)); }
__host__ __device__ __forceinline__ void stage_rc(int b, int& R, int& C) { const int st = b / 1024, sb = b % 1024, swz = sb ^ (((sb >> 9) & 1) << 5); R = (st >> 1) * 16 + swz / 64; C = (st & 1) * 32 + (swz % 64) / 2; }
__host__ __device__ __forceinline__ int perm32(int rho) { const int n = rho >> 4, i = rho & 15; return 8 * (i >> 2) + 4 * n + (i & 3); }

struct Unit { int pm, pn; };
struct Gemm { const bf16_t* A; const bf16_t* Bt; int M, N, K; };

struct StaticOrder {
    int nM, nN, nwg, G, c, reps;
    __host__ __device__ void init(int M, int N, int G_, int c_) { nM = M / BM; nN = N / BM; nwg = nM * nN; G = G_; c = c_; reps = 1; }
    __host__ __device__ bool next(int i, Unit& u) const {
        const long L = (long)i * G + c; if (L >= (long)nwg * reps) return false;
        int wgid = (int)(L % nwg); { const int q = nwg / NXCD, r = nwg % NXCD, xcd = wgid % NXCD, off = wgid / NXCD; wgid = (xcd < r ? xcd * (q + 1) : r * (q + 1) + (xcd - r) * q) + off; }
        const int nig = WGM * nN, gid = wgid / nig, fm = gid * WGM, gsz = (nM - fm) < WGM ? (nM - fm) : WGM;
        u.pm = fm + ((wgid % nig) % gsz); u.pn = (wgid % nig) / gsz; return true;
    }
    __device__ __forceinline__ void a_ready(const Unit&) const {}
    __device__ __forceinline__ void done(const Unit&) const {}
};

__device__ __forceinline__ unsigned cvt_pk_bf16(float lo, float hi) { unsigned r; asm volatile("v_cvt_pk_bf16_f32 %0, %1, %2" : "=v"(r) : "v"(lo), "v"(hi)); return r; }
struct EpiProj {
    static constexpr bool PERM = true, AFTER_DRAIN = false;
    ProjOut P;
    __device__ __forceinline__ void operator()(const f32x4 (&acc)[2][2][4][2], const Unit& u, int wr, int wc, int fr, int fq) const {
        const int row0 = u.pm * BM + wr * 64 + fr; const int pn = u.pn;
        if (pn == 28) {
            if (wc == 0) {
#pragma unroll
                for (int ai = 0; ai < 2; ++ai)
#pragma unroll
                    for (int m = 0; m < 4; ++m) { float* rowp = P.lr + (size_t)(row0 + ai * HALF + m * 16) * 32 + 8 * fq;
                        *(f32x4*)(rowp) = acc[ai][0][m][0]; *(f32x4*)(rowp + 4) = acc[ai][0][m][1]; }
            }
            return;
        }
        bf16_t* base; int ld, ct; int act = 0; float sc = 1.f;
        if (pn < 4) { base = P.aq; ld = 1024; ct = pn; sc = C2; }
        else if (pn < 8) { base = P.ak; ld = 1024; ct = pn - 4; }
        else if (pn < 12) { base = P.av; ld = 1024; ct = pn - 8; }
        else if (pn < 16) { base = P.sag; ld = 1024; ct = pn - 12; act = 1; }
        else if (pn < 18) { base = P.gq; ld = 512; ct = pn - 16; }
        else if (pn < 20) { base = P.gk; ld = 512; ct = pn - 18; }
        else if (pn < 24) { base = P.gv; ld = 1024; ct = pn - 20; }
        else { base = P.sgg; ld = 1024; ct = pn - 24; act = 1; }
        const int col0 = ct * BM + wc * 32 + 8 * fq;
#pragma unroll
        for (int ai = 0; ai < 2; ++ai)
#pragma unroll
            for (int m = 0; m < 4; ++m) { bf16_t* rowp = base + (size_t)(row0 + ai * HALF + m * 16) * ld + col0;
#pragma unroll
                for (int bj = 0; bj < 2; ++bj) { f32x4 v0 = acc[ai][bj][m][0], v1 = acc[ai][bj][m][1];
                    if (act) {
#pragma unroll
                        for (int e = 0; e < 4; ++e) { v0[e] = v0[e] * __builtin_amdgcn_rcpf(1.f + __expf(-v0[e])); v1[e] = v1[e] * __builtin_amdgcn_rcpf(1.f + __expf(-v1[e])); } }
                    v0 = v0 * sc; v1 = v1 * sc; u32x4 w; w.x = cvt_pk_bf16(v0[0], v0[1]); w.y = cvt_pk_bf16(v0[2], v0[3]); w.z = cvt_pk_bf16(v1[0], v1[1]); w.w = cvt_pk_bf16(v1[2], v1[3]);
                    *(u32x4*)(rowp + bj * HALF) = w; } }
    }
};
struct EpiY {
    static constexpr bool PERM = true, AFTER_DRAIN = false;
    bf16_t* Y;
    __device__ __forceinline__ void operator()(const f32x4 (&acc)[2][2][4][2], const Unit& u, int wr, int wc, int fr, int fq) const {
        const int row0 = u.pm * BM + wr * 64 + fr, col0 = u.pn * BM + wc * 32 + 8 * fq;
#pragma unroll
        for (int ai = 0; ai < 2; ++ai)
#pragma unroll
            for (int m = 0; m < 4; ++m) { bf16_t* rowp = Y + (size_t)(row0 + ai * HALF + m * 16) * DM + col0;
#pragma unroll
                for (int bj = 0; bj < 2; ++bj) { const f32x4 v0 = acc[ai][bj][m][0], v1 = acc[ai][bj][m][1];
                    u32x4 w; w.x = cvt_pk_bf16(v0[0], v0[1]); w.y = cvt_pk_bf16(v0[2], v0[3]); w.z = cvt_pk_bf16(v1[0], v1[1]); w.w = cvt_pk_bf16(v1[2], v1[3]);
                    *(u32x4*)(rowp + bj * HALF) = w; } }
    }
};
template <class Epi, class Sched, bool ALIGN_EPI = false, bool SP2 = false>
__device__ __forceinline__ void gemm_phase(PG8_LAS unsigned char* lds, const Gemm g, const Sched& S, const Epi& E) {
    const int tid = threadIdx.x, wid = __builtin_amdgcn_readfirstlane(tid >> 6), lane = tid & 63, wr = wid >> 2, wc = wid & 3, fr = lane & 15, fq = lane >> 4;
    const int K = g.K, nt = K / BK;
    unsigned voffA[2], voffB[2];
#pragma unroll
    for (int i = 0; i < 2; ++i) { int R, C; stage_rc(tid * 16 + i * 8192, R, C); const int Rb = Epi::PERM ? ((R & ~31) + perm32(R & 31)) : R;
        voffA[i] = (unsigned)(R * K + C) * 2u; voffB[i] = (unsigned)(Rb * K + C) * 2u; }
    const size_t kstep = (size_t)(BK * 2);
    const size_t hstep = (size_t)HALF * K * 2;
    const size_t tstep = 2 * hstep;
    const unsigned ldsw = (unsigned)wid * 1024u;
    const int aoff = lds_byte(wr * 64 + fr, fq * 8), boff = lds_byte(wc * 32 + fr, fq * 8);
#define PG8_SA(b, h) (((b) * 2 + (h)) * HTB)
#define PG8_SB(b, h) ((4 + (b) * 2 + (h)) * HTB)
#define PG8_STAGE(bufoff, gbase, voff) do { _Pragma("unroll") for (int _i = 0; _i < 2; ++_i) \
        __builtin_amdgcn_global_load_lds((const unsigned*)((const char*)(gbase) + (voff)[_i]), (PG8_LAS unsigned*)(lds + (bufoff) + ldsw + _i * 8192), 16, 0, 0); } while (0)
#define PG8_LDA(dst, b, h) do { _Pragma("unroll") for (int m = 0; m < 4; ++m) _Pragma("unroll") for (int k = 0; k < 2; ++k) dst[m][k] = *(const PG8_LAS bf16x8*)(lds + PG8_SA(b, h) + aoff + m * 2048 + k * 1024); } while (0)
#define PG8_LDB(dst, b, h) do { _Pragma("unroll") for (int n = 0; n < 2; ++n) _Pragma("unroll") for (int k = 0; k < 2; ++k) dst[n][k] = *(const PG8_LAS bf16x8*)(lds + PG8_SB(b, h) + boff + n * 2048 + k * 1024); } while (0)
#define PG8_MMA(ai, bj, At, Bt) do { __builtin_amdgcn_s_setprio(1); _Pragma("unroll") for (int m = 0; m < 4; ++m) _Pragma("unroll") for (int n = 0; n < 2; ++n) _Pragma("unroll") for (int k = 0; k < 2; ++k) \
        acc[ai][bj][m][n] = __builtin_amdgcn_mfma_f32_16x16x32_bf16(Bt[n][k], At[m][k], acc[ai][bj][m][n], 0, 0, 0); __builtin_amdgcn_s_setprio(0); } while (0)
#define PG8_WAIT_V(n) asm volatile("s_waitcnt vmcnt(" #n ")" ::: "memory")
#define PG8_WAIT_L(n) asm volatile("s_waitcnt lgkmcnt(" #n ")" ::: "memory")
#define PG8_BAR __builtin_amdgcn_s_barrier()
#define PG8_SCHED __builtin_amdgcn_sched_barrier(0)
    Unit cur, nxt; int ui = 0;
    if (!S.next(0, cur)) return;
    f32x4 acc[2][2][4][2];
#pragma unroll
    for (int a = 0; a < 2; ++a)
#pragma unroll
        for (int b = 0; b < 2; ++b)
#pragma unroll
            for (int m = 0; m < 4; ++m)
#pragma unroll
                for (int n = 0; n < 2; ++n) acc[a][b][m][n] = (f32x4){0.f, 0.f, 0.f, 0.f};
    bf16x8 At[4][2], B0[2][2], B1[2][2];
    const char* cA = (const char*)g.A + (size_t)cur.pm * tstep; const char* cB = (const char*)g.Bt + (size_t)cur.pn * tstep;
    S.a_ready(cur);
    if constexpr (SP2) {
        PG8_STAGE(PG8_SB(0, 0), cB, voffB); PG8_STAGE(PG8_SB(0, 1), cB + hstep, voffB); PG8_STAGE(PG8_SA(0, 0), cA, voffA); PG8_STAGE(PG8_SA(0, 1), cA + hstep, voffA);
        if (wr == 1) PG8_BAR;
        PG8_WAIT_V(2); PG8_BAR;
        PG8_STAGE(PG8_SB(1, 0), cB + kstep, voffB); PG8_STAGE(PG8_SA(1, 0), cA + kstep, voffA); PG8_STAGE(PG8_SB(1, 1), cB + hstep + kstep, voffB);
        PG8_WAIT_V(6); PG8_BAR;
    } else {
        PG8_STAGE(PG8_SB(0, 0), cB, voffB); PG8_STAGE(PG8_SA(0, 0), cA, voffA); PG8_STAGE(PG8_SB(0, 1), cB + hstep, voffB); PG8_STAGE(PG8_SA(0, 1), cA + hstep, voffA);
        if (wr == 1) PG8_BAR;
        PG8_WAIT_V(4); PG8_BAR;
        PG8_STAGE(PG8_SB(1, 0), cB + kstep, voffB); PG8_STAGE(PG8_SA(1, 0), cA + kstep, voffA); PG8_STAGE(PG8_SB(1, 1), cB + hstep + kstep, voffB);
        PG8_WAIT_V(6); PG8_BAR;
    }
    for (;;) {
        const bool has_next = S.next(ui + 1, nxt);
        const char* nA = has_next ? (const char*)g.A + (size_t)nxt.pm * tstep : cA; const char* nB = has_next ? (const char*)g.Bt + (size_t)nxt.pn * tstep : cB;
        for (int t = 0; t < nt; t += 2) {
            const bool last = (t == nt - 2);
            const char* a1 = cA + (size_t)(t + 1) * kstep;
            const char* a2 = last ? nA : cA + (size_t)(t + 2) * kstep; const char* b2 = last ? nB : cB + (size_t)(t + 2) * kstep;
            const char* a3 = a2 + kstep; const char* b3 = b2 + kstep;
            if (last && has_next) S.a_ready(nxt);
            if constexpr (SP2) {
            PG8_LDB(B0, 0, 0); PG8_LDB(B1, 0, 1); PG8_SCHED; PG8_LDA(At, 0, 0); PG8_STAGE(PG8_SA(1, 1), a1 + hstep, voffA);
            PG8_WAIT_V(8); PG8_WAIT_L(0); PG8_BAR; PG8_MMA(0, 0, At, B0); PG8_MMA(0, 1, At, B1); PG8_BAR; PG8_SCHED;
            PG8_LDA(At, 0, 1); PG8_STAGE(PG8_SB(0, 0), b2, voffB); PG8_STAGE(PG8_SB(0, 1), b2 + hstep, voffB); PG8_STAGE(PG8_SA(0, 0), a2, voffA);
            PG8_WAIT_V(8); PG8_WAIT_L(0); PG8_BAR; PG8_MMA(1, 0, At, B0); PG8_MMA(1, 1, At, B1); PG8_BAR; PG8_SCHED;
            PG8_LDB(B0, 1, 0); PG8_LDB(B1, 1, 1); PG8_SCHED; PG8_LDA(At, 1, 0); PG8_STAGE(PG8_SA(0, 1), a2 + hstep, voffA);
            PG8_WAIT_V(8); PG8_WAIT_L(0); PG8_BAR; PG8_MMA(0, 0, At, B0); PG8_MMA(0, 1, At, B1); PG8_BAR; PG8_SCHED;
            PG8_LDA(At, 1, 1); PG8_STAGE(PG8_SB(1, 0), b3, voffB); PG8_STAGE(PG8_SB(1, 1), b3 + hstep, voffB); PG8_STAGE(PG8_SA(1, 0), a3, voffA);
            PG8_WAIT_V(8); PG8_WAIT_L(0); PG8_BAR; PG8_MMA(1, 0, At, B0); PG8_MMA(1, 1, At, B1); PG8_BAR; PG8_SCHED;
            } else {
            PG8_LDB(B0, 0, 0); PG8_SCHED; PG8_LDA(At, 0, 0); PG8_STAGE(PG8_SA(1, 1), a1 + hstep, voffA);
            PG8_WAIT_L(8); PG8_BAR; PG8_WAIT_L(0); PG8_MMA(0, 0, At, B0); PG8_BAR; PG8_SCHED;
            PG8_LDB(B1, 0, 1); PG8_STAGE(PG8_SB(0, 0), b2, voffB);
            PG8_BAR; PG8_WAIT_L(0); PG8_MMA(0, 1, At, B1); PG8_BAR;
            PG8_LDA(At, 0, 1); PG8_STAGE(PG8_SA(0, 0), a2, voffA);
            PG8_BAR; PG8_WAIT_L(0); PG8_MMA(1, 0, At, B0); PG8_BAR; PG8_SCHED;
            PG8_STAGE(PG8_SB(0, 1), b2 + hstep, voffB);
            PG8_WAIT_V(6); PG8_BAR; PG8_MMA(1, 1, At, B1); PG8_BAR;
            PG8_LDB(B0, 1, 0); PG8_SCHED; PG8_LDA(At, 1, 0); PG8_STAGE(PG8_SA(0, 1), a2 + hstep, voffA);
            PG8_WAIT_L(8); PG8_BAR; PG8_WAIT_L(0); PG8_MMA(0, 0, At, B0); PG8_BAR; PG8_SCHED;
            PG8_LDB(B1, 1, 1); PG8_STAGE(PG8_SB(1, 0), b3, voffB);
            PG8_BAR; PG8_WAIT_L(0); PG8_MMA(0, 1, At, B1); PG8_BAR;
            PG8_LDA(At, 1, 1); PG8_STAGE(PG8_SA(1, 0), a3, voffA);
            PG8_BAR; PG8_WAIT_L(0); PG8_MMA(1, 0, At, B0); PG8_BAR; PG8_SCHED;
            PG8_STAGE(PG8_SB(1, 1), b3 + hstep, voffB);
            PG8_WAIT_V(6); PG8_BAR; PG8_MMA(1, 1, At, B1); PG8_BAR;
            }
        }
        if constexpr (ALIGN_EPI) { if (wr == 0) PG8_BAR; }
        if constexpr (!Epi::AFTER_DRAIN) { E(acc, cur, wr, wc, fr, fq); S.done(cur); }
        if (!has_next) break;
#pragma unroll
        for (int a = 0; a < 2; ++a)
#pragma unroll
            for (int b = 0; b < 2; ++b)
#pragma unroll
                for (int m = 0; m < 4; ++m)
#pragma unroll
                    for (int n = 0; n < 2; ++n) acc[a][b][m][n] = (f32x4){0.f, 0.f, 0.f, 0.f};
        cur = nxt; cA = nA; cB = nB; ++ui;
        if constexpr (ALIGN_EPI) { if (wr == 1) PG8_BAR; }
    }
    PG8_WAIT_V(0);
    if constexpr (!ALIGN_EPI) { if (wr == 0) PG8_BAR; }
    PG8_BAR;
    if constexpr (Epi::AFTER_DRAIN) { E.fused(acc, cur, wr, wc, fr, fq, lds, wid, lane); S.done(cur); }
#undef PG8_SA
#undef PG8_SB
#undef PG8_STAGE
#undef PG8_LDA
#undef PG8_LDB
#undef PG8_MMA
#undef PG8_WAIT_V
#undef PG8_WAIT_L
#undef PG8_BAR
#undef PG8_SCHED
}
}
constexpr int NWAVES = 8;
constexpr int RING_OFF = 0, RING_BYTES = 153600;
constexpr int LDSCTL_OFF = RING_BYTES, MISC_OFF = LDSCTL_OFF + 320;
constexpr int LDS_BYTES = 154624;
constexpr int CW_TMO = 0, CW_CODE = 1, CW_BAR = 4096;
#define GAS __attribute__((address_space(1)))
#define LAS __attribute__((address_space(3)))
typedef unsigned v4u __attribute__((ext_vector_type(4)));
typedef unsigned v2u __attribute__((ext_vector_type(2)));
typedef float f32x4 __attribute__((ext_vector_type(4)));
typedef float f32x16 __attribute__((ext_vector_type(16)));
typedef short bf16x8 __attribute__((ext_vector_type(8)));
typedef short s16x4 __attribute__((ext_vector_type(4)));
typedef GAS unsigned gu32;
typedef GAS unsigned long long gu64;
#define RLX_AGENT __ATOMIC_RELAXED, __HIP_MEMORY_SCOPE_AGENT
#define LDS_WAIT() asm volatile("s_waitcnt lgkmcnt(0)" ::: "memory")
#define VM_WAIT() asm volatile("s_waitcnt vmcnt(0)" ::: "memory")
__device__ __forceinline__ void glds16(const void* gsrc, unsigned lds_dst) { unsigned keep; const unsigned dst = (unsigned)__builtin_amdgcn_readfirstlane((int)lds_dst);
    asm volatile("s_mov_b32 %0, m0\n\ts_mov_b32 m0, %2\n\ts_nop 0\n\tglobal_load_lds_dwordx4 %1, off\n\ts_mov_b32 m0, %0" : "=&s"(keep) : "v"(gsrc), "s"(dst) : "memory"); }
__device__ __forceinline__ void glds16s(const void* sbase, unsigned voff, unsigned lds_dst) { unsigned keep; const unsigned dst = (unsigned)__builtin_amdgcn_readfirstlane((int)lds_dst);
    const unsigned long long b = (unsigned long long)sbase; const unsigned blo = (unsigned)__builtin_amdgcn_readfirstlane((int)(unsigned)b), bhi = (unsigned)__builtin_amdgcn_readfirstlane((int)(unsigned)(b >> 32));
    const unsigned long long bs = ((unsigned long long)bhi << 32) | blo;
    asm volatile("s_mov_b32 %0, m0\n\ts_mov_b32 m0, %3\n\ts_nop 0\n\tglobal_load_lds_dwordx4 %1, %2\n\ts_mov_b32 m0, %0" : "=&s"(keep) : "v"(voff), "s"(bs), "s"(dst) : "memory"); }
#define XB_TMO      128
#define XB_XCNT(j)  (256  + 64 * (j))
#define XB_XSUB(j)  (1280 + 64 * (j))
#define XB_XGEN(j)  (2304 + 64 * (j))
#define XB_TOP      3328
#define XB_TOPGEN   3392
#define XCD_BAR_WORDS 3456
#define XB_SPIN_CAP (1u << 18)

__device__ __forceinline__ unsigned xb_ld(unsigned* p)              { return __hip_atomic_load(p, __ATOMIC_RELAXED, __HIP_MEMORY_SCOPE_AGENT); }
__device__ __forceinline__ unsigned xb_add(unsigned* p, unsigned v) { return __hip_atomic_fetch_add(p, v, __ATOMIC_RELAXED, __HIP_MEMORY_SCOPE_AGENT); }
__device__ __forceinline__ unsigned xb_xcc_id() { return (unsigned)__builtin_amdgcn_s_getreg((3 << 11) | 20) & 0xFu; }
#define XB_SPIN(cond, bar) do { unsigned _sp = 0; while (cond) { __builtin_amdgcn_s_sleep(1); \
    if ((++_sp & 255u) == 0u) { if (xb_ld(&(bar)[XB_TMO])) break; if (_sp > XB_SPIN_CAP) { atomicAdd(&(bar)[XB_TMO], 1u); break; } } } } while (0)

struct XcdBarrier {
    unsigned* bar; unsigned x;
    volatile LAS unsigned* st;
};

__device__ __forceinline__ XcdBarrier xcd_barrier_post(unsigned* bar, volatile LAS unsigned* st) {
    XcdBarrier b; b.bar = bar; b.x = xb_xcc_id(); b.st = st;
    if (threadIdx.x == 0) (void)xb_add(&bar[XB_XCNT(b.x)], 1u);
    return b;
}
__device__ __forceinline__ void xcd_barrier_complete(unsigned* bar, unsigned x, unsigned& nloc, unsigned& nx) {
    const unsigned G = gridDim.x * gridDim.y * gridDim.z;
    unsigned sum, cnt, mine, sp = 0u;
    for (;;) {
        sum = 0u; cnt = 0u; mine = 0u;
#pragma unroll
        for (unsigned j = 0; j < 16; ++j) { const unsigned c = xb_ld(&bar[XB_XCNT(j)]); sum += c; cnt += (c > 0u) ? 1u : 0u; mine = (j == x) ? c : mine; }
        if (sum == G) break;
        __builtin_amdgcn_s_sleep(1);
        if ((++sp & 255u) == 0u) { if (xb_ld(&bar[XB_TMO])) break; if (sp > XB_SPIN_CAP) { atomicAdd(&bar[XB_TMO], 1u); break; } }
    }
    nloc = mine > 0u ? mine : 1u; nx = cnt > 0u ? cnt : 1u;
}

__device__ __forceinline__ void xcd_barrier(const XcdBarrier& b) {
    asm volatile("s_waitcnt vmcnt(0)" ::: "memory");
    __syncthreads();
    if (threadIdx.x == 0) {
        unsigned* bar = b.bar;
        __builtin_amdgcn_s_waitcnt(0);
        unsigned nloc = b.st[0], nx = b.st[1];
        if (nloc == 0u) { xcd_barrier_complete(bar, b.x, nloc, nx); b.st[0] = nloc; b.st[1] = nx; }
        const unsigned old = xb_add(&bar[XB_XSUB(b.x)], 1u);
        const unsigned gen = old / nloc;
        if (old + 1u == (gen + 1u) * nloc) {
            __builtin_amdgcn_fence(__ATOMIC_RELEASE, "agent");
            asm volatile("s_waitcnt vmcnt(0)" ::: "memory");
            const unsigned og = xb_add(&bar[XB_TOP], 1u);
            const unsigned tg = og / nx;
            if (og + 1u == (tg + 1u) * nx) xb_add(&bar[XB_TOPGEN], 1u);
            else XB_SPIN(xb_ld(&bar[XB_TOPGEN]) == tg, bar);
            __builtin_amdgcn_fence(__ATOMIC_ACQUIRE, "agent");
            xb_add(&bar[XB_XGEN(b.x)], 1u);
            asm volatile("s_waitcnt vmcnt(0)" ::: "memory");
        } else {
            XB_SPIN(xb_ld(&bar[XB_XGEN(b.x)]) == gen, bar);
            __builtin_amdgcn_fence(__ATOMIC_ACQUIRE, "agent");
            asm volatile("s_waitcnt vmcnt(0)" ::: "memory");
        }
    }
    __syncthreads();
}

struct Args { const float* in[13]; float* out; unsigned char* ws; int ph_lo, ph_hi, li, dup_phase, dup_reps, dup_sub; };
struct Frame {
    LAS unsigned char* lds; volatile LAS unsigned* MISC; gu32* ctl;
    int tid, lane, wave, vcu, G;
};
__device__ __forceinline__ float wave_sum(float v) {
#pragma unroll
    for (int o = 1; o < 64; o <<= 1) v += __shfl_xor(v, o);
    return v;
}
__device__ __forceinline__ void p0_transpose_item(const float* W, int K, int N, bf16* WT, LAS float* scr, int item, int lane) {
    const int nblk = N / 32, kb = item / nblk, nb = item % nblk, k0 = 64 * kb, n0 = 32 * nb;
#pragma unroll 8
    for (int i = 0; i < 32; ++i) { const int kk = 2 * i + (lane >> 5); scr[kk * 33 + (lane & 31)] = W[(size_t)(k0 + kk) * N + n0 + (lane & 31)]; }
    LDS_WAIT(); asm volatile("" ::: "memory");
    const int c = lane & 7;
#pragma unroll
    for (int j = 0; j < 4; ++j) { const int n = (lane >> 3) + 8 * j; const LAS float* s = scr + (8 * c) * 33 + n;
        v4u o; o.x = pk2(s[0 * 33], s[1 * 33]); o.y = pk2(s[2 * 33], s[3 * 33]); o.z = pk2(s[4 * 33], s[5 * 33]); o.w = pk2(s[6 * 33], s[7 * 33]);
        *(GAS v4u*)(WT + (size_t)(n0 + n) * K + k0 + 8 * c) = o; }
    LDS_WAIT(); asm volatile("" ::: "memory");
}
__device__ __forceinline__ void p0_mod(Frame& F, const Args& a) {
    const float* c = a.in[1]; const float* w_cond = a.in[2]; const float* b_cond = a.in[3];
    float* mod = (float*)(a.ws + WS_MOD);
    if (F.vcu < 192) {
        LAS float* sc = (LAS float*)(F.lds);
        LAS float* red = (LAS float*)(F.lds + 32768);
        for (int i = F.tid; i < 4 * DM; i += NWAVES * 64) sc[i] = silu_f(c[i]);
        __syncthreads();
        const int cg = F.lane & 7, kr = F.lane >> 3, n0 = 32 * F.vcu + 4 * cg;
        f32x4 acc[4];
#pragma unroll
        for (int b = 0; b < 4; ++b) acc[b] = (f32x4){0.f, 0.f, 0.f, 0.f};
#pragma unroll 8
        for (int it = 0; it < 32; ++it) { const int k = 256 * F.wave + 8 * it + kr;
            const f32x4 w = *(const GAS f32x4*)(w_cond + (size_t)k * (3 * DM) + n0);
#pragma unroll
            for (int b = 0; b < 4; ++b) acc[b] += w * sc[b * DM + k]; }
#pragma unroll
        for (int b = 0; b < 4; ++b)
#pragma unroll
            for (int e = 0; e < 4; ++e) { float v = acc[b][e]; v += __shfl_xor(v, 8); v += __shfl_xor(v, 16); v += __shfl_xor(v, 32); acc[b][e] = v; }
        if (kr == 0) {
#pragma unroll
            for (int b = 0; b < 4; ++b) *(LAS f32x4*)(red + (F.wave * 4 + b) * 32 + 4 * cg) = acc[b]; }
        __syncthreads();
        if (F.tid < 128) { const int b = F.tid >> 5, col = F.tid & 31; float s = b_cond[32 * F.vcu + col];
#pragma unroll
            for (int w = 0; w < 8; ++w) s += red[(w * 4 + b) * 32 + col];
            mod[b * 3 * DM + 32 * F.vcu + col] = s; }
        __syncthreads();
    }
}
__device__ __forceinline__ void p1_weights(Frame& F, const Args& a) {
    LAS float* scr = (LAS float*)(F.lds + RING_OFF + F.wave * 16384);
    const int gw = F.vcu * NWAVES + F.wave, NGW = F.G * NWAVES;
    bf16* wint = (bf16*)(a.ws + WS_WINT); bf16* woutt = (bf16*)(a.ws + WS_WOUTT);
    constexpr int I_IN = (DM / 64) * (NPROJ / 32), I_OUT = (DM / 64) * (DM / 32);
    for (int it = gw; it < I_IN + I_OUT; it += NGW) {
        if (it < I_IN) p0_transpose_item(a.in[4], DM, NPROJ, wint, scr, it, F.lane);
        else p0_transpose_item(a.in[11], DM, DM, woutt, scr, it - I_IN, F.lane);
    }
}
__device__ __forceinline__ void p1_h(Frame& F, const Args& a) {
    const float* x = a.in[0]; const float* mod = (const float*)(a.ws + WS_MOD); bf16* h = (bf16*)(a.ws + WS_H);
    const int gw = F.vcu * NWAVES + F.wave, NGW = F.G * NWAVES;
    for (int blk = gw; blk < T / 16; blk += NGW) {
        const int b = (blk * 16) / SEQ;
        const GAS f32x4* shp = (const GAS f32x4*)(mod + b * 3 * DM) + F.lane; const GAS f32x4* scp = (const GAS f32x4*)(mod + b * 3 * DM + DM) + F.lane;
        f32x4 sh[8], sc[8];
#pragma unroll
        for (int j = 0; j < 8; ++j) { sh[j] = shp[64 * j]; sc[j] = scp[64 * j] + 1.0f; }
        for (int r = 0; r < 16; ++r) { const int m = blk * 16 + r;
            const GAS f32x4* xr = (const GAS f32x4*)(x + (size_t)m * DM) + F.lane;
            f32x4 v[8]; float s = 0.f;
#pragma unroll
            for (int j = 0; j < 8; ++j) { v[j] = __builtin_nontemporal_load(xr + 64 * j); s += (v[j].x * v[j].x + v[j].y * v[j].y) + (v[j].z * v[j].z + v[j].w * v[j].w); }
            const float rs = rsqrtf(wave_sum(s) * (1.f / DM) + EPS);
            GAS unsigned long long* o8 = (GAS unsigned long long*)(h + (size_t)m * DM) + F.lane;
#pragma unroll
            for (int j = 0; j < 8; ++j) { const f32x4 o = v[j] * rs * sc[j] + sh[j];
                o8[64 * j] = (unsigned long long)pk2(o.x, o.y) | ((unsigned long long)pk2(o.z, o.w) << 32); } }
    }
}
__device__ __forceinline__ void lr_tail(Frame& F, const Args& a) {
    const bf16* h = (const bf16*)(a.ws + WS_H); const unsigned char* wl = a.ws + WS_WINT + (size_t)7168 * DM * 2; float* lr = (float*)(a.ws + WS_LR);
    constexpr int WROW = 4096 + 32;
    for (int i = F.tid; i < 32 * 256; i += NWAVES * 64) { const int r = i >> 8, c = i & 255; *(LAS v4u*)(F.lds + r * WROW + c * 16) = *(const GAS v4u*)(wl + (size_t)r * 4096 + c * 16); }
    __syncthreads();
    const int gw = F.vcu * NWAVES + F.wave, NGW = F.G * NWAVES, li = F.lane & 15, g = F.lane >> 4;
    const LAS unsigned char* bp0 = F.lds + li * WROW + g * 16; const LAS unsigned char* bp1 = bp0 + 16 * WROW;
    for (int rb = gw; rb < T / 16; rb += NGW) {
        const bf16* ap = h + (size_t)(rb * 16 + li) * DM + 8 * g;
        f32x4 c0 = (f32x4){0.f, 0.f, 0.f, 0.f}, c1 = c0;
        bf16x8 avA[16], avB[16];
#define LRLOAD(D, kb) do { _Pragma("unroll") for (int i_ = 0; i_ < 16; ++i_) D[i_] = *(const GAS bf16x8*)(ap + 32 * (16 * (kb) + i_)); } while (0)
#define LRMMA(D, kb) do { _Pragma("unroll") for (int i_ = 0; i_ < 16; ++i_) { const bf16x8 b0_ = *(const LAS bf16x8*)(bp0 + 64 * (16 * (kb) + i_)), b1_ = *(const LAS bf16x8*)(bp1 + 64 * (16 * (kb) + i_)); \
            c0 = __builtin_amdgcn_mfma_f32_16x16x32_bf16(D[i_], b0_, c0, 0, 0, 0); c1 = __builtin_amdgcn_mfma_f32_16x16x32_bf16(D[i_], b1_, c1, 0, 0, 0); } } while (0)
        LRLOAD(avA, 0); __builtin_amdgcn_sched_barrier(0); LRLOAD(avB, 1); __builtin_amdgcn_sched_barrier(0); LRMMA(avA, 0); __builtin_amdgcn_sched_barrier(0);
        LRLOAD(avA, 2); __builtin_amdgcn_sched_barrier(0); LRMMA(avB, 1); __builtin_amdgcn_sched_barrier(0); LRLOAD(avB, 3); __builtin_amdgcn_sched_barrier(0);
        LRMMA(avA, 2); __builtin_amdgcn_sched_barrier(0); LRMMA(avB, 3); __builtin_amdgcn_sched_barrier(0);
#undef LRLOAD
#undef LRMMA
#pragma unroll
        for (int rg = 0; rg < 4; ++rg) { float* o = lr + (size_t)(rb * 16 + 4 * g + rg) * 32 + li; o[0] = c0[rg]; o[16] = c1[rg]; }
    }
    __syncthreads();
}
__device__ __forceinline__ void unpack8(const v4u w, float (&f)[8]) {
    f[0] = __builtin_bit_cast(float, w.x << 16); f[1] = __builtin_bit_cast(float, w.x & 0xffff0000u); f[2] = __builtin_bit_cast(float, w.y << 16); f[3] = __builtin_bit_cast(float, w.y & 0xffff0000u);
    f[4] = __builtin_bit_cast(float, w.z << 16); f[5] = __builtin_bit_cast(float, w.z & 0xffff0000u); f[6] = __builtin_bit_cast(float, w.w << 16); f[7] = __builtin_bit_cast(float, w.w & 0xffff0000u);
}
__device__ __forceinline__ v4u pack8(const float (&f)[8]) { v4u w; w.x = pk2(f[0], f[1]); w.y = pk2(f[2], f[3]); w.z = pk2(f[4], f[5]); w.w = pk2(f[6], f[7]); return w; }
__device__ __forceinline__ void p5_combine(Frame& F, const Args& a) {
    const bf16* op = (const bf16*)(a.ws + WS_OP); const float* lse = (const float*)(a.ws + WS_LSE); const bf16* sag = (const bf16*)(a.ws + WS_SAG);
    const bf16* of = (const bf16*)(a.ws + WS_OF); const bf16* ob = (const bf16*)(a.ws + WS_OB); const bf16* sgg = (const bf16*)(a.ws + WS_SGG); const float* gain = a.in[9];
    bf16* cat = (bf16*)(a.ws + WS_H);
    const int gw = F.vcu * NWAVES + F.wave, NGW = F.G * NWAVES, lane = F.lane;
    float gn[16];
#pragma unroll
    for (int j = 0; j < 4; ++j) { const f32x4 g = *(const GAS f32x4*)(gain + 16 * lane + 4 * j); gn[4 * j] = g.x; gn[4 * j + 1] = g.y; gn[4 * j + 2] = g.z; gn[4 * j + 3] = g.w; }
    for (int t = gw; t < T; t += NGW) {
        const size_t e = (size_t)t * 1024 + 16 * lane; const int hh = lane >> 2;
        const float l0 = lse[(size_t)t * 16 + hh], l1 = lse[(size_t)T * 16 + (size_t)t * 16 + hh], l2 = lse[(size_t)2 * T * 16 + (size_t)t * 16 + hh];
        const float mx = fmaxf(l0, fmaxf(l1, l2)); float w0 = exp2f(l0 - mx), w1 = exp2f(l1 - mx), w2 = exp2f(l2 - mx); const float wi = 1.f / (w0 + w1 + w2); w0 *= wi; w1 *= wi; w2 *= wi;
#pragma unroll
        for (int hf = 0; hf < 2; ++hf) { float p0[8], p1[8], p2[8], g[8], o[8];
            unpack8(*(const GAS v4u*)(op + e + 8 * hf), p0); unpack8(*(const GAS v4u*)(op + (size_t)T * 1024 + e + 8 * hf), p1); unpack8(*(const GAS v4u*)(op + (size_t)2 * T * 1024 + e + 8 * hf), p2);
            unpack8(*(const GAS v4u*)(sag + e + 8 * hf), g);
#pragma unroll
            for (int i = 0; i < 8; ++i) o[i] = (w0 * p0[i] + w1 * p1[i] + w2 * p2[i]) * g[i];
            *(GAS v4u*)(cat + (size_t)t * 2048 + 16 * lane + 8 * hf) = pack8(o); }
        float xv[16], ss = 0.f;
#pragma unroll
        for (int hf = 0; hf < 2; ++hf) { float f[8], b[8]; unpack8(*(const GAS v4u*)(of + e + 8 * hf), f); unpack8(*(const GAS v4u*)(ob + e + 8 * hf), b);
#pragma unroll
            for (int i = 0; i < 8; ++i) { xv[8 * hf + i] = f[i] + b[i]; ss += xv[8 * hf + i] * xv[8 * hf + i]; } }
        ss += __shfl_xor(ss, 1); ss += __shfl_xor(ss, 2); ss += __shfl_xor(ss, 4); ss += __shfl_xor(ss, 8);
        const float r = rsqrtf(ss * (1.f / 256.f) + EPS);
#pragma unroll
        for (int hf = 0; hf < 2; ++hf) { float g[8], o[8]; unpack8(*(const GAS v4u*)(sgg + e + 8 * hf), g);
#pragma unroll
            for (int i = 0; i < 8; ++i) o[i] = xv[8 * hf + i] * r * gn[8 * hf + i] * g[i];
            *(GAS v4u*)(cat + (size_t)t * 2048 + 1024 + 16 * lane + 8 * hf) = pack8(o); }
    }
}
__device__ __forceinline__ void p7_final(Frame& F, const Args& a) {
    float* out = a.out; const float* x = a.in[0]; const float* fg = a.in[12]; const float* mod = (const float*)(a.ws + WS_MOD); const bf16* Y = (const bf16*)(a.ws + WS_Y);
    const int gw = F.vcu * NWAVES + F.wave, NGW = F.G * NWAVES;
    f32x4 g[8];
#pragma unroll
    for (int j = 0; j < 8; ++j) g[j] = *((const GAS f32x4*)fg + F.lane + 64 * j);
    for (int blk = gw; blk < T / 16; blk += NGW) {
        const int b = (blk * 16) / SEQ;
        f32x4 gt[8];
#pragma unroll
        for (int j = 0; j < 8; ++j) gt[j] = *((const GAS f32x4*)(mod + b * 3 * DM + 2 * DM) + F.lane + 64 * j);
        for (int r = 0; r < 16; ++r) { const int m = blk * 16 + r;
            const GAS f32x4* xr = (const GAS f32x4*)(x + (size_t)m * DM) + F.lane; const GAS v2u* yr = (const GAS v2u*)(Y + (size_t)m * DM) + F.lane;
            f32x4 v[8]; float s = 0.f;
#pragma unroll
            for (int j = 0; j < 8; ++j) { const f32x4 xv = __builtin_nontemporal_load(xr + 64 * j); const v2u yw = __builtin_nontemporal_load(yr + 64 * j);
                const f32x4 yv = (f32x4){__builtin_bit_cast(float, yw.x << 16), __builtin_bit_cast(float, yw.x & 0xffff0000u), __builtin_bit_cast(float, yw.y << 16), __builtin_bit_cast(float, yw.y & 0xffff0000u)};
                v[j] = xv + gt[j] * yv; s += (v[j].x * v[j].x + v[j].y * v[j].y) + (v[j].z * v[j].z + v[j].w * v[j].w); }
            const float rs = rsqrtf(wave_sum(s) * (1.f / DM) + EPS);
            GAS f32x4* orow = (GAS f32x4*)(out + (size_t)m * DM) + F.lane;
#pragma unroll
            for (int j = 0; j < 8; ++j) orow[64 * j] = v[j] * rs * g[j]; }
    }
}

namespace att {
constexpr int KCH = 384 * 16, VDH = 384 * 64, K_OFF = 0, V_OFF = 8 * KCH, VBUF = 2 * VDH, BIAS_OFF = V_OFF + 2 * VBUF, BCOPY = 832, RB_OFF = BIAS_OFF + 4 * BCOPY, ATT_LDS = RB_OFF + 2048;
static_assert(ATT_LDS <= RING_BYTES && (V_OFF % 1024) == 0 && (BIAS_OFF % 16) == 0, "attention LDS map");
constexpr int NUNITS = BATCH * 16 * 3 * 32;
__device__ __forceinline__ int crow(int r, int hi) { return (r & 3) + 8 * (r >> 2) + 4 * hi; }
typedef short v4i16_t __attribute__((ext_vector_type(4)));
__device__ __forceinline__ s16x4 vtr(const LAS unsigned char* p) { return __builtin_bit_cast(s16x4, __builtin_amdgcn_ds_read_tr16_b64_v4i16((LAS v4i16_t*)p)); }
__device__ __forceinline__ unsigned cvtpk(float lo, float hi) { typedef float f2 __attribute__((ext_vector_type(2))); typedef __bf16 b2 __attribute__((ext_vector_type(2))); f2 v = {lo, hi}; b2 b = __builtin_convertvector(v, b2); return __builtin_bit_cast(unsigned, b); }
#define ATT_BAR() asm volatile("s_waitcnt lgkmcnt(0)\n\ts_barrier" ::: "memory")

struct UnitGeo { int b, h, p, d, r, L, m0; unsigned rowb; size_t base; };
__device__ __forceinline__ UnitGeo decode(int uid) {
    UnitGeo u; const int bh = uid / 96, w96 = uid % 96, rs = w96 & 31; u.p = w96 >> 5; u.b = bh >> 4; u.h = bh & 15;
    u.d = (u.p == 0) ? 1 : (u.p == 1 ? 4 : 16);
    u.r = (u.p == 0) ? 0 : (u.p == 1 ? (rs >> 3) : (rs >> 1)); const int seg = (u.p == 0) ? rs : (u.p == 1 ? (rs & 7) : (rs & 1));
    u.L = SEQ / u.d; u.m0 = seg * 256; u.rowb = (unsigned)u.d * 2048u; u.base = ((size_t)u.b * SEQ + u.r) * 2048 + u.h * 128; return u;
}
__device__ __forceinline__ void dma_k(const Args& a, const UnitGeo& u, LAS unsigned char* lds, int wid, int lane) {
    const unsigned char* Kb = a.ws + WS_AK + u.base + (lane >> 3) * 16; const unsigned rowb = u.rowb;
#pragma unroll
    for (int j = 0; j < 6; ++j) { const int blk = wid + 8 * j; int m = u.m0 - 64 + 8 * blk + (lane & 7); m = m < 0 ? 0 : (m > u.L - 1 ? u.L - 1 : m);
        glds16(Kb + (size_t)m * rowb, (unsigned)(size_t)lds + K_OFF + blk * 1024); }
}
__device__ __forceinline__ void dma_v(const Args& a, const UnitGeo& u, LAS unsigned char* lds, int vbuf, int wid, int lane) {
    const unsigned char* Vb = a.ws + WS_AV + u.base + (lane >> 5) * 64 + (lane & 3) * 16; const unsigned rowb = u.rowb;
#pragma unroll
    for (int j = 0; j < 6; ++j) { const int blk = wid + 8 * j; int m = u.m0 - 64 + 8 * blk + ((lane >> 2) & 7); m = m < 0 ? 0 : (m > u.L - 1 ? u.L - 1 : m);
        glds16(Vb + (size_t)m * rowb, (unsigned)(size_t)lds + V_OFF + vbuf * VBUF + blk * 1024); }
}
__device__ __forceinline__ void load_q(bf16x8 (&q)[4], const Args& a, const UnitGeo& u, int wid, int r32, int hi) {
    const unsigned char* Qb = a.ws + WS_AQ + u.base + (size_t)(u.m0 + 32 * wid + r32) * u.rowb + hi * 16;
    asm volatile("global_load_dwordx4 %0, %1, off" : "=&v"(q[0]) : "v"(Qb) : "memory");
    asm volatile("global_load_dwordx4 %0, %1, off offset:32" : "=&v"(q[1]) : "v"(Qb) : "memory");
    asm volatile("global_load_dwordx4 %0, %1, off offset:64" : "=&v"(q[2]) : "v"(Qb) : "memory");
    asm volatile("global_load_dwordx4 %0, %1, off offset:96" : "=&v"(q[3]) : "v"(Qb) : "memory");
}
__device__ __forceinline__ void write_bias(const Args& a, const UnitGeo& u, LAS unsigned char* lds, int tid) {
    for (int e = tid; e < 4 * 192; e += 512) { const int s = e / 192, i = e % 192, sp = i + s - 95;
        *(LAS float*)(lds + BIAS_OFF + s * BCOPY + i * 4) = (sp >= -64 && sp <= 64) ? ((const LAS float*)(lds + RB_OFF))[t5_bucket(sp * u.d) * 16 + u.h] : -1e30f; }
}
#define DECODE(x) decode(unit_of(x))
__device__ __forceinline__ UnitGeo decode_p(int uid, bool contig) { UnitGeo u = decode(uid); if (contig) { u.rowb = 128u; u.base = (size_t)(uid / 96) * SEQ * 128 + (size_t)((uid % 96) >> 5) * 16 * 2048; } return u; }
__device__ __forceinline__ void attn_phase(Frame& F, const Args& a, int c, int ncu, const int knobs = 0) {
    const bool nodma = knobs & 1, nomath = knobs & 2, nostore = knobs & 4, noq = knobs & 16;
    if (c < 0 || c >= ncu) return;
    const bool coop = (ncu == 192);
    const int per = coop ? 32 : (NUNITS + ncu - 1) / ncu, u0 = coop ? 0 : c * per, u1 = coop ? 32 : ((u0 + per < NUNITS) ? u0 + per : NUNITS);
    if (u0 >= u1) return;
    const int cx = c / 24, cj = c % 24;
    auto unit_of = [&](int i) -> int { return coop ? ((8 * cx + (i >> 2)) * 96 + cj + 24 * (i & 3)) : i; };
    LAS unsigned char* lds = F.lds;
    const int tid = F.tid, lane = F.lane, wid = F.wave, r32 = lane & 31, hi = lane >> 5;
    UnitGeo cur = DECODE(u0);
    __builtin_amdgcn_s_waitcnt(0);
    asm volatile("s_waitcnt vmcnt(0) lgkmcnt(0)\n\ts_barrier" ::: "memory");
    ((LAS float*)(lds + RB_OFF))[tid] = a.in[10][tid] * LOG2E;
    asm volatile("s_waitcnt vmcnt(0) lgkmcnt(0)\n\ts_barrier" ::: "memory");
    dma_k(a, cur, lds, wid, lane); dma_v(a, cur, lds, 0, wid, lane); write_bias(a, cur, lds, tid);
    bf16x8 qr[4]; load_q(qr, a, cur, wid, r32, hi);
    int vb = 0;
    float* pl = nullptr; float plv = 0.f; GAS unsigned char* po = nullptr; size_t postep = 0; v4u pov[4] = {};
    const int e31 = 31 - r32;
    const LAS unsigned char* bias_b = lds + BIAS_OFF + (e31 & 3) * BCOPY + ((e31 >> 2) + hi) * 16;
    const LAS unsigned char* kb0 = lds + K_OFF + (4 * wid + (r32 >> 3)) * 1024 + hi * 128 + (r32 & 7) * 16;
    for (int uid = u0; uid < u1; ++uid) {
        asm volatile("s_waitcnt vmcnt(0) lgkmcnt(0)\n\ts_barrier" : "+v"(qr[0]), "+v"(qr[1]), "+v"(qr[2]), "+v"(qr[3]) :: "memory");
        if (uid != u0 && !nostore) {
            if (hi == 0) *pl = plv;
#pragma unroll
            for (int i = 0; i < 4; ++i) *(GAS v4u*)(po + i * postep) = pov[i]; }
        const bool has_next = uid + 1 < u1; UnitGeo nxt = cur;
        if (has_next) { nxt = DECODE(uid + 1); if (!nodma) dma_v(a, nxt, lds, vb ^ 1, wid, lane); }
        const int b = cur.b, h = cur.h, d = cur.d, r = cur.r, L = cur.L, m0 = cur.m0;
        {
        f32x16 pS[5];
#define SB() __builtin_amdgcn_sched_barrier(0)
#define LOADKB(KF, kb) do { _Pragma("unroll") for (int k_ = 0; k_ < 4; ++k_) { const f32x4 t_ = *(const LAS f32x4*)(bias_b + 32 * k_ + 128 * (kb)); pS[kb][4 * k_] = t_.x; pS[kb][4 * k_ + 1] = t_.y; pS[kb][4 * k_ + 2] = t_.z; pS[kb][4 * k_ + 3] = t_.w; } \
                            _Pragma("unroll") for (int d_ = 0; d_ < 4; ++d_) KF[d_] = *(const LAS bf16x8*)(kb0 + d_ * 256 + (kb) * 4096); } while (0)
#define MMAKB(KF, kb) do { _Pragma("unroll") for (int d_ = 0; d_ < 4; ++d_) pS[kb] = __builtin_amdgcn_mfma_f32_32x32x16_bf16(KF[d_], qr[d_], pS[kb], 0, 0, 0); } while (0)
        { bf16x8 ka[4], kc[4];
          LOADKB(ka, 0); SB(); LOADKB(kc, 1); SB(); MMAKB(ka, 0); SB(); LOADKB(ka, 2); SB(); MMAKB(kc, 1); SB(); LOADKB(kc, 3); SB(); MMAKB(ka, 2); SB(); LOADKB(ka, 4); SB(); MMAKB(kc, 3); SB(); MMAKB(ka, 4); SB(); }
#undef LOADKB
#undef MMAKB
        {
        ATT_BAR();
        if (has_next) { if (!nodma) dma_k(a, nxt, lds, wid, lane); if (nxt.p != cur.p || nxt.h != cur.h) write_bias(a, nxt, lds, tid); if (!noq) load_q(qr, a, nxt, wid, r32, hi); }
        }
        const int mb = m0 - 64 + 32 * wid;
        if (mb < 0 || mb + 160 > L) {
            const int mbl = mb + 4 * hi;
#pragma unroll
            for (int kb = 0; kb < 5; ++kb)
#pragma unroll
                for (int rg = 0; rg < 16; ++rg) { const int kr0 = 32 * kb + crow(rg, 0); pS[kb][rg] = ((unsigned)(mbl + kr0) < (unsigned)L) ? pS[kb][rg] : -1e30f; }
        }
        float mx = -1e30f;
#pragma unroll
        for (int kb = 0; kb < 5; ++kb)
#pragma unroll
            for (int rg = 0; rg < 16; rg += 2) mx = fmaxf(fmaxf(mx, pS[kb][rg]), pS[kb][rg + 1]);
        mx = fmaxf(mx, __shfl_xor(mx, 32));
        float l = 0.f;
#pragma unroll
        for (int kb = 0; kb < 5; ++kb)
#pragma unroll
            for (int rg = 0; rg < 16; ++rg) { const float e = __builtin_amdgcn_exp2f(pS[kb][rg] - mx); pS[kb][rg] = e; l += e; }
        l += __shfl_xor(l, 32);
        f32x16 o[2];
        o[0] = (f32x16){0.f, 0.f, 0.f, 0.f, 0.f, 0.f, 0.f, 0.f, 0.f, 0.f, 0.f, 0.f, 0.f, 0.f, 0.f, 0.f}; o[1] = o[0];
        const LAS unsigned char* vb0 = lds + V_OFF + vb * VBUF + (4 * wid) * 1024 + (4 * hi + ((lane & 15) >> 2)) * 64 + ((lane >> 4) & 1) * 32 + (lane & 3) * 8;
#define LOADV(VF, kb) do { _Pragma("unroll") for (int s_ = 0; s_ < 2; ++s_) _Pragma("unroll") for (int d_ = 0; d_ < 2; ++d_) { \
            const s16x4 lo_ = vtr(vb0 + d_ * 512 + (2 * (kb) + s_) * 2048), hh_ = vtr(vb0 + d_ * 512 + (2 * (kb) + s_) * 2048 + 1024); \
            VF[s_ * 2 + d_] = (bf16x8){lo_[0], lo_[1], lo_[2], lo_[3], hh_[0], hh_[1], hh_[2], hh_[3]}; } } while (0)
#define MMAV(VF, kb) do { _Pragma("unroll") for (int s_ = 0; s_ < 2; ++s_) { v4u pw_; pw_.x = cvtpk(pS[kb][8 * s_ + 0], pS[kb][8 * s_ + 1]); pw_.y = cvtpk(pS[kb][8 * s_ + 2], pS[kb][8 * s_ + 3]); \
            pw_.z = cvtpk(pS[kb][8 * s_ + 4], pS[kb][8 * s_ + 5]); pw_.w = cvtpk(pS[kb][8 * s_ + 6], pS[kb][8 * s_ + 7]); const bf16x8 pa_ = __builtin_bit_cast(bf16x8, pw_); \
            _Pragma("unroll") for (int d_ = 0; d_ < 2; ++d_) o[d_] = __builtin_amdgcn_mfma_f32_32x32x16_bf16(VF[s_ * 2 + d_], pa_, o[d_], 0, 0, 0); } } while (0)
        { bf16x8 va[4], vc[4];
          LOADV(va, 0); SB(); LOADV(vc, 1); SB(); MMAV(va, 0); SB(); LOADV(va, 2); SB(); MMAV(vc, 1); SB(); LOADV(vc, 3); SB(); MMAV(va, 2); SB(); LOADV(va, 4); SB(); MMAV(vc, 3); SB(); MMAV(va, 4); SB(); }
#undef LOADV
#undef MMAV
#undef SB
        const float li = 1.f / l;
        const size_t tq = (size_t)b * SEQ + (size_t)(m0 + 32 * wid + r32) * d + r;
        {
        pl = (float*)(a.ws + WS_LSE) + (size_t)cur.p * T * 16 + tq * 16 + h; plv = mx + __builtin_amdgcn_logf(l);
        ATT_BAR();
        LAS unsigned char* stg = lds + V_OFF + vb * VBUF + wid * (32 * 144);
#pragma unroll
        for (int d0 = 0; d0 < 2; ++d0)
#pragma unroll
            for (int k = 0; k < 4; ++k)
                *(LAS v2u*)(stg + r32 * 144 + (32 * d0 + 8 * k + 4 * hi) * 2) = (v2u){cvtpk(o[d0][4 * k] * li, o[d0][4 * k + 1] * li), cvtpk(o[d0][4 * k + 2] * li, o[d0][4 * k + 3] * li)};
        LDS_WAIT();
        { const int row = lane >> 3, ch = lane & 7;
          po = (GAS unsigned char*)(a.ws + WS_OP) + ((size_t)cur.p * T + (size_t)b * SEQ + (size_t)(m0 + 32 * wid + row) * d + r) * 2048 + h * 128 + ch * 16; postep = (size_t)8 * d * 2048;
#pragma unroll
          for (int i = 0; i < 4; ++i) pov[i] = *(const LAS v4u*)(stg + (row + 8 * i) * 144 + ch * 16); }
        LDS_WAIT();
        }
        }
        vb ^= 1; cur = nxt;
    }
    { if (hi == 0) *pl = plv;
#pragma unroll
        for (int i = 0; i < 4; ++i) *(GAS v4u*)(po + i * postep) = pov[i]; }
    asm volatile("s_waitcnt vmcnt(0) lgkmcnt(0)\n\ts_barrier" ::: "memory");
}
#undef ATT_BAR
}
namespace gla {
constexpr int PACK_QK = 32768, PACK_ATT = 9216;
constexpr float DKS = 0.08838834764831845f;
__device__ __forceinline__ unsigned cvtpk(float lo, float hi) { typedef float f2 __attribute__((ext_vector_type(2))); typedef __bf16 b2 __attribute__((ext_vector_type(2))); f2 v = {lo, hi}; b2 b = __builtin_convertvector(v, b2); return __builtin_bit_cast(unsigned, b); }
__device__ __forceinline__ int idx32(int g, int jj) { return 16 * (jj >> 2) + 4 * g + (jj & 3); }
__device__ __forceinline__ float fexp(float x) { return __builtin_amdgcn_exp2f(x * LOG2E); }
__device__ __forceinline__ float logsig16(float x) { return (fminf(x, 0.f) - __builtin_amdgcn_logf(1.f + fexp(-fabsf(x))) * 0.6931471805599453f) * (1.f / 16.f); }
typedef short v4i16_t __attribute__((ext_vector_type(4)));
__device__ __forceinline__ s16x4 vtr(const LAS unsigned char* p) { return __builtin_bit_cast(s16x4, __builtin_amdgcn_ds_read_tr16_b64_v4i16((LAS v4i16_t*)p)); }
constexpr int ROWB = 272  , GROW = 136  ;
constexpr int LRROW = 36  ;
constexpr int L_QT = 0, L_KT = 64 * ROWB, L_LR = 2 * 64 * ROWB, L_G = L_LR + 64 * LRROW * 4, L_GT = L_G + 2 * 64 * GROW * 4, L_TOT = L_GT + 4096, L_KBM = L_TOT + 1024  , L_PREP_END = L_KBM + 32768;
static_assert(L_PREP_END <= RING_BYTES, "prep LDS map");

__device__ __forceinline__ void prep_unit(Frame& F, const Args& a, int uid, const int knobs = 0) {
    const int b = uid >> 9, h = (uid >> 7) & 3, n = uid & 127; const size_t t0 = (size_t)b * SEQ + 64 * n;
    const bf16* gq = (const bf16*)(a.ws + WS_GQ); const bf16* gk = (const bf16*)(a.ws + WS_GK); const float* lr = (const float*)(a.ws + WS_LR);
    LAS unsigned char* lds = F.lds; const int tid = F.tid, lane = F.lane, wid = F.wave;
    float upb[2][4], bsv[2];
#pragma unroll
    for (int dir = 0; dir < 2; ++dir) { const float* up = a.in[dir ? 7 : 5] + h * 128 + 16 * wid + (lane & 15); bsv[dir] = a.in[dir ? 8 : 6][h * 128 + 16 * wid + (lane & 15)];
#pragma unroll
        for (int ks = 0; ks < 4; ++ks) upb[dir][ks] = up[(4 * ks + (lane >> 4)) * 512]; }
#pragma unroll
    for (int i = 0; i < 2; ++i) { const int pid = tid + 512 * i, row = pid >> 4, c16 = pid & 15; const size_t off = (t0 + row) * 512 + h * 128 + c16 * 8;
        *(LAS v4u*)(lds + L_QT + row * ROWB + c16 * 16) = *(const GAS v4u*)(gq + off); *(LAS v4u*)(lds + L_KT + row * ROWB + c16 * 16) = *(const GAS v4u*)(gk + off); }
    { const int row = tid >> 3, c16 = tid & 7; *(LAS v4u*)(lds + L_LR + row * (LRROW * 4) + c16 * 16) = *(const GAS v4u*)(lr + (t0 + row) * 32 + c16 * 4); }
    __syncthreads();
    LAS float* G = (LAS float*)(lds + L_G); LAS float* TOT = (LAS float*)(lds + L_TOT); const LAS float* LR = (const LAS float*)(lds + L_LR);
    if (!(knobs & 1)) { const int li2 = lane & 15, g2 = lane >> 4, c = 16 * wid + li2;
#pragma unroll
      for (int dir = 0; dir < 2; ++dir) { f32x4 gl[4];
#pragma unroll
          for (int mt = 0; mt < 4; ++mt) { f32x4 acc = (f32x4){0.f, 0.f, 0.f, 0.f};
#pragma unroll
              for (int ks = 0; ks < 4; ++ks) acc = __builtin_amdgcn_mfma_f32_16x16x4f32(LR[(16 * mt + li2) * LRROW + dir * 16 + 4 * ks + g2], upb[dir][ks], acc, 0, 0, 0);
#pragma unroll
              for (int rg = 0; rg < 4; ++rg) gl[mt][rg] = logsig16(acc[rg] + bsv[dir]); }
          float off = 0.f;
#pragma unroll
          for (int m2 = 0; m2 < 4; ++m2) { const int mt = dir ? 3 - m2 : m2; f32x4 p; float t;
              if (!dir) { p[0] = gl[mt][0]; p[1] = p[0] + gl[mt][1]; p[2] = p[1] + gl[mt][2]; p[3] = p[2] + gl[mt][3]; t = p[3]; }
              else      { p[3] = gl[mt][3]; p[2] = p[3] + gl[mt][2]; p[1] = p[2] + gl[mt][1]; p[0] = p[1] + gl[mt][0]; t = p[0]; }
              float sc = t, u;
              if (!dir) { u = __shfl_up(sc, 16); if (g2 >= 1) sc += u; u = __shfl_up(sc, 32); if (g2 >= 2) sc += u; }
              else      { u = __shfl_down(sc, 16); if (g2 <= 2) sc += u; u = __shfl_down(sc, 32); if (g2 <= 1) sc += u; }
              const float add = sc - t + off;
#pragma unroll
              for (int rg = 0; rg < 4; ++rg) G[(dir * 64 + 16 * mt + 4 * g2 + rg) * GROW + c] = p[rg] + add;
              off += __shfl(sc, (dir ? 0 : 48) + li2); }
          if (g2 == 0) TOT[dir * 128 + c] = off; } }
    __syncthreads();
    if (knobs & 2) { __syncthreads(); return; }
    const int dir = wid >> 2, it = wid & 3, li = lane & 15, g = lane >> 4;
    const int cid = ((b * 4 + h) * 2 + dir) * 128 + n;
    unsigned char* qk_pack = a.ws + WS_H + (size_t)cid * PACK_QK; unsigned char* att_pack = a.ws + WS_ATT + (size_t)cid * PACK_ATT;
    const LAS float* Gd = G + dir * 64 * GROW;
    auto frag = [&](int tile_off, int row, int ks, float sgn, float mul) -> bf16x8 {
        float v[8];
#pragma unroll
        for (int hf = 0; hf < 2; ++hf) { const int c = 32 * ks + 16 * hf + 4 * g;
            const v2u xw = *(const LAS v2u*)(lds + tile_off + row * ROWB + c * 2); const f32x4 bb = *(const LAS f32x4*)(Gd + row * GROW + c);
            v[4 * hf + 0] = __builtin_bit_cast(float, xw.x << 16) * fexp(sgn * bb.x) * mul; v[4 * hf + 1] = __builtin_bit_cast(float, xw.x & 0xffff0000u) * fexp(sgn * bb.y) * mul;
            v[4 * hf + 2] = __builtin_bit_cast(float, xw.y << 16) * fexp(sgn * bb.z) * mul; v[4 * hf + 3] = __builtin_bit_cast(float, xw.y & 0xffff0000u) * fexp(sgn * bb.w) * mul; }
        v4u w; w.x = cvtpk(v[0], v[1]); w.y = cvtpk(v[2], v[3]); w.z = cvtpk(v[4], v[5]); w.w = cvtpk(v[6], v[7]); return __builtin_bit_cast(bf16x8, w); };
    bf16x8 qf[4];
#pragma unroll
    for (int ks = 0; ks < 4; ++ks) { qf[ks] = frag(L_QT, 16 * it + li, ks, 1.f, DKS); *(GAS v4u*)(qk_pack + ((it * 4 + ks) * 64 + lane) * 16) = __builtin_bit_cast(v4u, qf[ks]); }
#pragma unroll
    for (int ks = 0; ks < 4; ++ks) *(LAS v4u*)(lds + L_KBM + (((dir * 4 + it) * 4 + ks) * 64 + lane) * 16) = __builtin_bit_cast(v4u, frag(L_KT, 16 * it + li, ks, -1.f, 1.f));
    __syncthreads();
    f32x4 at[4];
#pragma unroll
    for (int jt = 0; jt < 4; ++jt) { at[jt] = (f32x4){0.f, 0.f, 0.f, 0.f};
#pragma unroll
        for (int ks = 0; ks < 4; ++ks) { const bf16x8 kf = *(const LAS bf16x8*)(lds + L_KBM + (((dir * 4 + jt) * 4 + ks) * 64 + lane) * 16); at[jt] = __builtin_amdgcn_mfma_f32_16x16x32_bf16(kf, qf[ks], at[jt], 0, 0, 0); }
#pragma unroll
        for (int rg = 0; rg < 4; ++rg) { const int j = 16 * jt + 4 * g + rg, i = 16 * it + li; const bool keep = dir ? (j >= i) : (j <= i); at[jt][rg] = keep ? at[jt][rg] : 0.f; } }
#pragma unroll
    for (int ks2 = 0; ks2 < 2; ++ks2) { v4u w; w.x = cvtpk(at[2 * ks2][0], at[2 * ks2][1]); w.y = cvtpk(at[2 * ks2][2], at[2 * ks2][3]); w.z = cvtpk(at[2 * ks2 + 1][0], at[2 * ks2 + 1][1]); w.w = cvtpk(at[2 * ks2 + 1][2], at[2 * ks2 + 1][3]);
        *(GAS v4u*)(att_pack + ((it * 2 + ks2) * 64 + lane) * 16) = w; }
#pragma unroll
    for (int q2 = 0; q2 < 4; ++q2) { const int ct = 2 * it + (q2 >> 1), ks2 = q2 & 1, c = 16 * ct + li; const float te = TOT[dir * 128 + c]; float v[8];
#pragma unroll
        for (int jj = 0; jj < 8; ++jj) { const int j = 32 * ks2 + idx32(g, jj); const float kx = bf2f(*(const LAS bf16*)(lds + L_KT + j * ROWB + c * 2)); v[jj] = kx * fexp(te - Gd[j * GROW + c]); }
        v4u w; w.x = cvtpk(v[0], v[1]); w.y = cvtpk(v[2], v[3]); w.z = cvtpk(v[4], v[5]); w.w = cvtpk(v[6], v[7]);
        *(GAS v4u*)(qk_pack + 16384 + ((ct * 2 + ks2) * 64 + lane) * 16) = w; }
    if (tid < 256) { const int d2 = tid >> 7, c = tid & 127; *(float*)(a.ws + WS_ATT + (size_t)(((b * 4 + h) * 2 + d2) * 128 + n) * PACK_ATT + 8192 + c * 4) = fexp(TOT[d2 * 128 + c]); }
    __syncthreads();
}
__device__ __forceinline__ void prep_phase(Frame& F, const Args& a, int set, int c, int ncu, const int knobs = 0) {
    for (int u = c; u < 1024; u += ncu) { const int nn = u & 63, n = set == 0 ? (nn < 32 ? nn : 64 + nn) : 32 + nn; prep_unit(F, a, ((u >> 6) << 7) | n, knobs); }
}

constexpr int S_ATT = 0, S_DEC = 8192, S_QK = 9216, S_V = 9216 + 32768, S_BUF = S_V + 16384;
constexpr int S_O = 2 * S_BUF, OROW = 272, S_OT = 64 * OROW;
static_assert(S_O + 2 * S_OT <= RING_BYTES && (S_BUF % 1024) == 0, "scan LDS map");
template <class MidFn> __device__ __forceinline__ void scan_unit(Frame& F, const Args& a, int su, const MidFn& mid, const int knobs = 0) {
    const bool nodma = knobs & 1, nomath = knobs & 2, nostore = knobs & 4;
    const int bh = su >> 2, dir = (su >> 1) & 1, half = su & 1, b = bh >> 2, h = bh & 3;
    const int cid0 = ((b * 4 + h) * 2 + dir) * 128;
    LAS unsigned char* lds = F.lds; const int tid = F.tid, lane = F.lane, wid = F.wave, li = lane & 15, g = lane >> 4;
    const unsigned char* gvb = a.ws + WS_GV + (size_t)b * SEQ * 2048 + h * 512 + half * 256;
    unsigned char* ob = a.ws + (dir ? WS_OB : WS_OF) + (size_t)b * SEQ * 2048 + h * 512 + half * 256 + (size_t)(tid >> 4) * 2048 + (tid & 15) * 16;
    const int ow = (16 * wid + 4 * g) * 2 + li * OROW;
    const unsigned lds0 = (unsigned)(size_t)lds;
    int pk[8]; unsigned pvo[8], plo[8];
#pragma unroll
    for (int j = 0; j < 8; ++j) { const int p = wid + 8 * j;
        if (p < 9) { pk[j] = 0; pvo[j] = p * 1024 + lane * 16; plo[j] = S_ATT + p * 1024; }
        else if (p < 41) { pk[j] = 1; pvo[j] = (p - 9) * 1024 + lane * 16; plo[j] = S_QK + (p - 9) * 1024; }
        else if (p < 57) { const int pv = p - 41, row = 4 * pv + (lane >> 4), c = (lane & 15) ^ (2 * (row & 7)); pk[j] = 2; pvo[j] = row * 2048 + c * 16; plo[j] = S_V + pv * 1024; }
        else { pk[j] = 3; pvo[j] = 0; plo[j] = 0; } }
    auto issue = [&](int n, int bufoff) {
        const int cid = cid0 + n; const unsigned char* b0 = a.ws + WS_ATT + (size_t)cid * PACK_ATT; const unsigned char* b1 = a.ws + WS_H + (size_t)cid * PACK_QK; const unsigned char* b2 = gvb + (size_t)(64 * n) * 2048;
#pragma unroll
        for (int j = 0; j < 8; ++j) if (pk[j] != 3) glds16s(pk[j] == 0 ? b0 : (pk[j] == 1 ? b1 : b2), pvo[j], lds0 + bufoff + plo[j]);
    };
    f32x4 S[8];
#pragma unroll
    for (int ct = 0; ct < 8; ++ct) S[ct] = (f32x4){0.f, 0.f, 0.f, 0.f};
    const int vq = li >> 2, vp = li & 3;
    const int voff = (4 * g + vq) * 256 + (((2 * wid + (vp >> 1)) ^ (2 * ((4 * (g & 1) + vq)))) * 16) + 8 * (vp & 1);
    __builtin_amdgcn_s_waitcnt(0);
    auto step = [&](int s, int sb, int se) __attribute__((always_inline)) {
        const int n = dir ? 127 - s : s; const int bufoff = (s & 1) * S_BUF;
        if (!nostore && s > sb) { unsigned char* op = ob + (size_t)(64 * (dir ? n + 1 : n - 1)) * 2048; const LAS unsigned char* ot = lds + S_O + ((s - 1) & 1) * S_OT + (tid >> 4) * OROW + (tid & 15) * 16;
#pragma unroll
          for (int p = 0; p < 2; ++p) *(GAS v4u*)(op + (size_t)(32 * p) * 2048) = *(const LAS v4u*)(ot + 32 * p * OROW); }
        if (s + 1 < se && !nodma) issue(dir ? 126 - s : s + 1, S_BUF - bufoff);
        const LAS unsigned char* B = lds + bufoff;
        if (!nomath) {
        bf16x8 vf[2];
#pragma unroll
        for (int ks2 = 0; ks2 < 2; ++ks2) { const s16x4 lo = vtr(B + S_V + voff + ks2 * 8192), hh = vtr(B + S_V + voff + ks2 * 8192 + 4096); vf[ks2] = (bf16x8){lo[0], lo[1], lo[2], lo[3], hh[0], hh[1], hh[2], hh[3]}; }
        bf16x8 sf[4];
#pragma unroll
        for (int ks = 0; ks < 4; ++ks) { v4u w; w.x = cvtpk(S[2 * ks][0], S[2 * ks][1]); w.y = cvtpk(S[2 * ks][2], S[2 * ks][3]); w.z = cvtpk(S[2 * ks + 1][0], S[2 * ks + 1][1]); w.w = cvtpk(S[2 * ks + 1][2], S[2 * ks + 1][3]); sf[ks] = __builtin_bit_cast(bf16x8, w); }
#define SB() __builtin_amdgcn_sched_barrier(0)
#define LOADO(D, mt) do { _Pragma("unroll") for (int k_ = 0; k_ < 4; ++k_) D[k_] = *(const LAS bf16x8*)(B + S_QK + (((mt) * 4 + k_) * 64 + lane) * 16); \
                          _Pragma("unroll") for (int k_ = 0; k_ < 2; ++k_) D[4 + k_] = *(const LAS bf16x8*)(B + S_ATT + (((mt) * 2 + k_) * 64 + lane) * 16); } while (0)
#define MMAO(D, mt) do { f32x4 o_ = (f32x4){0.f, 0.f, 0.f, 0.f}; _Pragma("unroll") for (int k_ = 0; k_ < 4; ++k_) o_ = __builtin_amdgcn_mfma_f32_16x16x32_bf16(sf[k_], D[k_], o_, 0, 0, 0); \
                         _Pragma("unroll") for (int k_ = 0; k_ < 2; ++k_) o_ = __builtin_amdgcn_mfma_f32_16x16x32_bf16(vf[k_], D[4 + k_], o_, 0, 0, 0); *(LAS v2u*)(otile + (16 * (mt)) * OROW) = (v2u){cvtpk(o_[0], o_[1]), cvtpk(o_[2], o_[3])}; } while (0)
#define LOADS(D, V, c2) do { _Pragma("unroll") for (int k_ = 0; k_ < 4; ++k_) D[k_] = *(const LAS bf16x8*)(B + S_QK + 16384 + (((c2) * 4 + k_) * 64 + lane) * 16); \
                             V[0] = *(const LAS f32x4*)(B + S_DEC + (32 * (c2) + 4 * g) * 4); V[1] = *(const LAS f32x4*)(B + S_DEC + (32 * (c2) + 16 + 4 * g) * 4); } while (0)
#define MMAS(D, V, c2) do { _Pragma("unroll") for (int t_ = 0; t_ < 2; ++t_) { S[2 * (c2) + t_] = S[2 * (c2) + t_] * V[t_]; \
                            _Pragma("unroll") for (int k_ = 0; k_ < 2; ++k_) S[2 * (c2) + t_] = __builtin_amdgcn_mfma_f32_16x16x32_bf16(D[2 * t_ + k_], vf[k_], S[2 * (c2) + t_], 0, 0, 0); } } while (0)
        LAS unsigned char* otile = lds + S_O + (s & 1) * S_OT + ow;
        bf16x8 fa[6], fb[6]; f32x4 da[2], db[2];
        LOADO(fa, 0); SB(); LOADO(fb, 1); SB(); MMAO(fa, 0); SB(); LOADO(fa, 2); SB(); MMAO(fb, 1); SB(); LOADO(fb, 3); SB(); MMAO(fa, 2); SB();
        LOADS(fa, da, 0); SB(); MMAO(fb, 3); SB(); LOADS(fb, db, 1); SB(); MMAS(fa, da, 0); SB(); LOADS(fa, da, 2); SB(); MMAS(fb, db, 1); SB(); LOADS(fb, db, 3); SB(); MMAS(fa, da, 2); SB(); MMAS(fb, db, 3); SB();
#undef LOADO
#undef MMAO
#undef LOADS
#undef MMAS
#undef SB
        }
        asm volatile("s_waitcnt vmcnt(0) lgkmcnt(0)\n\ts_barrier" ::: "memory");
    };
    for (int seg = 0; seg < 2; ++seg) { const int sb = seg ? 32 : 0, se = seg ? 128 : 32;
        asm volatile("s_waitcnt vmcnt(0) lgkmcnt(0)\n\ts_barrier" ::: "memory");
        issue(dir ? 127 - sb : sb, (sb & 1) * S_BUF);
        asm volatile("s_waitcnt vmcnt(0) lgkmcnt(0)\n\ts_barrier" ::: "memory");
        for (int s = sb; s < se; ++s) step(s, sb, se);
        if (!nostore) { unsigned char* op = ob + (size_t)(64 * (dir ? 128 - se : se - 1)) * 2048; const LAS unsigned char* ot = lds + S_O + ((se - 1) & 1) * S_OT + (tid >> 4) * OROW + (tid & 15) * 16;
#pragma unroll
          for (int p = 0; p < 2; ++p) *(GAS v4u*)(op + (size_t)(32 * p) * 2048) = *(const LAS v4u*)(ot + 32 * p * OROW); }
        asm volatile("s_waitcnt vmcnt(0)" ::: "memory");
        if (seg == 0) mid();
    }
}
}
__global__ void __launch_bounds__(NWAVES * 64, 2) mega(Args args) {
    extern __shared__ __attribute__((aligned(16))) unsigned char lds[];
    Frame F;
    F.lds = (LAS unsigned char*)lds; F.MISC = (volatile LAS unsigned*)(F.lds + MISC_OFF);
    F.tid = threadIdx.x; F.lane = F.tid & 63; F.wave = __builtin_amdgcn_readfirstlane(F.tid >> 6);
    F.G = gridDim.x; { const int bx = blockIdx.x; F.vcu = (F.G % 8 == 0) ? (bx % 8) * (F.G / 8) + bx / 8 : bx; }
    unsigned char* ws = args.ws;
    F.ctl = (gu32*)(ws + WS_CTL);
    for (int u = F.tid; u < (LDS_BYTES - LDSCTL_OFF) / 4; u += NWAVES * 64) ((LAS unsigned*)(F.lds + LDSCTL_OFF))[u] = 0u;
    __syncthreads();
    XcdBarrier bar = xcd_barrier_post((unsigned*)(F.ctl + CW_BAR) + args.li * XCD_BAR_WORDS, F.MISC + 8);
    const int lo = args.ph_lo, hi = args.ph_hi;
#define IN(k) (lo <= (k) && (k) < hi)
#define BOTH(k) (IN(k) && IN((k) + 1))
    ProjOut P{(bf16*)(ws + WS_AQ), (bf16*)(ws + WS_AK), (bf16*)(ws + WS_AV), (bf16*)(ws + WS_SAG), (bf16*)(ws + WS_GQ), (bf16*)(ws + WS_GK), (bf16*)(ws + WS_GV), (bf16*)(ws + WS_SGG), (float*)(ws + WS_LR)};
    if (IN(0)) { p0_mod(F, args); if (BOTH(0)) xcd_barrier(bar); }
    if (IN(1)) { p1_h(F, args); p1_weights(F, args); if (BOTH(1)) xcd_barrier(bar); }
    if (IN(2)) {
        pg8::Gemm g{(const bf16*)(ws + WS_H), (const bf16*)(ws + WS_WINT), T, 7168, DM}; pg8::StaticOrder S; S.init(T, 7168, F.G, (int)blockIdx.x);
#ifdef PROBE_G2
        S.reps = 2;
#endif
        pg8::EpiProj E{P};
        pg8::gemm_phase<pg8::EpiProj, pg8::StaticOrder, true, true>(F.lds + RING_OFF, g, S, E);
        lr_tail(F, args);
        if (BOTH(2)) xcd_barrier(bar);
    }
    if (IN(3)) {
#ifdef PROBE_P
        { int q = F.vcu; asm volatile("" : "+s"(q)); gla::prep_phase(F, args, 0, q, F.G, PROBE_P); }
#endif
        gla::prep_phase(F, args, 0, F.vcu, F.G); if (BOTH(3)) xcd_barrier(bar); }
    if (IN(4)) {
        const int ac = (F.vcu >> 2) * 3 + (F.vcu & 3) - 1, anc = (F.G >> 2) * 3;
#ifdef PROBE_S
        if ((F.vcu & 3) == 0) { int q = F.vcu >> 2; asm volatile("" : "+s"(q)); gla::scan_unit(F, args, q, [&]() {}, PROBE_S); }
#endif
        if ((F.vcu & 3) == 0) gla::scan_unit(F, args, F.vcu >> 2, [&]() { xcd_barrier(bar); });
        else { gla::prep_phase(F, args, 1, ac, anc); xcd_barrier(bar);
#ifdef PROBE_A2
            { int q = ac; asm volatile("" : "+s"(q)); att::attn_phase(F, args, q, anc, PROBE_A2); }
#endif
            att::attn_phase(F, args, ac, anc);
        }
        if (BOTH(4)) xcd_barrier(bar); }
    if (IN(5)) { p5_combine(F, args); if (BOTH(5)) xcd_barrier(bar); }
    if (IN(6)) {
        pg8::Gemm g{(const bf16*)(ws + WS_H), (const bf16*)(ws + WS_WOUTT), T, DM, DM}; pg8::StaticOrder S; S.init(T, DM, F.G, (int)blockIdx.x);
#ifdef PROBE_G6
        S.reps = 2;
#endif
        pg8::EpiY E{(bf16*)(ws + WS_Y)};
        pg8::gemm_phase<pg8::EpiY, pg8::StaticOrder, true, true>(F.lds + RING_OFF, g, S, E);
        if (BOTH(6)) xcd_barrier(bar);
    }
    if (IN(7)) { p7_final(F, args); }
#undef IN
#undef BOTH
}
extern "C" void kernel_launch(void* const* d_in, const int* in_sizes, int n_in, void* d_out, int out_size, void* d_ws, size_t ws_size, hipStream_t stream) {
    static int grid = 0;
    if (grid == 0) {
        if (n_in != 13 || ws_size < WS_END || out_size != T * DM) { fprintf(stderr, "kernel_launch: unexpected problem (n_in %d, ws %zu, out %d)\n", n_in, ws_size, out_size); grid = -1; return; }
        int dev = 0, cus = 0, per_cu = 0;
        if (hipGetDevice(&dev) != hipSuccess || hipDeviceGetAttribute(&cus, hipDeviceAttributeMultiprocessorCount, dev) != hipSuccess) { grid = -1; return; }
        if (hipFuncSetAttribute((const void*)mega, hipFuncAttributeMaxDynamicSharedMemorySize, LDS_BYTES) != hipSuccess) { fprintf(stderr, "kernel_launch: hipFuncSetAttribute failed\n"); grid = -1; return; }
        if (hipOccupancyMaxActiveBlocksPerMultiprocessor(&per_cu, (const void*)mega, NWAVES * 64, LDS_BYTES) != hipSuccess || per_cu < 1) { fprintf(stderr, "kernel_launch: occupancy query says %d\n", per_cu); }
        (void)hipGetLastError();
        grid = cus;
    }
    if (grid < 0) return;
    (void)hipMemsetAsync((char*)d_ws + WS_CTL, 0, CTL_ZERO_BYTES, stream);
    Args a{};
    for (int i = 0; i < 13; ++i) a.in[i] = (const float*)d_in[i];
    a.out = (float*)d_out; a.ws = (unsigned char*)d_ws;
    unsigned char* ws = (unsigned char*)d_ws;
#ifndef PROBE_DUP
#define PROBE_DUP -1
#endif
#ifndef PROBE_REPS
#define PROBE_REPS 2
#endif
#ifndef PROBE_SUB
#define PROBE_SUB 2
#endif
    a.ph_lo = 0; a.ph_hi = 8; a.li = 0; a.dup_phase = PROBE_DUP; a.dup_reps = PROBE_REPS; a.dup_sub = PROBE_SUB;
    hipLaunchKernelGGL(mega, dim3(grid), dim3(NWAVES * 64), LDS_BYTES, stream, a);
}
```

```cpp
#include <hip/hip_runtime.h>
#include <stdint.h>
#include <cstdio>
#include <type_traits>

typedef unsigned short bf16;
constexpr int BATCH = 4, SEQ = 8192, DM = 2048, T = BATCH * SEQ;
constexpr int NPROJ = 7200, NPAD = 7424;
constexpr float EPS = 1e-6f;
constexpr float LOG2E = 1.4426950408889634f;
constexpr float C2 = 0.125f * LOG2E;
constexpr size_t MiB = 1u << 20;
constexpr size_t WS_CTL = 0, CTL_ZERO_BYTES = 1 * MiB, WS_MOD = 1 * MiB, WS_SSP = 1 * MiB + 512 * 1024  , WS_WINT = 2 * MiB, WS_WOUTT = 32 * MiB,
                 WS_H = 40 * MiB  ,
                 WS_AQ = 168 * MiB, WS_AK = 232 * MiB, WS_AV = 296 * MiB, WS_SAG = 360 * MiB, WS_GQ = 424 * MiB, WS_GK = 456 * MiB, WS_GV = 488 * MiB,
                 WS_SGG = 552 * MiB, WS_LR = 616 * MiB, WS_OP = 620 * MiB  , WS_LSE = 812 * MiB  , WS_OF = 818 * MiB, WS_OB = 882 * MiB,
                 WS_SS = 946 * MiB  , WS_ATT = 950 * MiB  ,
                 WS_Y = WS_AQ  ,
                 WS_END = 986 * MiB;

__device__ __forceinline__ unsigned f2bf(float f) { unsigned u = __builtin_bit_cast(unsigned, f); return (u + 0x7fffu + ((u >> 16) & 1u)) >> 16; }
__device__ __forceinline__ unsigned pk2(float lo, float hi) { typedef float f2_ __attribute__((ext_vector_type(2))); typedef __bf16 b2_ __attribute__((ext_vector_type(2))); f2_ v = {lo, hi}; b2_ b = __builtin_convertvector(v, b2_); return __builtin_bit_cast(unsigned, b); }
__device__ __forceinline__ float bf2f(bf16 h) { return __builtin_bit_cast(float, (unsigned)h << 16); }
__device__ __forceinline__ float silu_f(float x) { return x / (1.f + __expf(-x)); }
__device__ __forceinline__ float log_sigmoid_f(float x) { return fminf(x, 0.f) - log1pf(__expf(-fabsf(x))); }
__device__ __forceinline__ int t5_bucket(int rel) {
    const int n = rel < 0 ? -rel : rel;
    int v;
    if (n < 8) v = n;
    else v = 8 + (n >= 15) + (n >= 27) + (n >= 50) + (n >= 91) + (n >= 166) + (n >= 305) + (n >= 559);
    return (rel > 0 ? 16 : 0) + v;
}
struct ProjOut { bf16 *aq, *ak, *av, *sag, *gq, *gk, *gv, *sgg; float* lr; };
namespace pg8 {
#define PG8_LAS __attribute__((address_space(3)))
typedef unsigned short bf16_t;
typedef short bf16x8 __attribute__((ext_vector_type(8)));
typedef float f32x4 __attribute__((ext_vector_type(4)));
typedef unsigned u32x4 __attribute__((ext_vector_type(4)));
constexpr int BM = 256, BK = 64, HALF = 128, HTB = HALF * BK * 2  , STAGE_BYTES = 8 * HTB, NXCD = 8, WGM = 8;

__host__ __device__ __forceinline__ int lds_byte(int r, int c) { const int st = (r >> 4) * 2 + (c >> 5), rr = r & 15, cc = c & 31, ob = rr * 64 + cc * 2; return st * 1024 + (ob ^ (((ob >> 9) & 1) << 5)); }
__host__ __device__ __forceinline__ void stage_rc(int b, int& R, int& C) { const int st = b / 1024, sb = b % 1024, swz = sb ^ (((sb >> 9) & 1) << 5); R = (st >> 1) * 16 + swz / 64; C = (st & 1) * 32 + (swz % 64) / 2; }
__host__ __device__ __forceinline__ int perm32(int rho) { const int n = rho >> 4, i = rho & 15; return 8 * (i >> 2) + 4 * n + (i & 3); }

struct Unit { int pm, pn; };
struct Gemm { const bf16_t* A; const bf16_t* Bt; int M, N, K; };

struct StaticOrder {
    int nM, nN, nwg, G, c, reps;
    __host__ __device__ void init(int M, int N, int G_, int c_) { nM = M / BM; nN = N / BM; nwg = nM * nN; G = G_; c = c_; reps = 1; }
    __host__ __device__ bool next(int i, Unit& u) const {
        const long L = (long)i * G + c; if (L >= (long)nwg * reps) return false;
        int wgid = (int)(L % nwg); { const int q = nwg / NXCD, r = nwg % NXCD, xcd = wgid % NXCD, off = wgid / NXCD; wgid = (xcd < r ? xcd * (q + 1) : r * (q + 1) + (xcd - r) * q) + off; }
        const int nig = WGM * nN, gid = wgid / nig, fm = gid * WGM, gsz = (nM - fm) < WGM ? (nM - fm) : WGM;
        u.pm = fm + ((wgid % nig) % gsz); u.pn = (wgid % nig) / gsz; return true;
    }
    __device__ __forceinline__ void a_ready(const Unit&) const {}
    __device__ __forceinline__ void done(const Unit&) const {}
};

__device__ __forceinline__ unsigned cvt_pk_bf16(float lo, float hi) { unsigned r; asm volatile("v_cvt_pk_bf16_f32 %0, %1, %2" : "=v"(r) : "v"(lo), "v"(hi)); return r; }
struct EpiProj {
    static constexpr bool PERM = true, AFTER_DRAIN = false;
    ProjOut P;
    __device__ __forceinline__ void operator()(const f32x4 (&acc)[2][2][4][2], const Unit& u, int wr, int wc, int fr, int fq) const {
        const int row0 = u.pm * BM + wr * 64 + fr; const int pn = u.pn;
        if (pn == 28) {
            if (wc == 0) {
#pragma unroll
                for (int ai = 0; ai < 2; ++ai)
#pragma unroll
                    for (int m = 0; m < 4; ++m) { float* rowp = P.lr + (size_t)(row0 + ai * HALF + m * 16) * 32 + 8 * fq;
                        *(f32x4*)(rowp) = acc[ai][0][m][0]; *(f32x4*)(rowp + 4) = acc[ai][0][m][1]; }
            }
            return;
        }
        bf16_t* base; int ld, ct; int act = 0; float sc = 1.f;
        if (pn < 4) { base = P.aq; ld = 1024; ct = pn; sc = C2; }
        else if (pn < 8) { base = P.ak; ld = 1024; ct = pn - 4; }
        else if (pn < 12) { base = P.av; ld = 1024; ct = pn - 8; }
        else if (pn < 16) { base = P.sag; ld = 1024; ct = pn - 12; act = 1; }
        else if (pn < 18) { base = P.gq; ld = 512; ct = pn - 16; }
        else if (pn < 20) { base = P.gk; ld = 512; ct = pn - 18; }
        else if (pn < 24) { base = P.gv; ld = 1024; ct = pn - 20; }
        else { base = P.sgg; ld = 1024; ct = pn - 24; act = 1; }
        const int col0 = ct * BM + wc * 32 + 8 * fq;
#pragma unroll
        for (int ai = 0; ai < 2; ++ai)
#pragma unroll
            for (int m = 0; m < 4; ++m) { bf16_t* rowp = base + (size_t)(row0 + ai * HALF + m * 16) * ld + col0;
#pragma unroll
                for (int bj = 0; bj < 2; ++bj) { f32x4 v0 = acc[ai][bj][m][0], v1 = acc[ai][bj][m][1];
                    if (act) {
#pragma unroll
                        for (int e = 0; e < 4; ++e) { v0[e] = v0[e] * __builtin_amdgcn_rcpf(1.f + __expf(-v0[e])); v1[e] = v1[e] * __builtin_amdgcn_rcpf(1.f + __expf(-v1[e])); } }
                    v0 = v0 * sc; v1 = v1 * sc; u32x4 w; w.x = cvt_pk_bf16(v0[0], v0[1]); w.y = cvt_pk_bf16(v0[2], v0[3]); w.z = cvt_pk_bf16(v1[0], v1[1]); w.w = cvt_pk_bf16(v1[2], v1[3]);
                    *(u32x4*)(rowp + bj * HALF) = w; } }
    }
};
struct EpiY {
    static constexpr bool PERM = true, AFTER_DRAIN = false;
    bf16_t* Y;
    __device__ __forceinline__ void operator()(const f32x4 (&acc)[2][2][4][2], const Unit& u, int wr, int wc, int fr, int fq) const {
        const int row0 = u.pm * BM + wr * 64 + fr, col0 = u.pn * BM + wc * 32 + 8 * fq;
#pragma unroll
        for (int ai = 0; ai < 2; ++ai)
#pragma unroll
            for (int m = 0; m < 4; ++m) { bf16_t* rowp = Y + (size_t)(row0 + ai * HALF + m * 16) * DM + col0;
#pragma unroll
                for (int bj = 0; bj < 2; ++bj) { const f32x4 v0 = acc[ai][bj][m][0], v1 = acc[ai][bj][m][1];
                    u32x4 w; w.x = cvt_pk_bf16(v0[0], v0[1]); w.y = cvt_pk_bf16(v0[2], v0[3]); w.z = cvt_pk_bf16(v1[0], v1[1]); w.w = cvt_pk_bf16(v1[2], v1[3]);
                    *(u32x4*)(rowp + bj * HALF) = w; } }
    }
};
template <class Epi, class Sched, bool ALIGN_EPI = false, bool SP2 = false>
__device__ __forceinline__ void gemm_phase(PG8_LAS unsigned char* lds, const Gemm g, const Sched& S, const Epi& E) {
    const int tid = threadIdx.x, wid = __builtin_amdgcn_readfirstlane(tid >> 6), lane = tid & 63, wr = wid >> 2, wc = wid & 3, fr = lane & 15, fq = lane >> 4;
    const int K = g.K, nt = K / BK;
    unsigned voffA[2], voffB[2];
#pragma unroll
    for (int i = 0; i < 2; ++i) { int R, C; stage_rc(tid * 16 + i * 8192, R, C); const int Rb = Epi::PERM ? ((R & ~31) + perm32(R & 31)) : R;
        voffA[i] = (unsigned)(R * K + C) * 2u; voffB[i] = (unsigned)(Rb * K + C) * 2u; }
    const size_t kstep = (size_t)(BK * 2);
    const size_t hstep = (size_t)HALF * K * 2;
    const size_t tstep = 2 * hstep;
    const unsigned ldsw = (unsigned)wid * 1024u;
    const int aoff = lds_byte(wr * 64 + fr, fq * 8), boff = lds_byte(wc * 32 + fr, fq * 8);
#define PG8_SA(b, h) (((b) * 2 + (h)) * HTB)
#define PG8_SB(b, h) ((4 + (b) * 2 + (h)) * HTB)
#define PG8_STAGE(bufoff, gbase, voff) do { _Pragma("unroll") for (int _i = 0; _i < 2; ++_i) \
        __builtin_amdgcn_global_load_lds((const unsigned*)((const char*)(gbase) + (voff)[_i]), (PG8_LAS unsigned*)(lds + (bufoff) + ldsw + _i * 8192), 16, 0, 0); } while (0)
#define PG8_LDA(dst, b, h) do { _Pragma("unroll") for (int m = 0; m < 4; ++m) _Pragma("unroll") for (int k = 0; k < 2; ++k) dst[m][k] = *(const PG8_LAS bf16x8*)(lds + PG8_SA(b, h) + aoff + m * 2048 + k * 1024); } while (0)
#define PG8_LDB(dst, b, h) do { _Pragma("unroll") for (int n = 0; n < 2; ++n) _Pragma("unroll") for (int k = 0; k < 2; ++k) dst[n][k] = *(const PG8_LAS bf16x8*)(lds + PG8_SB(b, h) + boff + n * 2048 + k * 1024); } while (0)
#define PG8_MMA(ai, bj, At, Bt) do { __builtin_amdgcn_s_setprio(1); _Pragma("unroll") for (int m = 0; m < 4; ++m) _Pragma("unroll") for (int n = 0; n < 2; ++n) _Pragma("unroll") for (int k = 0; k < 2; ++k) \
        acc[ai][bj][m][n] = __builtin_amdgcn_mfma_f32_16x16x32_bf16(Bt[n][k], At[m][k], acc[ai][bj][m][n], 0, 0, 0); __builtin_amdgcn_s_setprio(0); } while (0)
#define PG8_WAIT_V(n) asm volatile("s_waitcnt vmcnt(" #n ")" ::: "memory")
#define PG8_WAIT_L(n) asm volatile("s_waitcnt lgkmcnt(" #n ")" ::: "memory")
#define PG8_BAR __builtin_amdgcn_s_barrier()
#define PG8_SCHED __builtin_amdgcn_sched_barrier(0)
    Unit cur, nxt; int ui = 0;
    if (!S.next(0, cur)) return;
    f32x4 acc[2][2][4][2];
#pragma unroll
    for (int a = 0; a < 2; ++a)
#pragma unroll
        for (int b = 0; b < 2; ++b)
#pragma unroll
            for (int m = 0; m < 4; ++m)
#pragma unroll
                for (int n = 0; n < 2; ++n) acc[a][b][m][n] = (f32x4){0.f, 0.f, 0.f, 0.f};
    bf16x8 At[4][2], B0[2][2], B1[2][2];
    const char* cA = (const char*)g.A + (size_t)cur.pm * tstep; const char* cB = (const char*)g.Bt + (size_t)cur.pn * tstep;
    S.a_ready(cur);
    if constexpr (SP2) {
        PG8_STAGE(PG8_SB(0, 0), cB, voffB); PG8_STAGE(PG8_SB(0, 1), cB + hstep, voffB); PG8_STAGE(PG8_SA(0, 0), cA, voffA); PG8_STAGE(PG8_SA(0, 1), cA + hstep, voffA);
        if (wr == 1) PG8_BAR;
        PG8_WAIT_V(2); PG8_BAR;
        PG8_STAGE(PG8_SB(1, 0), cB + kstep, voffB); PG8_STAGE(PG8_SA(1, 0), cA + kstep, voffA); PG8_STAGE(PG8_SB(1, 1), cB + hstep + kstep, voffB);
        PG8_WAIT_V(6); PG8_BAR;
    } else {
        PG8_STAGE(PG8_SB(0, 0), cB, voffB); PG8_STAGE(PG8_SA(0, 0), cA, voffA); PG8_STAGE(PG8_SB(0, 1), cB + hstep, voffB); PG8_STAGE(PG8_SA(0, 1), cA + hstep, voffA);
        if (wr == 1) PG8_BAR;
        PG8_WAIT_V(4); PG8_BAR;
        PG8_STAGE(PG8_SB(1, 0), cB + kstep, voffB); PG8_STAGE(PG8_SA(1, 0), cA + kstep, voffA); PG8_STAGE(PG8_SB(1, 1), cB + hstep + kstep, voffB);
        PG8_WAIT_V(6); PG8_BAR;
    }
    for (;;) {
        const bool has_next = S.next(ui + 1, nxt);
        const char* nA = has_next ? (const char*)g.A + (size_t)nxt.pm * tstep : cA; const char* nB = has_next ? (const char*)g.Bt + (size_t)nxt.pn * tstep : cB;
        for (int t = 0; t < nt; t += 2) {
            const bool last = (t == nt - 2);
            const char* a1 = cA + (size_t)(t + 1) * kstep;
            const char* a2 = last ? nA : cA + (size_t)(t + 2) * kstep; const char* b2 = last ? nB : cB + (size_t)(t + 2) * kstep;
            const char* a3 = a2 + kstep; const char* b3 = b2 + kstep;
            if (last && has_next) S.a_ready(nxt);
            if constexpr (SP2) {
            PG8_LDB(B0, 0, 0); PG8_LDB(B1, 0, 1); PG8_SCHED; PG8_LDA(At, 0, 0); PG8_STAGE(PG8_SA(1, 1), a1 + hstep, voffA);
            PG8_WAIT_V(8); PG8_WAIT_L(0); PG8_BAR; PG8_MMA(0, 0, At, B0); PG8_MMA(0, 1, At, B1); PG8_BAR; PG8_SCHED;
            PG8_LDA(At, 0, 1); PG8_STAGE(PG8_SB(0, 0), b2, voffB); PG8_STAGE(PG8_SB(0, 1), b2 + hstep, voffB); PG8_STAGE(PG8_SA(0, 0), a2, voffA);
            PG8_WAIT_V(8); PG8_WAIT_L(0); PG8_BAR; PG8_MMA(1, 0, At, B0); PG8_MMA(1, 1, At, B1); PG8_BAR; PG8_SCHED;
            PG8_LDB(B0, 1, 0); PG8_LDB(B1, 1, 1); PG8_SCHED; PG8_LDA(At, 1, 0); PG8_STAGE(PG8_SA(0, 1), a2 + hstep, voffA);
            PG8_WAIT_V(8); PG8_WAIT_L(0); PG8_BAR; PG8_MMA(0, 0, At, B0); PG8_MMA(0, 1, At, B1); PG8_BAR; PG8_SCHED;
            PG8_LDA(At, 1, 1); PG8_STAGE(PG8_SB(1, 0), b3, voffB); PG8_STAGE(PG8_SB(1, 1), b3 + hstep, voffB); PG8_STAGE(PG8_SA(1, 0), a3, voffA);
            PG8_WAIT_V(8); PG8_WAIT_L(0); PG8_BAR; PG8_MMA(1, 0, At, B0); PG8_MMA(1, 1, At, B1); PG8_BAR; PG8_SCHED;
            } else {
            PG8_LDB(B0, 0, 0); PG8_SCHED; PG8_LDA(At, 0, 0); PG8_STAGE(PG8_SA(1, 1), a1 + hstep, voffA);
            PG8_WAIT_L(8); PG8_BAR; PG8_WAIT_L(0); PG8_MMA(0, 0, At, B0); PG8_BAR; PG8_SCHED;
            PG8_LDB(B1, 0, 1); PG8_STAGE(PG8_SB(0, 0), b2, voffB);
            PG8_BAR; PG8_WAIT_L(0); PG8_MMA(0, 1, At, B1); PG8_BAR;
            PG8_LDA(At, 0, 1); PG8_STAGE(PG8_SA(0, 0), a2, voffA);
            PG8_BAR; PG8_WAIT_L(0); PG8_MMA(1, 0, At, B0); PG8_BAR; PG8_SCHED;
            PG8_STAGE(PG8_SB(0, 1), b2 + hstep, voffB);
            PG8_WAIT_V(6); PG8_BAR; PG8_MMA(1, 1, At, B1); PG8_BAR;
            PG8_LDB(B0, 1, 0); PG8_SCHED; PG8_LDA(At, 1, 0); PG8_STAGE(PG8_SA(0, 1), a2 + hstep, voffA);
            PG8_WAIT_L(8); PG8_BAR; PG8_WAIT_L(0); PG8_MMA(0, 0, At, B0); PG8_BAR; PG8_SCHED;
            PG8_LDB(B1, 1, 1); PG8_STAGE(PG8_SB(1, 0), b3, voffB);
            PG8_BAR; PG8_WAIT_L(0); PG8_MMA(0, 1, At, B1); PG8_BAR;
            PG8_LDA(At, 1, 1); PG8_STAGE(PG8_SA(1, 0), a3, voffA);
            PG8_BAR; PG8_WAIT_L(0); PG8_MMA(1, 0, At, B0); PG8_BAR; PG8_SCHED;
            PG8_STAGE(PG8_SB(1, 1), b3 + hstep, voffB);
            PG8_WAIT_V(6); PG8_BAR; PG8_MMA(1, 1, At, B1); PG8_BAR;
            }
        }
        if constexpr (ALIGN_EPI) { if (wr == 0) PG8_BAR; }
        if constexpr (!Epi::AFTER_DRAIN) { E(acc, cur, wr, wc, fr, fq); S.done(cur); }
        if (!has_next) break;
#pragma unroll
        for (int a = 0; a < 2; ++a)
#pragma unroll
            for (int b = 0; b < 2; ++b)
#pragma unroll
                for (int m = 0; m < 4; ++m)
#pragma unroll
                    for (int n = 0; n < 2; ++n) acc[a][b][m][n] = (f32x4){0.f, 0.f, 0.f, 0.f};
        cur = nxt; cA = nA; cB = nB; ++ui;
        if constexpr (ALIGN_EPI) { if (wr == 1) PG8_BAR; }
    }
    PG8_WAIT_V(0);
    if constexpr (!ALIGN_EPI) { if (wr == 0) PG8_BAR; }
    PG8_BAR;
    if constexpr (Epi::AFTER_DRAIN) { E.fused(acc, cur, wr, wc, fr, fq, lds, wid, lane); S.done(cur); }
#undef PG8_SA
#undef PG8_SB
#undef PG8_STAGE
#undef PG8_LDA
#undef PG8_LDB
#undef PG8_MMA
#undef PG8_WAIT_V
#undef PG8_WAIT_L
#undef PG8_BAR
#undef PG8_SCHED
}
}
constexpr int NWAVES = 8;
constexpr int RING_OFF = 0, RING_BYTES = 153600;
constexpr int LDSCTL_OFF = RING_BYTES, MISC_OFF = LDSCTL_OFF + 320;
constexpr int LDS_BYTES = 154624;
constexpr int CW_TMO = 0, CW_CODE = 1, CW_BAR = 4096;
#define GAS __attribute__((address_space(1)))
#define LAS __attribute__((address_space(3)))
typedef unsigned v4u __attribute__((ext_vector_type(4)));
typedef unsigned v2u __attribute__((ext_vector_type(2)));
typedef float f32x4 __attribute__((ext_vector_type(4)));
typedef float f32x16 __attribute__((ext_vector_type(16)));
typedef short bf16x8 __attribute__((ext_vector_type(8)));
typedef short s16x4 __attribute__((ext_vector_type(4)));
typedef GAS unsigned gu32;
typedef GAS unsigned long long gu64;
#define RLX_AGENT __ATOMIC_RELAXED, __HIP_MEMORY_SCOPE_AGENT
#define LDS_WAIT() asm volatile("s_waitcnt lgkmcnt(0)" ::: "memory")
#define VM_WAIT() asm volatile("s_waitcnt vmcnt(0)" ::: "memory")
__device__ __forceinline__ void glds16(const void* gsrc, unsigned lds_dst) { unsigned keep; const unsigned dst = (unsigned)__builtin_amdgcn_readfirstlane((int)lds_dst);
    asm volatile("s_mov_b32 %0, m0\n\ts_mov_b32 m0, %2\n\ts_nop 0\n\tglobal_load_lds_dwordx4 %1, off\n\ts_mov_b32 m0, %0" : "=&s"(keep) : "v"(gsrc), "s"(dst) : "memory"); }
__device__ __forceinline__ void glds16s(const void* sbase, unsigned voff, unsigned lds_dst) { unsigned keep; const unsigned dst = (unsigned)__builtin_amdgcn_readfirstlane((int)lds_dst);
    const unsigned long long b = (unsigned long long)sbase; const unsigned blo = (unsigned)__builtin_amdgcn_readfirstlane((int)(unsigned)b), bhi = (unsigned)__builtin_amdgcn_readfirstlane((int)(unsigned)(b >> 32));
    const unsigned long long bs = ((unsigned long long)bhi << 32) | blo;
    asm volatile("s_mov_b32 %0, m0\n\ts_mov_b32 m0, %3\n\ts_nop 0\n\tglobal_load_lds_dwordx4 %1, %2\n\ts_mov_b32 m0, %0" : "=&s"(keep) : "v"(voff), "s"(bs), "s"(dst) : "memory"); }
#define XB_TMO      128
#define XB_XCNT(j)  (256  + 64 * (j))
#define XB_XSUB(j)  (1280 + 64 * (j))
#define XB_XGEN(j)  (2304 + 64 * (j))
#define XB_TOP      3328
#define XB_TOPGEN   3392
#define XCD_BAR_WORDS 3456
#define XB_SPIN_CAP (1u << 18)

__device__ __forceinline__ unsigned xb_ld(unsigned* p)              { return __hip_atomic_load(p, __ATOMIC_RELAXED, __HIP_MEMORY_SCOPE_AGENT); }
__device__ __forceinline__ unsigned xb_add(unsigned* p, unsigned v) { return __hip_atomic_fetch_add(p, v, __ATOMIC_RELAXED, __HIP_MEMORY_SCOPE_AGENT); }
__device__ __forceinline__ unsigned xb_xcc_id() { return (unsigned)__builtin_amdgcn_s_getreg((3 << 11) | 20) & 0xFu; }
#define XB_SPIN(cond, bar) do { unsigned _sp = 0; while (cond) { __builtin_amdgcn_s_sleep(1); \
    if ((++_sp & 255u) == 0u) { if (xb_ld(&(bar)[XB_TMO])) break; if (_sp > XB_SPIN_CAP) { atomicAdd(&(bar)[XB_TMO], 1u); break; } } } } while (0)

struct XcdBarrier {
    unsigned* bar; unsigned x;
    volatile LAS unsigned* st;
};

__device__ __forceinline__ XcdBarrier xcd_barrier_post(unsigned* bar, volatile LAS unsigned* st) {
    XcdBarrier b; b.bar = bar; b.x = xb_xcc_id(); b.st = st;
    if (threadIdx.x == 0) (void)xb_add(&bar[XB_XCNT(b.x)], 1u);
    return b;
}
__device__ __forceinline__ void xcd_barrier_complete(unsigned* bar, unsigned x, unsigned& nloc, unsigned& nx) {
    const unsigned G = gridDim.x * gridDim.y * gridDim.z;
    unsigned sum, cnt, mine, sp = 0u;
    for (;;) {
        sum = 0u; cnt = 0u; mine = 0u;
#pragma unroll
        for (unsigned j = 0; j < 16; ++j) { const unsigned c = xb_ld(&bar[XB_XCNT(j)]); sum += c; cnt += (c > 0u) ? 1u : 0u; mine = (j == x) ? c : mine; }
        if (sum == G) break;
        __builtin_amdgcn_s_sleep(1);
        if ((++sp & 255u) == 0u) { if (xb_ld(&bar[XB_TMO])) break; if (sp > XB_SPIN_CAP) { atomicAdd(&bar[XB_TMO], 1u); break; } }
    }
    nloc = mine > 0u ? mine : 1u; nx = cnt > 0u ? cnt : 1u;
}

__device__ __forceinline__ void xcd_barrier(const XcdBarrier& b) {
    asm volatile("s_waitcnt vmcnt(0)" ::: "memory");
    __syncthreads();
    if (threadIdx.x == 0) {
        unsigned* bar = b.bar;
        __builtin_amdgcn_s_waitcnt(0);
        unsigned nloc = b.st[0], nx = b.st[1];
        if (nloc == 0u) { xcd_barrier_complete(bar, b.x, nloc, nx); b.st[0] = nloc; b.st[1] = nx; }
        const unsigned old = xb_add(&bar[XB_XSUB(b.x)], 1u);
        const unsigned gen = old / nloc;
        if (old + 1u == (gen + 1u) * nloc) {
            __builtin_amdgcn_fence(__ATOMIC_RELEASE, "agent");
            asm volatile("s_waitcnt vmcnt(0)" ::: "memory");
            const unsigned og = xb_add(&bar[XB_TOP], 1u);
            const unsigned tg = og / nx;
            if (og + 1u == (tg + 1u) * nx) xb_add(&bar[XB_TOPGEN], 1u);
            else XB_SPIN(xb_ld(&bar[XB_TOPGEN]) == tg, bar);
            __builtin_amdgcn_fence(__ATOMIC_ACQUIRE, "agent");
            xb_add(&bar[XB_XGEN(b.x)], 1u);
            asm volatile("s_waitcnt vmcnt(0)" ::: "memory");
        } else {
            XB_SPIN(xb_ld(&bar[XB_XGEN(b.x)]) == gen, bar);
            __builtin_amdgcn_fence(__ATOMIC_ACQUIRE, "agent");
            asm volatile("s_waitcnt vmcnt(0)" ::: "memory");
        }
    }
    __syncthreads();
}

struct Args { const float* in[13]; float* out; unsigned char* ws; int ph_lo, ph_hi, li, dup_phase, dup_reps, dup_sub; };
struct Frame {
    LAS unsigned char* lds; volatile LAS unsigned* MISC; gu32* ctl;
    int tid, lane, wave, vcu, G;
};
__device__ __forceinline__ float wave_sum(float v) {
#pragma unroll
    for (int o = 1; o < 64; o <<= 1) v += __shfl_xor(v, o);
    return v;
}
__device__ __forceinline__ void p0_transpose_item(const float* W, int K, int N, bf16* WT, LAS float* scr, int item, int lane) {
    const int nblk = N / 32, kb = item / nblk, nb = item % nblk, k0 = 64 * kb, n0 = 32 * nb;
#pragma unroll 8
    for (int i = 0; i < 32; ++i) { const int kk = 2 * i + (lane >> 5); scr[kk * 33 + (lane & 31)] = __builtin_nontemporal_load(W + (size_t)(k0 + kk) * N + n0 + (lane & 31)); }
    LDS_WAIT(); asm volatile("" ::: "memory");
    const int c = lane & 7;
#pragma unroll
    for (int j = 0; j < 4; ++j) { const int n = (lane >> 3) + 8 * j; const LAS float* s = scr + (8 * c) * 33 + n;
        v4u o; o.x = pk2(s[0 * 33], s[1 * 33]); o.y = pk2(s[2 * 33], s[3 * 33]); o.z = pk2(s[4 * 33], s[5 * 33]); o.w = pk2(s[6 * 33], s[7 * 33]);
        *(GAS v4u*)(WT + (size_t)(n0 + n) * K + k0 + 8 * c) = o; }
    LDS_WAIT(); asm volatile("" ::: "memory");
}
__device__ __forceinline__ void p0_mod(Frame& F, const Args& a) {
    const float* c = a.in[1]; const float* w_cond = a.in[2]; const float* b_cond = a.in[3];
    float* mod = (float*)(a.ws + WS_MOD);
    if (F.vcu < 192) {
        LAS float* sc = (LAS float*)(F.lds);
        LAS float* red = (LAS float*)(F.lds + 32768);
        for (int i = F.tid; i < 4 * DM; i += NWAVES * 64) sc[i] = silu_f(c[i]);
        __syncthreads();
        const int cg = F.lane & 7, kr = F.lane >> 3, n0 = 32 * F.vcu + 4 * cg;
        f32x4 acc[4];
#pragma unroll
        for (int b = 0; b < 4; ++b) acc[b] = (f32x4){0.f, 0.f, 0.f, 0.f};
#pragma unroll 8
        for (int it = 0; it < 32; ++it) { const int k = 256 * F.wave + 8 * it + kr;
            const f32x4 w = __builtin_nontemporal_load((const GAS f32x4*)(w_cond + (size_t)k * (3 * DM) + n0));
#pragma unroll
            for (int b = 0; b < 4; ++b) acc[b] += w * sc[b * DM + k]; }
#pragma unroll
        for (int b = 0; b < 4; ++b)
#pragma unroll
            for (int e = 0; e < 4; ++e) { float v = acc[b][e]; v += __shfl_xor(v, 8); v += __shfl_xor(v, 16); v += __shfl_xor(v, 32); acc[b][e] = v; }
        if (kr == 0) {
#pragma unroll
            for (int b = 0; b < 4; ++b) *(LAS f32x4*)(red + (F.wave * 4 + b) * 32 + 4 * cg) = acc[b]; }
        __syncthreads();
        if (F.tid < 128) { const int b = F.tid >> 5, col = F.tid & 31; float s = b_cond[32 * F.vcu + col];
#pragma unroll
            for (int w = 0; w < 8; ++w) s += red[(w * 4 + b) * 32 + col];
            mod[b * 3 * DM + 32 * F.vcu + col] = s; }
        __syncthreads();
    }
}
__device__ __forceinline__ void p1_weights(Frame& F, const Args& a) {
    LAS float* scr = (LAS float*)(F.lds + RING_OFF + F.wave * 16384);
    const int gw = F.vcu * NWAVES + F.wave, NGW = F.G * NWAVES;
    bf16* wint = (bf16*)(a.ws + WS_WINT); bf16* woutt = (bf16*)(a.ws + WS_WOUTT);
    constexpr int I_IN = (DM / 64) * (NPROJ / 32), I_OUT = (DM / 64) * (DM / 32);
    for (int it = gw; it < I_IN + I_OUT; it += NGW) {
        if (it < I_IN) p0_transpose_item(a.in[4], DM, NPROJ, wint, scr, it, F.lane);
        else p0_transpose_item(a.in[11], DM, DM, woutt, scr, it - I_IN, F.lane);
    }
}
__device__ __forceinline__ void p1_h(Frame& F, const Args& a) {
    const float* x = a.in[0]; const float* mod = (const float*)(a.ws + WS_MOD); bf16* h = (bf16*)(a.ws + WS_H);
    const int gw = F.vcu * NWAVES + F.wave, NGW = F.G * NWAVES;
    for (int blk = gw; blk < T / 16; blk += NGW) {
        const int b = (blk * 16) / SEQ;
        const GAS f32x4* shp = (const GAS f32x4*)(mod + b * 3 * DM) + F.lane; const GAS f32x4* scp = (const GAS f32x4*)(mod + b * 3 * DM + DM) + F.lane;
        f32x4 sh[8], sc[8];
#pragma unroll
        for (int j = 0; j < 8; ++j) { sh[j] = shp[64 * j]; sc[j] = scp[64 * j] + 1.0f; }
        for (int r = 0; r < 16; ++r) { const int m = blk * 16 + r;
            const GAS f32x4* xr = (const GAS f32x4*)(x + (size_t)m * DM) + F.lane;
            f32x4 v[8]; float s = 0.f;
#pragma unroll
            for (int j = 0; j < 8; ++j) { v[j] = __builtin_nontemporal_load(xr + 64 * j); s += (v[j].x * v[j].x + v[j].y * v[j].y) + (v[j].z * v[j].z + v[j].w * v[j].w); }
            const float rs = rsqrtf(wave_sum(s) * (1.f / DM) + EPS);
            GAS unsigned long long* o8 = (GAS unsigned long long*)(h + (size_t)m * DM) + F.lane;
#pragma unroll
            for (int j = 0; j < 8; ++j) { const f32x4 o = v[j] * rs * sc[j] + sh[j];
                o8[64 * j] = (unsigned long long)pk2(o.x, o.y) | ((unsigned long long)pk2(o.z, o.w) << 32); } }
    }
}
__device__ __forceinline__ void lr_tail(Frame& F, const Args& a) {
    const bf16* h = (const bf16*)(a.ws + WS_H); const unsigned char* wl = a.ws + WS_WINT + (size_t)7168 * DM * 2; float* lr = (float*)(a.ws + WS_LR);
    constexpr int WROW = 4096 + 32;
    for (int i = F.tid; i < 32 * 256; i += NWAVES * 64) { const int r = i >> 8, c = i & 255; *(LAS v4u*)(F.lds + r * WROW + c * 16) = *(const GAS v4u*)(wl + (size_t)r * 4096 + c * 16); }
    __syncthreads();
    const int gw = F.vcu * NWAVES + F.wave, NGW = F.G * NWAVES, li = F.lane & 15, g = F.lane >> 4;
    const LAS unsigned char* bp0 = F.lds + li * WROW + g * 16; const LAS unsigned char* bp1 = bp0 + 16 * WROW;
    for (int rb = gw; rb < T / 16; rb += NGW) {
        const bf16* ap = h + (size_t)(rb * 16 + li) * DM + 8 * g;
        f32x4 c0 = (f32x4){0.f, 0.f, 0.f, 0.f}, c1 = c0;
        bf16x8 avA[16], avB[16];
#define LRLOAD(D, kb) do { _Pragma("unroll") for (int i_ = 0; i_ < 16; ++i_) D[i_] = __builtin_nontemporal_load((const GAS bf16x8*)(ap + 32 * (16 * (kb) + i_))); } while (0)
#define LRMMA(D, kb) do { _Pragma("unroll") for (int i_ = 0; i_ < 16; ++i_) { const bf16x8 b0_ = *(const LAS bf16x8*)(bp0 + 64 * (16 * (kb) + i_)), b1_ = *(const LAS bf16x8*)(bp1 + 64 * (16 * (kb) + i_)); \
            c0 = __builtin_amdgcn_mfma_f32_16x16x32_bf16(D[i_], b0_, c0, 0, 0, 0); c1 = __builtin_amdgcn_mfma_f32_16x16x32_bf16(D[i_], b1_, c1, 0, 0, 0); } } while (0)
        LRLOAD(avA, 0); __builtin_amdgcn_sched_barrier(0); LRLOAD(avB, 1); __builtin_amdgcn_sched_barrier(0); LRMMA(avA, 0); __builtin_amdgcn_sched_barrier(0);
        LRLOAD(avA, 2); __builtin_amdgcn_sched_barrier(0); LRMMA(avB, 1); __builtin_amdgcn_sched_barrier(0); LRLOAD(avB, 3); __builtin_amdgcn_sched_barrier(0);
        LRMMA(avA, 2); __builtin_amdgcn_sched_barrier(0); LRMMA(avB, 3); __builtin_amdgcn_sched_barrier(0);
#undef LRLOAD
#undef LRMMA
#pragma unroll
        for (int rg = 0; rg < 4; ++rg) { float* o = lr + (size_t)(rb * 16 + 4 * g + rg) * 32 + li; o[0] = c0[rg]; o[16] = c1[rg]; }
    }
    __syncthreads();
}
__device__ __forceinline__ void unpack8(const v4u w, float (&f)[8]) {
    f[0] = __builtin_bit_cast(float, w.x << 16); f[1] = __builtin_bit_cast(float, w.x & 0xffff0000u); f[2] = __builtin_bit_cast(float, w.y << 16); f[3] = __builtin_bit_cast(float, w.y & 0xffff0000u);
    f[4] = __builtin_bit_cast(float, w.z << 16); f[5] = __builtin_bit_cast(float, w.z & 0xffff0000u); f[6] = __builtin_bit_cast(float, w.w << 16); f[7] = __builtin_bit_cast(float, w.w & 0xffff0000u);
}
__device__ __forceinline__ v4u pack8(const float (&f)[8]) { v4u w; w.x = pk2(f[0], f[1]); w.y = pk2(f[2], f[3]); w.z = pk2(f[4], f[5]); w.w = pk2(f[6], f[7]); return w; }
__device__ __forceinline__ void p5_combine(Frame& F, const Args& a) {
    const bf16* op = (const bf16*)(a.ws + WS_OP); const float* lse = (const float*)(a.ws + WS_LSE); const bf16* sag = (const bf16*)(a.ws + WS_SAG);
    const bf16* of = (const bf16*)(a.ws + WS_OF); const bf16* ob = (const bf16*)(a.ws + WS_OB); const bf16* sgg = (const bf16*)(a.ws + WS_SGG); const float* gain = a.in[9];
    bf16* cat = (bf16*)(a.ws + WS_H);
    const int gw = F.vcu * NWAVES + F.wave, NGW = F.G * NWAVES, lane = F.lane;
    float gn[16];
#pragma unroll
    for (int j = 0; j < 4; ++j) { const f32x4 g = *(const GAS f32x4*)(gain + 16 * lane + 4 * j); gn[4 * j] = g.x; gn[4 * j + 1] = g.y; gn[4 * j + 2] = g.z; gn[4 * j + 3] = g.w; }
    for (int t = gw; t < T; t += NGW) {
        const size_t e = (size_t)t * 1024 + 16 * lane; const int hh = lane >> 2;
        const float l0 = __builtin_nontemporal_load(lse + (size_t)t * 16 + hh), l1 = __builtin_nontemporal_load(lse + (size_t)T * 16 + (size_t)t * 16 + hh), l2 = __builtin_nontemporal_load(lse + (size_t)2 * T * 16 + (size_t)t * 16 + hh);
        const float mx = fmaxf(l0, fmaxf(l1, l2)); float w0 = exp2f(l0 - mx), w1 = exp2f(l1 - mx), w2 = exp2f(l2 - mx); const float wi = 1.f / (w0 + w1 + w2); w0 *= wi; w1 *= wi; w2 *= wi;
#pragma unroll
        for (int hf = 0; hf < 2; ++hf) { float p0[8], p1[8], p2[8], g[8], o[8];
            unpack8(__builtin_nontemporal_load((const GAS v4u*)(op + e + 8 * hf)), p0); unpack8(__builtin_nontemporal_load((const GAS v4u*)(op + (size_t)T * 1024 + e + 8 * hf)), p1); unpack8(__builtin_nontemporal_load((const GAS v4u*)(op + (size_t)2 * T * 1024 + e + 8 * hf)), p2);
            unpack8(__builtin_nontemporal_load((const GAS v4u*)(sag + e + 8 * hf)), g);
#pragma unroll
            for (int i = 0; i < 8; ++i) o[i] = (w0 * p0[i] + w1 * p1[i] + w2 * p2[i]) * g[i];
            *(GAS v4u*)(cat + (size_t)t * 2048 + 16 * lane + 8 * hf) = pack8(o); }
        float xv[16], ss = 0.f;
#pragma unroll
        for (int hf = 0; hf < 2; ++hf) { float f[8], b[8]; unpack8(__builtin_nontemporal_load((const GAS v4u*)(of + e + 8 * hf)), f); unpack8(__builtin_nontemporal_load((const GAS v4u*)(ob + e + 8 * hf)), b);
#pragma unroll
            for (int i = 0; i < 8; ++i) { xv[8 * hf + i] = f[i] + b[i]; ss += xv[8 * hf + i] * xv[8 * hf + i]; } }
        ss += __shfl_xor(ss, 1); ss += __shfl_xor(ss, 2); ss += __shfl_xor(ss, 4); ss += __shfl_xor(ss, 8);
        const float r = rsqrtf(ss * (1.f / 256.f) + EPS);
#pragma unroll
        for (int hf = 0; hf < 2; ++hf) { float g[8], o[8]; unpack8(__builtin_nontemporal_load((const GAS v4u*)(sgg + e + 8 * hf)), g);
#pragma unroll
            for (int i = 0; i < 8; ++i) o[i] = xv[8 * hf + i] * r * gn[8 * hf + i] * g[i];
            *(GAS v4u*)(cat + (size_t)t * 2048 + 1024 + 16 * lane + 8 * hf) = pack8(o); }
    }
}
__device__ __forceinline__ void p7_final(Frame& F, const Args& a) {
    float* out = a.out; const float* x = a.in[0]; const float* fg = a.in[12]; const float* mod = (const float*)(a.ws + WS_MOD); const bf16* Y = (const bf16*)(a.ws + WS_Y);
    const int gw = F.vcu * NWAVES + F.wave, NGW = F.G * NWAVES;
    f32x4 g[8];
#pragma unroll
    for (int j = 0; j < 8; ++j) g[j] = *((const GAS f32x4*)fg + F.lane + 64 * j);
    for (int blk = gw; blk < T / 16; blk += NGW) {
        const int b = (blk * 16) / SEQ;
        f32x4 gt[8];
#pragma unroll
        for (int j = 0; j < 8; ++j) gt[j] = *((const GAS f32x4*)(mod + b * 3 * DM + 2 * DM) + F.lane + 64 * j);
        for (int r = 0; r < 16; ++r) { const int m = blk * 16 + r;
            const GAS f32x4* xr = (const GAS f32x4*)(x + (size_t)m * DM) + F.lane; const GAS v2u* yr = (const GAS v2u*)(Y + (size_t)m * DM) + F.lane;
            f32x4 v[8]; float s = 0.f;
#pragma unroll
            for (int j = 0; j < 8; ++j) { const f32x4 xv = __builtin_nontemporal_load(xr + 64 * j); const v2u yw = __builtin_nontemporal_load(yr + 64 * j);
                const f32x4 yv = (f32x4){__builtin_bit_cast(float, yw.x << 16), __builtin_bit_cast(float, yw.x & 0xffff0000u), __builtin_bit_cast(float, yw.y << 16), __builtin_bit_cast(float, yw.y & 0xffff0000u)};
                v[j] = xv + gt[j] * yv; s += (v[j].x * v[j].x + v[j].y * v[j].y) + (v[j].z * v[j].z + v[j].w * v[j].w); }
            const float rs = rsqrtf(wave_sum(s) * (1.f / DM) + EPS);
            GAS f32x4* orow = (GAS f32x4*)(out + (size_t)m * DM) + F.lane;
#pragma unroll
            for (int j = 0; j < 8; ++j) orow[64 * j] = v[j] * rs * g[j]; }
    }
}

namespace att {
constexpr int KCH = 384 * 16, VDH = 384 * 64, K_OFF = 0, V_OFF = 8 * KCH, VBUF = 2 * VDH, BIAS_OFF = V_OFF + 2 * VBUF, BCOPY = 832, RB_OFF = BIAS_OFF + 4 * BCOPY, ATT_LDS = RB_OFF + 2048;
static_assert(ATT_LDS <= RING_BYTES && (V_OFF % 1024) == 0 && (BIAS_OFF % 16) == 0, "attention LDS map");
constexpr int NUNITS = BATCH * 16 * 3 * 32;
__device__ __forceinline__ int crow(int r, int hi) { return (r & 3) + 8 * (r >> 2) + 4 * hi; }
typedef short v4i16_t __attribute__((ext_vector_type(4)));
__device__ __forceinline__ s16x4 vtr(const LAS unsigned char* p) { return __builtin_bit_cast(s16x4, __builtin_amdgcn_ds_read_tr16_b64_v4i16((LAS v4i16_t*)p)); }
__device__ __forceinline__ unsigned cvtpk(float lo, float hi) { typedef float f2 __attribute__((ext_vector_type(2))); typedef __bf16 b2 __attribute__((ext_vector_type(2))); f2 v = {lo, hi}; b2 b = __builtin_convertvector(v, b2); return __builtin_bit_cast(unsigned, b); }
#define ATT_BAR() asm volatile("s_waitcnt lgkmcnt(0)\n\ts_barrier" ::: "memory")

struct UnitGeo { int b, h, p, d, r, L, m0; unsigned rowb; size_t base; };
__device__ __forceinline__ UnitGeo decode(int uid) {
    UnitGeo u; const int bh = uid / 96, w96 = uid % 96, rs = w96 & 31; u.p = w96 >> 5; u.b = bh >> 4; u.h = bh & 15;
    u.d = (u.p == 0) ? 1 : (u.p == 1 ? 4 : 16);
    u.r = (u.p == 0) ? 0 : (u.p == 1 ? (rs >> 3) : (rs >> 1)); const int seg = (u.p == 0) ? rs : (u.p == 1 ? (rs & 7) : (rs & 1));
    u.L = SEQ / u.d; u.m0 = seg * 256; u.rowb = (unsigned)u.d * 2048u; u.base = ((size_t)u.b * SEQ + u.r) * 2048 + u.h * 128; return u;
}
__device__ __forceinline__ void dma_k(const Args& a, const UnitGeo& u, LAS unsigned char* lds, int wid, int lane) {
    const unsigned char* Kb = a.ws + WS_AK + u.base + (lane >> 3) * 16; const unsigned rowb = u.rowb;
#pragma unroll
    for (int j = 0; j < 6; ++j) { const int blk = wid + 8 * j; int m = u.m0 - 64 + 8 * blk + (lane & 7); m = m < 0 ? 0 : (m > u.L - 1 ? u.L - 1 : m);
        glds16(Kb + (size_t)m * rowb, (unsigned)(size_t)lds + K_OFF + blk * 1024); }
}
__device__ __forceinline__ void dma_v(const Args& a, const UnitGeo& u, LAS unsigned char* lds, int vbuf, int wid, int lane) {
    const unsigned char* Vb = a.ws + WS_AV + u.base + (lane >> 5) * 64 + (lane & 3) * 16; const unsigned rowb = u.rowb;
#pragma unroll
    for (int j = 0; j < 6; ++j) { const int blk = wid + 8 * j; int m = u.m0 - 64 + 8 * blk + ((lane >> 2) & 7); m = m < 0 ? 0 : (m > u.L - 1 ? u.L - 1 : m);
        glds16(Vb + (size_t)m * rowb, (unsigned)(size_t)lds + V_OFF + vbuf * VBUF + blk * 1024); }
}
__device__ __forceinline__ void load_q(bf16x8 (&q)[4], const Args& a, const UnitGeo& u, int wid, int r32, int hi) {
    const unsigned char* Qb = a.ws + WS_AQ + u.base + (size_t)(u.m0 + 32 * wid + r32) * u.rowb + hi * 16;
    asm volatile("global_load_dwordx4 %0, %1, off" : "=&v"(q[0]) : "v"(Qb) : "memory");
    asm volatile("global_load_dwordx4 %0, %1, off offset:32" : "=&v"(q[1]) : "v"(Qb) : "memory");
    asm volatile("global_load_dwordx4 %0, %1, off offset:64" : "=&v"(q[2]) : "v"(Qb) : "memory");
    asm volatile("global_load_dwordx4 %0, %1, off offset:96" : "=&v"(q[3]) : "v"(Qb) : "memory");
}
__device__ __forceinline__ void write_bias(const Args& a, const UnitGeo& u, LAS unsigned char* lds, int tid) {
    for (int e = tid; e < 4 * 192; e += 512) { const int s = e / 192, i = e % 192, sp = i + s - 95;
        *(LAS float*)(lds + BIAS_OFF + s * BCOPY + i * 4) = (sp >= -64 && sp <= 64) ? ((const LAS float*)(lds + RB_OFF))[t5_bucket(sp * u.d) * 16 + u.h] : -1e30f; }
}
#define DECODE(x) decode(unit_of(x))
__device__ __forceinline__ UnitGeo decode_p(int uid, bool contig) { UnitGeo u = decode(uid); if (contig) { u.rowb = 128u; u.base = (size_t)(uid / 96) * SEQ * 128 + (size_t)((uid % 96) >> 5) * 16 * 2048; } return u; }
__device__ __forceinline__ void attn_phase(Frame& F, const Args& a, int c, int ncu, const int knobs = 0) {
    const bool nodma = knobs & 1, nomath = knobs & 2, nostore = knobs & 4, noq = knobs & 16;
    if (c < 0 || c >= ncu) return;
    const bool coop = (ncu == 192);
    const int per = coop ? 32 : (NUNITS + ncu - 1) / ncu, u0 = coop ? 0 : c * per, u1 = coop ? 32 : ((u0 + per < NUNITS) ? u0 + per : NUNITS);
    if (u0 >= u1) return;
    const int cx = c / 24, cj = c % 24;
    auto unit_of = [&](int i) -> int { return coop ? ((8 * cx + (i >> 2)) * 96 + cj + 24 * (i & 3)) : i; };
    LAS unsigned char* lds = F.lds;
    const int tid = F.tid, lane = F.lane, wid = F.wave, r32 = lane & 31, hi = lane >> 5;
    UnitGeo cur = DECODE(u0);
    __builtin_amdgcn_s_waitcnt(0);
    asm volatile("s_waitcnt vmcnt(0) lgkmcnt(0)\n\ts_barrier" ::: "memory");
    ((LAS float*)(lds + RB_OFF))[tid] = a.in[10][tid] * LOG2E;
    asm volatile("s_waitcnt vmcnt(0) lgkmcnt(0)\n\ts_barrier" ::: "memory");
    dma_k(a, cur, lds, wid, lane); dma_v(a, cur, lds, 0, wid, lane); write_bias(a, cur, lds, tid);
    bf16x8 qr[4]; load_q(qr, a, cur, wid, r32, hi);
    int vb = 0;
    float* pl = nullptr; float plv = 0.f; GAS unsigned char* po = nullptr; size_t postep = 0; v4u pov[4] = {};
    const int e31 = 31 - r32;
    const LAS unsigned char* bias_b = lds + BIAS_OFF + (e31 & 3) * BCOPY + ((e31 >> 2) + hi) * 16;
    const LAS unsigned char* kb0 = lds + K_OFF + (4 * wid + (r32 >> 3)) * 1024 + hi * 128 + (r32 & 7) * 16;
    for (int uid = u0; uid < u1; ++uid) {
        asm volatile("s_waitcnt vmcnt(0) lgkmcnt(0)\n\ts_barrier" : "+v"(qr[0]), "+v"(qr[1]), "+v"(qr[2]), "+v"(qr[3]) :: "memory");
        if (uid != u0 && !nostore) {
            if (hi == 0) *pl = plv;
#pragma unroll
            for (int i = 0; i < 4; ++i) *(GAS v4u*)(po + i * postep) = pov[i]; }
        const bool has_next = uid + 1 < u1; UnitGeo nxt = cur;
        if (has_next) { nxt = DECODE(uid + 1); if (!nodma) dma_v(a, nxt, lds, vb ^ 1, wid, lane); }
        const int b = cur.b, h = cur.h, d = cur.d, r = cur.r, L = cur.L, m0 = cur.m0;
        {
        f32x16 pS[5];
#define SB() __builtin_amdgcn_sched_barrier(0)
#define LOADKB(KF, kb) do { _Pragma("unroll") for (int k_ = 0; k_ < 4; ++k_) { const f32x4 t_ = *(const LAS f32x4*)(bias_b + 32 * k_ + 128 * (kb)); pS[kb][4 * k_] = t_.x; pS[kb][4 * k_ + 1] = t_.y; pS[kb][4 * k_ + 2] = t_.z; pS[kb][4 * k_ + 3] = t_.w; } \
                            _Pragma("unroll") for (int d_ = 0; d_ < 4; ++d_) KF[d_] = *(const LAS bf16x8*)(kb0 + d_ * 256 + (kb) * 4096); } while (0)
#define MMAKB(KF, kb) do { _Pragma("unroll") for (int d_ = 0; d_ < 4; ++d_) pS[kb] = __builtin_amdgcn_mfma_f32_32x32x16_bf16(KF[d_], qr[d_], pS[kb], 0, 0, 0); } while (0)
        { bf16x8 ka[4], kc[4];
          LOADKB(ka, 0); SB(); LOADKB(kc, 1); SB(); MMAKB(ka, 0); SB(); LOADKB(ka, 2); SB(); MMAKB(kc, 1); SB(); LOADKB(kc, 3); SB(); MMAKB(ka, 2); SB(); LOADKB(ka, 4); SB(); MMAKB(kc, 3); SB(); MMAKB(ka, 4); SB(); }
#undef LOADKB
#undef MMAKB
        {
        ATT_BAR();
        if (has_next) { if (!nodma) dma_k(a, nxt, lds, wid, lane); if (nxt.p != cur.p || nxt.h != cur.h) write_bias(a, nxt, lds, tid); if (!noq) load_q(qr, a, nxt, wid, r32, hi); }
        }
        const int mb = m0 - 64 + 32 * wid;
        if (mb < 0 || mb + 160 > L) {
            const int mbl = mb + 4 * hi;
#pragma unroll
            for (int kb = 0; kb < 5; ++kb)
#pragma unroll
                for (int rg = 0; rg < 16; ++rg) { const int kr0 = 32 * kb + crow(rg, 0); pS[kb][rg] = ((unsigned)(mbl + kr0) < (unsigned)L) ? pS[kb][rg] : -1e30f; }
        }
        float mx = -1e30f;
#pragma unroll
        for (int kb = 0; kb < 5; ++kb)
#pragma unroll
            for (int rg = 0; rg < 16; rg += 2) mx = fmaxf(fmaxf(mx, pS[kb][rg]), pS[kb][rg + 1]);
        mx = fmaxf(mx, __shfl_xor(mx, 32));
        float l = 0.f;
#pragma unroll
        for (int kb = 0; kb < 5; ++kb)
#pragma unroll
            for (int rg = 0; rg < 16; ++rg) { const float e = __builtin_amdgcn_exp2f(pS[kb][rg] - mx); pS[kb][rg] = e; l += e; }
        l += __shfl_xor(l, 32);
        f32x16 o[2];
        o[0] = (f32x16){0.f, 0.f, 0.f, 0.f, 0.f, 0.f, 0.f, 0.f, 0.f, 0.f, 0.f, 0.f, 0.f, 0.f, 0.f, 0.f}; o[1] = o[0];
        const LAS unsigned char* vb0 = lds + V_OFF + vb * VBUF + (4 * wid) * 1024 + (4 * hi + ((lane & 15) >> 2)) * 64 + ((lane >> 4) & 1) * 32 + (lane & 3) * 8;
#define LOADV(VF, kb) do { _Pragma("unroll") for (int s_ = 0; s_ < 2; ++s_) _Pragma("unroll") for (int d_ = 0; d_ < 2; ++d_) { \
            const s16x4 lo_ = vtr(vb0 + d_ * 512 + (2 * (kb) + s_) * 2048), hh_ = vtr(vb0 + d_ * 512 + (2 * (kb) + s_) * 2048 + 1024); \
            VF[s_ * 2 + d_] = (bf16x8){lo_[0], lo_[1], lo_[2], lo_[3], hh_[0], hh_[1], hh_[2], hh_[3]}; } } while (0)
#define MMAV(VF, kb) do { _Pragma("unroll") for (int s_ = 0; s_ < 2; ++s_) { v4u pw_; pw_.x = cvtpk(pS[kb][8 * s_ + 0], pS[kb][8 * s_ + 1]); pw_.y = cvtpk(pS[kb][8 * s_ + 2], pS[kb][8 * s_ + 3]); \
            pw_.z = cvtpk(pS[kb][8 * s_ + 4], pS[kb][8 * s_ + 5]); pw_.w = cvtpk(pS[kb][8 * s_ + 6], pS[kb][8 * s_ + 7]); const bf16x8 pa_ = __builtin_bit_cast(bf16x8, pw_); \
            _Pragma("unroll") for (int d_ = 0; d_ < 2; ++d_) o[d_] = __builtin_amdgcn_mfma_f32_32x32x16_bf16(VF[s_ * 2 + d_], pa_, o[d_], 0, 0, 0); } } while (0)
        { bf16x8 va[4], vc[4];
          LOADV(va, 0); SB(); LOADV(vc, 1); SB(); MMAV(va, 0); SB(); LOADV(va, 2); SB(); MMAV(vc, 1); SB(); LOADV(vc, 3); SB(); MMAV(va, 2); SB(); LOADV(va, 4); SB(); MMAV(vc, 3); SB(); MMAV(va, 4); SB(); }
#undef LOADV
#undef MMAV
#undef SB
        const float li = 1.f / l;
        const size_t tq = (size_t)b * SEQ + (size_t)(m0 + 32 * wid + r32) * d + r;
        {
        pl = (float*)(a.ws + WS_LSE) + (size_t)cur.p * T * 16 + tq * 16 + h; plv = mx + __builtin_amdgcn_logf(l);
        ATT_BAR();
        LAS unsigned char* stg = lds + V_OFF + vb * VBUF + wid * (32 * 144);
#pragma unroll
        for (int d0 = 0; d0 < 2; ++d0)
#pragma unroll
            for (int k = 0; k < 4; ++k)
                *(LAS v2u*)(stg + r32 * 144 + (32 * d0 + 8 * k + 4 * hi) * 2) = (v2u){cvtpk(o[d0][4 * k] * li, o[d0][4 * k + 1] * li), cvtpk(o[d0][4 * k + 2] * li, o[d0][4 * k + 3] * li)};
        LDS_WAIT();
        { const int row = lane >> 3, ch = lane & 7;
          po = (GAS unsigned char*)(a.ws + WS_OP) + ((size_t)cur.p * T + (size_t)b * SEQ + (size_t)(m0 + 32 * wid + row) * d + r) * 2048 + h * 128 + ch * 16; postep = (size_t)8 * d * 2048;
#pragma unroll
          for (int i = 0; i < 4; ++i) pov[i] = *(const LAS v4u*)(stg + (row + 8 * i) * 144 + ch * 16); }
        LDS_WAIT();
        }
        }
        vb ^= 1; cur = nxt;
    }
    { if (hi == 0) *pl = plv;
#pragma unroll
        for (int i = 0; i < 4; ++i) *(GAS v4u*)(po + i * postep) = pov[i]; }
    asm volatile("s_waitcnt vmcnt(0) lgkmcnt(0)\n\ts_barrier" ::: "memory");
}
#undef ATT_BAR
}
namespace gla {
constexpr int PACK_QK = 32768, PACK_ATT = 9216;
constexpr float DKS = 0.08838834764831845f;
__device__ __forceinline__ unsigned cvtpk(float lo, float hi) { typedef float f2 __attribute__((ext_vector_type(2))); typedef __bf16 b2 __attribute__((ext_vector_type(2))); f2 v = {lo, hi}; b2 b = __builtin_convertvector(v, b2); return __builtin_bit_cast(unsigned, b); }
__device__ __forceinline__ int idx32(int g, int jj) { return 16 * (jj >> 2) + 4 * g + (jj & 3); }
__device__ __forceinline__ float fexp(float x) { return __builtin_amdgcn_exp2f(x * LOG2E); }
__device__ __forceinline__ float logsig16(float x) { return (fminf(x, 0.f) - __builtin_amdgcn_logf(1.f + fexp(-fabsf(x))) * 0.6931471805599453f) * (1.f / 16.f); }
typedef short v4i16_t __attribute__((ext_vector_type(4)));
__device__ __forceinline__ s16x4 vtr(const LAS unsigned char* p) { return __builtin_bit_cast(s16x4, __builtin_amdgcn_ds_read_tr16_b64_v4i16((LAS v4i16_t*)p)); }
constexpr int ROWB = 272  , GROW = 136  ;
constexpr int LRROW = 36  ;
constexpr int L_QT = 0, L_KT = 64 * ROWB, L_LR = 2 * 64 * ROWB, L_G = L_LR + 64 * LRROW * 4, L_GT = L_G + 2 * 64 * GROW * 4, L_TOT = L_GT + 4096, L_KBM = L_TOT + 1024  , L_PREP_END = L_KBM + 32768;
static_assert(L_PREP_END <= RING_BYTES, "prep LDS map");

__device__ __forceinline__ void prep_unit(Frame& F, const Args& a, int uid, const int knobs = 0) {
    const int b = uid >> 9, h = (uid >> 7) & 3, n = uid & 127; const size_t t0 = (size_t)b * SEQ + 64 * n;
    const bf16* gq = (const bf16*)(a.ws + WS_GQ); const bf16* gk = (const bf16*)(a.ws + WS_GK); const float* lr = (const float*)(a.ws + WS_LR);
    LAS unsigned char* lds = F.lds; const int tid = F.tid, lane = F.lane, wid = F.wave;
    float upb[2][4], bsv[2];
#pragma unroll
    for (int dir = 0; dir < 2; ++dir) { const float* up = a.in[dir ? 7 : 5] + h * 128 + 16 * wid + (lane & 15); bsv[dir] = a.in[dir ? 8 : 6][h * 128 + 16 * wid + (lane & 15)];
#pragma unroll
        for (int ks = 0; ks < 4; ++ks) upb[dir][ks] = up[(4 * ks + (lane >> 4)) * 512]; }
#pragma unroll
    for (int i = 0; i < 2; ++i) { const int pid = tid + 512 * i, row = pid >> 4, c16 = pid & 15; const size_t off = (t0 + row) * 512 + h * 128 + c16 * 8;
        *(LAS v4u*)(lds + L_QT + row * ROWB + c16 * 16) = __builtin_nontemporal_load((const GAS v4u*)(gq + off)); *(LAS v4u*)(lds + L_KT + row * ROWB + c16 * 16) = __builtin_nontemporal_load((const GAS v4u*)(gk + off)); }
    { const int row = tid >> 3, c16 = tid & 7; *(LAS v4u*)(lds + L_LR + row * (LRROW * 4) + c16 * 16) = __builtin_nontemporal_load((const GAS v4u*)(lr + (t0 + row) * 32 + c16 * 4)); }
    __syncthreads();
    LAS float* G = (LAS float*)(lds + L_G); LAS float* TOT = (LAS float*)(lds + L_TOT); const LAS float* LR = (const LAS float*)(lds + L_LR);
    if (!(knobs & 1)) { const int li2 = lane & 15, g2 = lane >> 4, c = 16 * wid + li2;
#pragma unroll
      for (int dir = 0; dir < 2; ++dir) { f32x4 gl[4];
#pragma unroll
          for (int mt = 0; mt < 4; ++mt) { f32x4 acc = (f32x4){0.f, 0.f, 0.f, 0.f};
#pragma unroll
              for (int ks = 0; ks < 4; ++ks) acc = __builtin_amdgcn_mfma_f32_16x16x4f32(LR[(16 * mt + li2) * LRROW + dir * 16 + 4 * ks + g2], upb[dir][ks], acc, 0, 0, 0);
#pragma unroll
              for (int rg = 0; rg < 4; ++rg) gl[mt][rg] = logsig16(acc[rg] + bsv[dir]); }
          float off = 0.f;
#pragma unroll
          for (int m2 = 0; m2 < 4; ++m2) { const int mt = dir ? 3 - m2 : m2; f32x4 p; float t;
              if (!dir) { p[0] = gl[mt][0]; p[1] = p[0] + gl[mt][1]; p[2] = p[1] + gl[mt][2]; p[3] = p[2] + gl[mt][3]; t = p[3]; }
              else      { p[3] = gl[mt][3]; p[2] = p[3] + gl[mt][2]; p[1] = p[2] + gl[mt][1]; p[0] = p[1] + gl[mt][0]; t = p[0]; }
              float sc = t, u;
              if (!dir) { u = __shfl_up(sc, 16); if (g2 >= 1) sc += u; u = __shfl_up(sc, 32); if (g2 >= 2) sc += u; }
              else      { u = __shfl_down(sc, 16); if (g2 <= 2) sc += u; u = __shfl_down(sc, 32); if (g2 <= 1) sc += u; }
              const float add = sc - t + off;
#pragma unroll
              for (int rg = 0; rg < 4; ++rg) G[(dir * 64 + 16 * mt + 4 * g2 + rg) * GROW + c] = p[rg] + add;
              off += __shfl(sc, (dir ? 0 : 48) + li2); }
          if (g2 == 0) TOT[dir * 128 + c] = off; } }
    __syncthreads();
    if (knobs & 2) { __syncthreads(); return; }
    const int dir = wid >> 2, it = wid & 3, li = lane & 15, g = lane >> 4;
    const int cid = ((b * 4 + h) * 2 + dir) * 128 + n;
    unsigned char* qk_pack = a.ws + WS_H + (size_t)cid * PACK_QK; unsigned char* att_pack = a.ws + WS_ATT + (size_t)cid * PACK_ATT;
    const LAS float* Gd = G + dir * 64 * GROW;
    auto frag = [&](int tile_off, int row, int ks, float sgn, float mul) -> bf16x8 {
        float v[8];
#pragma unroll
        for (int hf = 0; hf < 2; ++hf) { const int c = 32 * ks + 16 * hf + 4 * g;
            const v2u xw = *(const LAS v2u*)(lds + tile_off + row * ROWB + c * 2); const f32x4 bb = *(const LAS f32x4*)(Gd + row * GROW + c);
            v[4 * hf + 0] = __builtin_bit_cast(float, xw.x << 16) * fexp(sgn * bb.x) * mul; v[4 * hf + 1] = __builtin_bit_cast(float, xw.x & 0xffff0000u) * fexp(sgn * bb.y) * mul;
            v[4 * hf + 2] = __builtin_bit_cast(float, xw.y << 16) * fexp(sgn * bb.z) * mul; v[4 * hf + 3] = __builtin_bit_cast(float, xw.y & 0xffff0000u) * fexp(sgn * bb.w) * mul; }
        v4u w; w.x = cvtpk(v[0], v[1]); w.y = cvtpk(v[2], v[3]); w.z = cvtpk(v[4], v[5]); w.w = cvtpk(v[6], v[7]); return __builtin_bit_cast(bf16x8, w); };
    bf16x8 qf[4];
#pragma unroll
    for (int ks = 0; ks < 4; ++ks) { qf[ks] = frag(L_QT, 16 * it + li, ks, 1.f, DKS); *(GAS v4u*)(qk_pack + ((it * 4 + ks) * 64 + lane) * 16) = __builtin_bit_cast(v4u, qf[ks]); }
#pragma unroll
    for (int ks = 0; ks < 4; ++ks) *(LAS v4u*)(lds + L_KBM + (((dir * 4 + it) * 4 + ks) * 64 + lane) * 16) = __builtin_bit_cast(v4u, frag(L_KT, 16 * it + li, ks, -1.f, 1.f));
    __syncthreads();
    f32x4 at[4];
#pragma unroll
    for (int jt = 0; jt < 4; ++jt) { at[jt] = (f32x4){0.f, 0.f, 0.f, 0.f};
#pragma unroll
        for (int ks = 0; ks < 4; ++ks) { const bf16x8 kf = *(const LAS bf16x8*)(lds + L_KBM + (((dir * 4 + jt) * 4 + ks) * 64 + lane) * 16); at[jt] = __builtin_amdgcn_mfma_f32_16x16x32_bf16(kf, qf[ks], at[jt], 0, 0, 0); }
#pragma unroll
        for (int rg = 0; rg < 4; ++rg) { const int j = 16 * jt + 4 * g + rg, i = 16 * it + li; const bool keep = dir ? (j >= i) : (j <= i); at[jt][rg] = keep ? at[jt][rg] : 0.f; } }
#pragma unroll
    for (int ks2 = 0; ks2 < 2; ++ks2) { v4u w; w.x = cvtpk(at[2 * ks2][0], at[2 * ks2][1]); w.y = cvtpk(at[2 * ks2][2], at[2 * ks2][3]); w.z = cvtpk(at[2 * ks2 + 1][0], at[2 * ks2 + 1][1]); w.w = cvtpk(at[2 * ks2 + 1][2], at[2 * ks2 + 1][3]);
        *(GAS v4u*)(att_pack + ((it * 2 + ks2) * 64 + lane) * 16) = w; }
#pragma unroll
    for (int q2 = 0; q2 < 4; ++q2) { const int ct = 2 * it + (q2 >> 1), ks2 = q2 & 1, c = 16 * ct + li; const float te = TOT[dir * 128 + c]; float v[8];
#pragma unroll
        for (int jj = 0; jj < 8; ++jj) { const int j = 32 * ks2 + idx32(g, jj); const float kx = bf2f(*(const LAS bf16*)(lds + L_KT + j * ROWB + c * 2)); v[jj] = kx * fexp(te - Gd[j * GROW + c]); }
        v4u w; w.x = cvtpk(v[0], v[1]); w.y = cvtpk(v[2], v[3]); w.z = cvtpk(v[4], v[5]); w.w = cvtpk(v[6], v[7]);
        *(GAS v4u*)(qk_pack + 16384 + ((ct * 2 + ks2) * 64 + lane) * 16) = w; }
    if (tid < 256) { const int d2 = tid >> 7, c = tid & 127; *(float*)(a.ws + WS_ATT + (size_t)(((b * 4 + h) * 2 + d2) * 128 + n) * PACK_ATT + 8192 + c * 4) = fexp(TOT[d2 * 128 + c]); }
    __syncthreads();
}
__device__ __forceinline__ void prep_phase(Frame& F, const Args& a, int set, int c, int ncu, const int knobs = 0) {
    for (int u = c; u < 1024; u += ncu) { const int nn = u & 63, n = set == 0 ? (nn < 32 ? nn : 64 + nn) : 32 + nn; prep_unit(F, a, ((u >> 6) << 7) | n, knobs); }
}

constexpr int S_ATT = 0, S_DEC = 8192, S_QK = 9216, S_V = 9216 + 32768, S_BUF = S_V + 16384;
constexpr int S_O = 2 * S_BUF, OROW = 272, S_OT = 64 * OROW;
static_assert(S_O + 2 * S_OT <= RING_BYTES && (S_BUF % 1024) == 0, "scan LDS map");
template <class MidFn> __device__ __forceinline__ void scan_unit(Frame& F, const Args& a, int su, const MidFn& mid, const int knobs = 0) {
    const bool nodma = knobs & 1, nomath = knobs & 2, nostore = knobs & 4;
    const int bh = su >> 2, dir = (su >> 1) & 1, half = su & 1, b = bh >> 2, h = bh & 3;
    const int cid0 = ((b * 4 + h) * 2 + dir) * 128;
    LAS unsigned char* lds = F.lds; const int tid = F.tid, lane = F.lane, wid = F.wave, li = lane & 15, g = lane >> 4;
    const unsigned char* gvb = a.ws + WS_GV + (size_t)b * SEQ * 2048 + h * 512 + half * 256;
    unsigned char* ob = a.ws + (dir ? WS_OB : WS_OF) + (size_t)b * SEQ * 2048 + h * 512 + half * 256 + (size_t)(tid >> 4) * 2048 + (tid & 15) * 16;
    const int ow = (16 * wid + 4 * g) * 2 + li * OROW;
    const unsigned lds0 = (unsigned)(size_t)lds;
    int pk[8]; unsigned pvo[8], plo[8];
#pragma unroll
    for (int j = 0; j < 8; ++j) { const int p = wid + 8 * j;
        if (p < 9) { pk[j] = 0; pvo[j] = p * 1024 + lane * 16; plo[j] = S_ATT + p * 1024; }
        else if (p < 41) { pk[j] = 1; pvo[j] = (p - 9) * 1024 + lane * 16; plo[j] = S_QK + (p - 9) * 1024; }
        else if (p < 57) { const int pv = p - 41, row = 4 * pv + (lane >> 4), c = (lane & 15) ^ (2 * (row & 7)); pk[j] = 2; pvo[j] = row * 2048 + c * 16; plo[j] = S_V + pv * 1024; }
        else { pk[j] = 3; pvo[j] = 0; plo[j] = 0; } }
    auto issue = [&](int n, int bufoff) {
        const int cid = cid0 + n; const unsigned char* b0 = a.ws + WS_ATT + (size_t)cid * PACK_ATT; const unsigned char* b1 = a.ws + WS_H + (size_t)cid * PACK_QK; const unsigned char* b2 = gvb + (size_t)(64 * n) * 2048;
#pragma unroll
        for (int j = 0; j < 8; ++j) if (pk[j] != 3) glds16s(pk[j] == 0 ? b0 : (pk[j] == 1 ? b1 : b2), pvo[j], lds0 + bufoff + plo[j]);
    };
    f32x4 S[8];
#pragma unroll
    for (int ct = 0; ct < 8; ++ct) S[ct] = (f32x4){0.f, 0.f, 0.f, 0.f};
    const int vq = li >> 2, vp = li & 3;
    const int voff = (4 * g + vq) * 256 + (((2 * wid + (vp >> 1)) ^ (2 * ((4 * (g & 1) + vq)))) * 16) + 8 * (vp & 1);
    __builtin_amdgcn_s_waitcnt(0);
    auto step = [&](int s, int sb, int se) __attribute__((always_inline)) {
        const int n = dir ? 127 - s : s; const int bufoff = (s & 1) * S_BUF;
        if (!nostore && s > sb) { unsigned char* op = ob + (size_t)(64 * (dir ? n + 1 : n - 1)) * 2048; const LAS unsigned char* ot = lds + S_O + ((s - 1) & 1) * S_OT + (tid >> 4) * OROW + (tid & 15) * 16;
#pragma unroll
          for (int p = 0; p < 2; ++p) *(GAS v4u*)(op + (size_t)(32 * p) * 2048) = *(const LAS v4u*)(ot + 32 * p * OROW); }
        if (s + 1 < se && !nodma) issue(dir ? 126 - s : s + 1, S_BUF - bufoff);
        const LAS unsigned char* B = lds + bufoff;
        if (!nomath) {
        bf16x8 vf[2];
#pragma unroll
        for (int ks2 = 0; ks2 < 2; ++ks2) { const s16x4 lo = vtr(B + S_V + voff + ks2 * 8192), hh = vtr(B + S_V + voff + ks2 * 8192 + 4096); vf[ks2] = (bf16x8){lo[0], lo[1], lo[2], lo[3], hh[0], hh[1], hh[2], hh[3]}; }
        bf16x8 sf[4];
#pragma unroll
        for (int ks = 0; ks < 4; ++ks) { v4u w; w.x = cvtpk(S[2 * ks][0], S[2 * ks][1]); w.y = cvtpk(S[2 * ks][2], S[2 * ks][3]); w.z = cvtpk(S[2 * ks + 1][0], S[2 * ks + 1][1]); w.w = cvtpk(S[2 * ks + 1][2], S[2 * ks + 1][3]); sf[ks] = __builtin_bit_cast(bf16x8, w); }
#define SB() __builtin_amdgcn_sched_barrier(0)
#define LOADO(D, mt) do { _Pragma("unroll") for (int k_ = 0; k_ < 4; ++k_) D[k_] = *(const LAS bf16x8*)(B + S_QK + (((mt) * 4 + k_) * 64 + lane) * 16); \
                          _Pragma("unroll") for (int k_ = 0; k_ < 2; ++k_) D[4 + k_] = *(const LAS bf16x8*)(B + S_ATT + (((mt) * 2 + k_) * 64 + lane) * 16); } while (0)
#define MMAO(D, mt) do { f32x4 o_ = (f32x4){0.f, 0.f, 0.f, 0.f}; _Pragma("unroll") for (int k_ = 0; k_ < 4; ++k_) o_ = __builtin_amdgcn_mfma_f32_16x16x32_bf16(sf[k_], D[k_], o_, 0, 0, 0); \
                         _Pragma("unroll") for (int k_ = 0; k_ < 2; ++k_) o_ = __builtin_amdgcn_mfma_f32_16x16x32_bf16(vf[k_], D[4 + k_], o_, 0, 0, 0); *(LAS v2u*)(otile + (16 * (mt)) * OROW) = (v2u){cvtpk(o_[0], o_[1]), cvtpk(o_[2], o_[3])}; } while (0)
#define LOADS(D, V, c2) do { _Pragma("unroll") for (int k_ = 0; k_ < 4; ++k_) D[k_] = *(const LAS bf16x8*)(B + S_QK + 16384 + (((c2) * 4 + k_) * 64 + lane) * 16); \
                             V[0] = *(const LAS f32x4*)(B + S_DEC + (32 * (c2) + 4 * g) * 4); V[1] = *(const LAS f32x4*)(B + S_DEC + (32 * (c2) + 16 + 4 * g) * 4); } while (0)
#define MMAS(D, V, c2) do { _Pragma("unroll") for (int t_ = 0; t_ < 2; ++t_) { S[2 * (c2) + t_] = S[2 * (c2) + t_] * V[t_]; \
                            _Pragma("unroll") for (int k_ = 0; k_ < 2; ++k_) S[2 * (c2) + t_] = __builtin_amdgcn_mfma_f32_16x16x32_bf16(D[2 * t_ + k_], vf[k_], S[2 * (c2) + t_], 0, 0, 0); } } while (0)
        LAS unsigned char* otile = lds + S_O + (s & 1) * S_OT + ow;
        bf16x8 fa[6], fb[6]; f32x4 da[2], db[2];
        LOADO(fa, 0); SB(); LOADO(fb, 1); SB(); MMAO(fa, 0); SB(); LOADO(fa, 2); SB(); MMAO(fb, 1); SB(); LOADO(fb, 3); SB(); MMAO(fa, 2); SB();
        LOADS(fa, da, 0); SB(); MMAO(fb, 3); SB(); LOADS(fb, db, 1); SB(); MMAS(fa, da, 0); SB(); LOADS(fa, da, 2); SB(); MMAS(fb, db, 1); SB(); LOADS(fb, db, 3); SB(); MMAS(fa, da, 2); SB(); MMAS(fb, db, 3); SB();
#undef LOADO
#undef MMAO
#undef LOADS
#undef MMAS
#undef SB
        }
        asm volatile("s_waitcnt vmcnt(0) lgkmcnt(0)\n\ts_barrier" ::: "memory");
    };
    for (int seg = 0; seg < 2; ++seg) { const int sb = seg ? 32 : 0, se = seg ? 128 : 32;
        asm volatile("s_waitcnt vmcnt(0) lgkmcnt(0)\n\ts_barrier" ::: "memory");
        issue(dir ? 127 - sb : sb, (sb & 1) * S_BUF);
        asm volatile("s_waitcnt vmcnt(0) lgkmcnt(0)\n\ts_barrier" ::: "memory");
        for (int s = sb; s < se; ++s) step(s, sb, se);
        if (!nostore) { unsigned char* op = ob + (size_t)(64 * (dir ? 128 - se : se - 1)) * 2048; const LAS unsigned char* ot = lds + S_O + ((se - 1) & 1) * S_OT + (tid >> 4) * OROW + (tid & 15) * 16;
#pragma unroll
          for (int p = 0; p < 2; ++p) *(GAS v4u*)(op + (size_t)(32 * p) * 2048) = *(const LAS v4u*)(ot + 32 * p * OROW); }
        asm volatile("s_waitcnt vmcnt(0)" ::: "memory");
        if (seg == 0) mid();
    }
}
}
__global__ void __launch_bounds__(NWAVES * 64, 2) mega(Args args) {
    extern __shared__ __attribute__((aligned(16))) unsigned char lds[];
    Frame F;
    F.lds = (LAS unsigned char*)lds; F.MISC = (volatile LAS unsigned*)(F.lds + MISC_OFF);
    F.tid = threadIdx.x; F.lane = F.tid & 63; F.wave = __builtin_amdgcn_readfirstlane(F.tid >> 6);
    F.G = gridDim.x; { const int bx = blockIdx.x; F.vcu = (F.G % 8 == 0) ? (bx % 8) * (F.G / 8) + bx / 8 : bx; }
    unsigned char* ws = args.ws;
    F.ctl = (gu32*)(ws + WS_CTL);
    for (int u = F.tid; u < (LDS_BYTES - LDSCTL_OFF) / 4; u += NWAVES * 64) ((LAS unsigned*)(F.lds + LDSCTL_OFF))[u] = 0u;
    __syncthreads();
    XcdBarrier bar = xcd_barrier_post((unsigned*)(F.ctl + CW_BAR) + args.li * XCD_BAR_WORDS, F.MISC + 8);
    const int lo = args.ph_lo, hi = args.ph_hi;
#define IN(k) (lo <= (k) && (k) < hi)
#define BOTH(k) (IN(k) && IN((k) + 1))
    ProjOut P{(bf16*)(ws + WS_AQ), (bf16*)(ws + WS_AK), (bf16*)(ws + WS_AV), (bf16*)(ws + WS_SAG), (bf16*)(ws + WS_GQ), (bf16*)(ws + WS_GK), (bf16*)(ws + WS_GV), (bf16*)(ws + WS_SGG), (float*)(ws + WS_LR)};
    if (IN(0)) { p0_mod(F, args); if (BOTH(0)) xcd_barrier(bar); }
    if (IN(1)) { p1_h(F, args); p1_weights(F, args); if (BOTH(1)) xcd_barrier(bar); }
    if (IN(2)) {
        pg8::Gemm g{(const bf16*)(ws + WS_H), (const bf16*)(ws + WS_WINT), T, 7168, DM}; pg8::StaticOrder S; S.init(T, 7168, F.G, (int)blockIdx.x);
#ifdef PROBE_G2
        S.reps = 2;
#endif
        pg8::EpiProj E{P};
        pg8::gemm_phase<pg8::EpiProj, pg8::StaticOrder, true, true>(F.lds + RING_OFF, g, S, E);
        lr_tail(F, args);
        if (BOTH(2)) xcd_barrier(bar);
    }
    if (IN(3)) {
#ifdef PROBE_P
        { int q = F.vcu; asm volatile("" : "+s"(q)); gla::prep_phase(F, args, 0, q, F.G, PROBE_P); }
#endif
        gla::prep_phase(F, args, 0, F.vcu, F.G); if (BOTH(3)) xcd_barrier(bar); }
    if (IN(4)) {
        const int ac = (F.vcu >> 2) * 3 + (F.vcu & 3) - 1, anc = (F.G >> 2) * 3;
#ifdef PROBE_S
        if ((F.vcu & 3) == 0) { int q = F.vcu >> 2; asm volatile("" : "+s"(q)); gla::scan_unit(F, args, q, [&]() {}, PROBE_S); }
#endif
        if ((F.vcu & 3) == 0) gla::scan_unit(F, args, F.vcu >> 2, [&]() { xcd_barrier(bar); });
        else { gla::prep_phase(F, args, 1, ac, anc); xcd_barrier(bar);
#ifdef PROBE_A2
            { int q = ac; asm volatile("" : "+s"(q)); att::attn_phase(F, args, q, anc, PROBE_A2); }
#endif
            att::attn_phase(F, args, ac, anc);
        }
        if (BOTH(4)) xcd_barrier(bar); }
    if (IN(5)) { p5_combine(F, args); if (BOTH(5)) xcd_barrier(bar); }
    if (IN(6)) {
        pg8::Gemm g{(const bf16*)(ws + WS_H), (const bf16*)(ws + WS_WOUTT), T, DM, DM}; pg8::StaticOrder S; S.init(T, DM, F.G, (int)blockIdx.x);
#ifdef PROBE_G6
        S.reps = 2;
#endif
        pg8::EpiY E{(bf16*)(ws + WS_Y)};
        pg8::gemm_phase<pg8::EpiY, pg8::StaticOrder, true, true>(F.lds + RING_OFF, g, S, E);
        if (BOTH(6)) xcd_barrier(bar);
    }
    if (IN(7)) { p7_final(F, args); }
#undef IN
#undef BOTH
}
extern "C" void kernel_launch(void* const* d_in, const int* in_sizes, int n_in, void* d_out, int out_size, void* d_ws, size_t ws_size, hipStream_t stream) {
    static int grid = 0;
    if (grid == 0) {
        if (n_in != 13 || ws_size < WS_END || out_size != T * DM) { fprintf(stderr, "kernel_launch: unexpected problem (n_in %d, ws %zu, out %d)\n", n_in, ws_size, out_size); grid = -1; return; }
        int dev = 0, cus = 0, per_cu = 0;
        if (hipGetDevice(&dev) != hipSuccess || hipDeviceGetAttribute(&cus, hipDeviceAttributeMultiprocessorCount, dev) != hipSuccess) { grid = -1; return; }
        if (hipFuncSetAttribute((const void*)mega, hipFuncAttributeMaxDynamicSharedMemorySize, LDS_BYTES) != hipSuccess) { fprintf(stderr, "kernel_launch: hipFuncSetAttribute failed\n"); grid = -1; return; }
        if (hipOccupancyMaxActiveBlocksPerMultiprocessor(&per_cu, (const void*)mega, NWAVES * 64, LDS_BYTES) != hipSuccess || per_cu < 1) { fprintf(stderr, "kernel_launch: occupancy query says %d\n", per_cu); }
        (void)hipGetLastError();
        grid = cus;
    }
    if (grid < 0) return;
    (void)hipMemsetAsync((char*)d_ws + WS_CTL, 0, CTL_ZERO_BYTES, stream);
    Args a{};
    for (int i = 0; i < 13; ++i) a.in[i] = (const float*)d_in[i];
    a.out = (float*)d_out; a.ws = (unsigned char*)d_ws;
    unsigned char* ws = (unsigned char*)d_ws;
#ifndef PROBE_DUP
#define PROBE_DUP -1
#endif
#ifndef PROBE_REPS
#define PROBE_REPS 2
#endif
#ifndef PROBE_SUB
#define PROBE_SUB 2
#endif
    a.ph_lo = 0; a.ph_hi = 8; a.li = 0; a.dup_phase = PROBE_DUP; a.dup_reps = PROBE_REPS; a.dup_sub = PROBE_SUB;
    hipLaunchKernelGGL(mega, dim3(grid), dim3(NWAVES * 64), LDS_BYTES, stream, a);
}
```

```cpp
#include <hip/hip_runtime.h>
#include <stdint.h>
#include <cstdio>
#include <type_traits>

typedef unsigned short bf16;
constexpr int BATCH = 4, SEQ = 8192, DM = 2048, T = BATCH * SEQ;
constexpr int NPROJ = 7200, NPAD = 7424;
constexpr float EPS = 1e-6f;
constexpr float LOG2E = 1.4426950408889634f;
constexpr float C2 = 0.125f * LOG2E;
constexpr size_t MiB = 1u << 20;
constexpr size_t WS_CTL = 0, CTL_ZERO_BYTES = 1 * MiB, WS_MOD = 1 * MiB, WS_SSP = 1 * MiB + 512 * 1024  , WS_WINT = 2 * MiB, WS_WOUTT = 32 * MiB,
                 WS_H = 40 * MiB  ,
                 WS_AQ = 168 * MiB, WS_AK = 232 * MiB, WS_AV = 296 * MiB, WS_SAG = 360 * MiB, WS_GQ = 424 * MiB, WS_GK = 456 * MiB, WS_GV = 488 * MiB,
                 WS_SGG = 552 * MiB, WS_LR = 616 * MiB, WS_OP = 620 * MiB  , WS_LSE = 812 * MiB  , WS_OF = 818 * MiB, WS_OB = 882 * MiB,
                 WS_SS = 946 * MiB  , WS_ATT = 950 * MiB  ,
                 WS_Y = WS_AQ  ,
                 WS_END = 986 * MiB;

__device__ __forceinline__ unsigned f2bf(float f) { unsigned u = __builtin_bit_cast(unsigned, f); return (u + 0x7fffu + ((u >> 16) & 1u)) >> 16; }
__device__ __forceinline__ unsigned pk2(float lo, float hi) { typedef float f2_ __attribute__((ext_vector_type(2))); typedef __bf16 b2_ __attribute__((ext_vector_type(2))); f2_ v = {lo, hi}; b2_ b = __builtin_convertvector(v, b2_); return __builtin_bit_cast(unsigned, b); }
__device__ __forceinline__ float bf2f(bf16 h) { return __builtin_bit_cast(float, (unsigned)h << 16); }
__device__ __forceinline__ float silu_f(float x) { return x / (1.f + __expf(-x)); }
__device__ __forceinline__ float log_sigmoid_f(float x) { return fminf(x, 0.f) - log1pf(__expf(-fabsf(x))); }
__device__ __forceinline__ int t5_bucket(int rel) {
    const int n = rel < 0 ? -rel : rel;
    int v;
    if (n < 8) v = n;
    else v = 8 + (n >= 15) + (n >= 27) + (n >= 50) + (n >= 91) + (n >= 166) + (n >= 305) + (n >= 559);
    return (rel > 0 ? 16 : 0) + v;
}
struct ProjOut { bf16 *aq, *ak, *av, *sag, *gq, *gk, *gv, *sgg; float* lr; };
namespace pg8 {
#define PG8_LAS __attribute__((address_space(3)))
typedef unsigned short bf16_t;
typedef short bf16x8 __attribute__((ext_vector_type(8)));
typedef float f32x4 __attribute__((ext_vector_type(4)));
typedef unsigned u32x4 __attribute__((ext_vector_type(4)));
constexpr int BM = 256, BK = 64, HALF = 128, HTB = HALF * BK * 2  , STAGE_BYTES = 8 * HTB, NXCD = 8, WGM = 8;

__host__ __device__ __forceinline__ int lds_byte(int r, int c) { const int st = (r >> 4) * 2 + (c >> 5), rr = r & 15, cc = c & 31, ob = rr * 64 + cc * 2; return st * 1024 + (ob ^ (((ob >> 9) & 1) << 5)); }
__host__ __device__ __forceinline__ void stage_rc(int b, int& R, int& C) { const int st = b / 1024, sb = b % 1024, swz = sb ^ (((sb >> 9) & 1) << 5); R = (st >> 1) * 16 + swz / 64; C = (st & 1) * 32 + (swz % 64) / 2; }
__host__ __device__ __forceinline__ int perm32(int rho) { const int n = rho >> 4, i = rho & 15; return 8 * (i >> 2) + 4 * n + (i & 3); }

struct Unit { int pm, pn; };
struct Gemm { const bf16_t* A; const bf16_t* Bt; int M, N, K; };

struct StaticOrder {
    int nM, nN, nwg, G, c, reps;
    __host__ __device__ void init(int M, int N, int G_, int c_) { nM = M / BM; nN = N / BM; nwg = nM * nN; G = G_; c = c_; reps = 1; }
    __host__ __device__ bool next(int i, Unit& u) const {
        const long L = (long)i * G + c; if (L >= (long)nwg * reps) return false;
        int wgid = (int)(L % nwg); { const int q = nwg / NXCD, r = nwg % NXCD, xcd = wgid % NXCD, off = wgid / NXCD; wgid = (xcd < r ? xcd * (q + 1) : r * (q + 1) + (xcd - r) * q) + off; }
        const int nig = WGM * nN, gid = wgid / nig, fm = gid * WGM, gsz = (nM - fm) < WGM ? (nM - fm) : WGM;
        u.pm = fm + ((wgid % nig) % gsz); u.pn = (wgid % nig) / gsz; return true;
    }
    __device__ __forceinline__ void a_ready(const Unit&) const {}
    __device__ __forceinline__ void done(const Unit&) const {}
};

__device__ __forceinline__ unsigned cvt_pk_bf16(float lo, float hi) { unsigned r; asm volatile("v_cvt_pk_bf16_f32 %0, %1, %2" : "=v"(r) : "v"(lo), "v"(hi)); return r; }
struct EpiProj {
    static constexpr bool PERM = true, AFTER_DRAIN = false;
    ProjOut P;
    __device__ __forceinline__ void operator()(const f32x4 (&acc)[2][2][4][2], const Unit& u, int wr, int wc, int fr, int fq) const {
        const int row0 = u.pm * BM + wr * 64 + fr; const int pn = u.pn;
        if (pn == 28) {
            if (wc == 0) {
#pragma unroll
                for (int ai = 0; ai < 2; ++ai)
#pragma unroll
                    for (int m = 0; m < 4; ++m) { float* rowp = P.lr + (size_t)(row0 + ai * HALF + m * 16) * 32 + 8 * fq;
                        *(f32x4*)(rowp) = acc[ai][0][m][0]; *(f32x4*)(rowp + 4) = acc[ai][0][m][1]; }
            }
            return;
        }
        bf16_t* base; int ld, ct; int act = 0; float sc = 1.f;
        if (pn < 4) { base = P.aq; ld = 1024; ct = pn; sc = C2; }
        else if (pn < 8) { base = P.ak; ld = 1024; ct = pn - 4; }
        else if (pn < 12) { base = P.av; ld = 1024; ct = pn - 8; }
        else if (pn < 16) { base = P.sag; ld = 1024; ct = pn - 12; act = 1; }
        else if (pn < 18) { base = P.gq; ld = 512; ct = pn - 16; }
        else if (pn < 20) { base = P.gk; ld = 512; ct = pn - 18; }
        else if (pn < 24) { base = P.gv; ld = 1024; ct = pn - 20; }
        else { base = P.sgg; ld = 1024; ct = pn - 24; act = 1; }
        const int col0 = ct * BM + wc * 32 + 8 * fq;
#pragma unroll
        for (int ai = 0; ai < 2; ++ai)
#pragma unroll
            for (int m = 0; m < 4; ++m) { bf16_t* rowp = base + (size_t)(row0 + ai * HALF + m * 16) * ld + col0;
#pragma unroll
                for (int bj = 0; bj < 2; ++bj) { f32x4 v0 = acc[ai][bj][m][0], v1 = acc[ai][bj][m][1];
                    if (act) {
#pragma unroll
                        for (int e = 0; e < 4; ++e) { v0[e] = v0[e] * __builtin_amdgcn_rcpf(1.f + __expf(-v0[e])); v1[e] = v1[e] * __builtin_amdgcn_rcpf(1.f + __expf(-v1[e])); } }
                    v0 = v0 * sc; v1 = v1 * sc; u32x4 w; w.x = cvt_pk_bf16(v0[0], v0[1]); w.y = cvt_pk_bf16(v0[2], v0[3]); w.z = cvt_pk_bf16(v1[0], v1[1]); w.w = cvt_pk_bf16(v1[2], v1[3]);
                    __builtin_nontemporal_store(w, (u32x4*)(rowp + bj * HALF)); } }
    }
};
struct EpiY {
    static constexpr bool PERM = true, AFTER_DRAIN = false;
    bf16_t* Y;
    __device__ __forceinline__ void operator()(const f32x4 (&acc)[2][2][4][2], const Unit& u, int wr, int wc, int fr, int fq) const {
        const int row0 = u.pm * BM + wr * 64 + fr, col0 = u.pn * BM + wc * 32 + 8 * fq;
#pragma unroll
        for (int ai = 0; ai < 2; ++ai)
#pragma unroll
            for (int m = 0; m < 4; ++m) { bf16_t* rowp = Y + (size_t)(row0 + ai * HALF + m * 16) * DM + col0;
#pragma unroll
                for (int bj = 0; bj < 2; ++bj) { const f32x4 v0 = acc[ai][bj][m][0], v1 = acc[ai][bj][m][1];
                    u32x4 w; w.x = cvt_pk_bf16(v0[0], v0[1]); w.y = cvt_pk_bf16(v0[2], v0[3]); w.z = cvt_pk_bf16(v1[0], v1[1]); w.w = cvt_pk_bf16(v1[2], v1[3]);
                    *(u32x4*)(rowp + bj * HALF) = w; } }
    }
};
template <class Epi, class Sched, bool ALIGN_EPI = false, bool SP2 = false>
__device__ __forceinline__ void gemm_phase(PG8_LAS unsigned char* lds, const Gemm g, const Sched& S, const Epi& E) {
    const int tid = threadIdx.x, wid = __builtin_amdgcn_readfirstlane(tid >> 6), lane = tid & 63, wr = wid >> 2, wc = wid & 3, fr = lane & 15, fq = lane >> 4;
    const int K = g.K, nt = K / BK;
    unsigned voffA[2], voffB[2];
#pragma unroll
    for (int i = 0; i < 2; ++i) { int R, C; stage_rc(tid * 16 + i * 8192, R, C); const int Rb = Epi::PERM ? ((R & ~31) + perm32(R & 31)) : R;
        voffA[i] = (unsigned)(R * K + C) * 2u; voffB[i] = (unsigned)(Rb * K + C) * 2u; }
    const size_t kstep = (size_t)(BK * 2);
    const size_t hstep = (size_t)HALF * K * 2;
    const size_t tstep = 2 * hstep;
    const unsigned ldsw = (unsigned)wid * 1024u;
    const int aoff = lds_byte(wr * 64 + fr, fq * 8), boff = lds_byte(wc * 32 + fr, fq * 8);
#define PG8_SA(b, h) (((b) * 2 + (h)) * HTB)
#define PG8_SB(b, h) ((4 + (b) * 2 + (h)) * HTB)
#define PG8_STAGE(bufoff, gbase, voff) do { _Pragma("unroll") for (int _i = 0; _i < 2; ++_i) \
        __builtin_amdgcn_global_load_lds((const unsigned*)((const char*)(gbase) + (voff)[_i]), (PG8_LAS unsigned*)(lds + (bufoff) + ldsw + _i * 8192), 16, 0, 0); } while (0)
#define PG8_LDA(dst, b, h) do { _Pragma("unroll") for (int m = 0; m < 4; ++m) _Pragma("unroll") for (int k = 0; k < 2; ++k) dst[m][k] = *(const PG8_LAS bf16x8*)(lds + PG8_SA(b, h) + aoff + m * 2048 + k * 1024); } while (0)
#define PG8_LDB(dst, b, h) do { _Pragma("unroll") for (int n = 0; n < 2; ++n) _Pragma("unroll") for (int k = 0; k < 2; ++k) dst[n][k] = *(const PG8_LAS bf16x8*)(lds + PG8_SB(b, h) + boff + n * 2048 + k * 1024); } while (0)
#define PG8_MMA(ai, bj, At, Bt) do { __builtin_amdgcn_s_setprio(1); _Pragma("unroll") for (int m = 0; m < 4; ++m) _Pragma("unroll") for (int n = 0; n < 2; ++n) _Pragma("unroll") for (int k = 0; k < 2; ++k) \
        acc[ai][bj][m][n] = __builtin_amdgcn_mfma_f32_16x16x32_bf16(Bt[n][k], At[m][k], acc[ai][bj][m][n], 0, 0, 0); __builtin_amdgcn_s_setprio(0); } while (0)
#define PG8_WAIT_V(n) asm volatile("s_waitcnt vmcnt(" #n ")" ::: "memory")
#define PG8_WAIT_L(n) asm volatile("s_waitcnt lgkmcnt(" #n ")" ::: "memory")
#define PG8_BAR __builtin_amdgcn_s_barrier()
#define PG8_SCHED __builtin_amdgcn_sched_barrier(0)
    Unit cur, nxt; int ui = 0;
    if (!S.next(0, cur)) return;
    f32x4 acc[2][2][4][2];
#pragma unroll
    for (int a = 0; a < 2; ++a)
#pragma unroll
        for (int b = 0; b < 2; ++b)
#pragma unroll
            for (int m = 0; m < 4; ++m)
#pragma unroll
                for (int n = 0; n < 2; ++n) acc[a][b][m][n] = (f32x4){0.f, 0.f, 0.f, 0.f};
    bf16x8 At[4][2], B0[2][2], B1[2][2];
    const char* cA = (const char*)g.A + (size_t)cur.pm * tstep; const char* cB = (const char*)g.Bt + (size_t)cur.pn * tstep;
    S.a_ready(cur);
    if constexpr (SP2) {
        PG8_STAGE(PG8_SB(0, 0), cB, voffB); PG8_STAGE(PG8_SB(0, 1), cB + hstep, voffB); PG8_STAGE(PG8_SA(0, 0), cA, voffA); PG8_STAGE(PG8_SA(0, 1), cA + hstep, voffA);
        if (wr == 1) PG8_BAR;
        PG8_WAIT_V(2); PG8_BAR;
        PG8_STAGE(PG8_SB(1, 0), cB + kstep, voffB); PG8_STAGE(PG8_SA(1, 0), cA + kstep, voffA); PG8_STAGE(PG8_SB(1, 1), cB + hstep + kstep, voffB);
        PG8_WAIT_V(6); PG8_BAR;
    } else {
        PG8_STAGE(PG8_SB(0, 0), cB, voffB); PG8_STAGE(PG8_SA(0, 0), cA, voffA); PG8_STAGE(PG8_SB(0, 1), cB + hstep, voffB); PG8_STAGE(PG8_SA(0, 1), cA + hstep, voffA);
        if (wr == 1) PG8_BAR;
        PG8_WAIT_V(4); PG8_BAR;
        PG8_STAGE(PG8_SB(1, 0), cB + kstep, voffB); PG8_STAGE(PG8_SA(1, 0), cA + kstep, voffA); PG8_STAGE(PG8_SB(1, 1), cB + hstep + kstep, voffB);
        PG8_WAIT_V(6); PG8_BAR;
    }
    for (;;) {
        const bool has_next = S.next(ui + 1, nxt);
        const char* nA = has_next ? (const char*)g.A + (size_t)nxt.pm * tstep : cA; const char* nB = has_next ? (const char*)g.Bt + (size_t)nxt.pn * tstep : cB;
        for (int t = 0; t < nt; t += 2) {
            const bool last = (t == nt - 2);
            const char* a1 = cA + (size_t)(t + 1) * kstep;
            const char* a2 = last ? nA : cA + (size_t)(t + 2) * kstep; const char* b2 = last ? nB : cB + (size_t)(t + 2) * kstep;
            const char* a3 = a2 + kstep; const char* b3 = b2 + kstep;
            if (last && has_next) S.a_ready(nxt);
            if constexpr (SP2) {
            PG8_LDB(B0, 0, 0); PG8_LDB(B1, 0, 1); PG8_SCHED; PG8_LDA(At, 0, 0); PG8_STAGE(PG8_SA(1, 1), a1 + hstep, voffA);
            PG8_WAIT_V(8); PG8_WAIT_L(0); PG8_BAR; PG8_MMA(0, 0, At, B0); PG8_MMA(0, 1, At, B1); PG8_BAR; PG8_SCHED;
            PG8_LDA(At, 0, 1); PG8_STAGE(PG8_SB(0, 0), b2, voffB); PG8_STAGE(PG8_SB(0, 1), b2 + hstep, voffB); PG8_STAGE(PG8_SA(0, 0), a2, voffA);
            PG8_WAIT_V(8); PG8_WAIT_L(0); PG8_BAR; PG8_MMA(1, 0, At, B0); PG8_MMA(1, 1, At, B1); PG8_BAR; PG8_SCHED;
            PG8_LDB(B0, 1, 0); PG8_LDB(B1, 1, 1); PG8_SCHED; PG8_LDA(At, 1, 0); PG8_STAGE(PG8_SA(0, 1), a2 + hstep, voffA);
            PG8_WAIT_V(8); PG8_WAIT_L(0); PG8_BAR; PG8_MMA(0, 0, At, B0); PG8_MMA(0, 1, At, B1); PG8_BAR; PG8_SCHED;
            PG8_LDA(At, 1, 1); PG8_STAGE(PG8_SB(1, 0), b3, voffB); PG8_STAGE(PG8_SB(1, 1), b3 + hstep, voffB); PG8_STAGE(PG8_SA(1, 0), a3, voffA);
            PG8_WAIT_V(8); PG8_WAIT_L(0); PG8_BAR; PG8_MMA(1, 0, At, B0); PG8_MMA(1, 1, At, B1); PG8_BAR; PG8_SCHED;
            } else {
            PG8_LDB(B0, 0, 0); PG8_SCHED; PG8_LDA(At, 0, 0); PG8_STAGE(PG8_SA(1, 1), a1 + hstep, voffA);
            PG8_WAIT_L(8); PG8_BAR; PG8_WAIT_L(0); PG8_MMA(0, 0, At, B0); PG8_BAR; PG8_SCHED;
            PG8_LDB(B1, 0, 1); PG8_STAGE(PG8_SB(0, 0), b2, voffB);
            PG8_BAR; PG8_WAIT_L(0); PG8_MMA(0, 1, At, B1); PG8_BAR;
            PG8_LDA(At, 0, 1); PG8_STAGE(PG8_SA(0, 0), a2, voffA);
            PG8_BAR; PG8_WAIT_L(0); PG8_MMA(1, 0, At, B0); PG8_BAR; PG8_SCHED;
            PG8_STAGE(PG8_SB(0, 1), b2 + hstep, voffB);
            PG8_WAIT_V(6); PG8_BAR; PG8_MMA(1, 1, At, B1); PG8_BAR;
            PG8_LDB(B0, 1, 0); PG8_SCHED; PG8_LDA(At, 1, 0); PG8_STAGE(PG8_SA(0, 1), a2 + hstep, voffA);
            PG8_WAIT_L(8); PG8_BAR; PG8_WAIT_L(0); PG8_MMA(0, 0, At, B0); PG8_BAR; PG8_SCHED;
            PG8_LDB(B1, 1, 1); PG8_STAGE(PG8_SB(1, 0), b3, voffB);
            PG8_BAR; PG8_WAIT_L(0); PG8_MMA(0, 1, At, B1); PG8_BAR;
            PG8_LDA(At, 1, 1); PG8_STAGE(PG8_SA(1, 0), a3, voffA);
            PG8_BAR; PG8_WAIT_L(0); PG8_MMA(1, 0, At, B0); PG8_BAR; PG8_SCHED;
            PG8_STAGE(PG8_SB(1, 1), b3 + hstep, voffB);
            PG8_WAIT_V(6); PG8_BAR; PG8_MMA(1, 1, At, B1); PG8_BAR;
            }
        }
        if constexpr (ALIGN_EPI) { if (wr == 0) PG8_BAR; }
        if constexpr (!Epi::AFTER_DRAIN) { E(acc, cur, wr, wc, fr, fq); S.done(cur); }
        if (!has_next) break;
#pragma unroll
        for (int a = 0; a < 2; ++a)
#pragma unroll
            for (int b = 0; b < 2; ++b)
#pragma unroll
                for (int m = 0; m < 4; ++m)
#pragma unroll
                    for (int n = 0; n < 2; ++n) acc[a][b][m][n] = (f32x4){0.f, 0.f, 0.f, 0.f};
        cur = nxt; cA = nA; cB = nB; ++ui;
        if constexpr (ALIGN_EPI) { if (wr == 1) PG8_BAR; }
    }
    PG8_WAIT_V(0);
    if constexpr (!ALIGN_EPI) { if (wr == 0) PG8_BAR; }
    PG8_BAR;
    if constexpr (Epi::AFTER_DRAIN) { E.fused(acc, cur, wr, wc, fr, fq, lds, wid, lane); S.done(cur); }
#undef PG8_SA
#undef PG8_SB
#undef PG8_STAGE
#undef PG8_LDA
#undef PG8_LDB
#undef PG8_MMA
#undef PG8_WAIT_V
#undef PG8_WAIT_L
#undef PG8_BAR
#undef PG8_SCHED
}
}
constexpr int NWAVES = 8;
constexpr int RING_OFF = 0, RING_BYTES = 153600;
constexpr int LDSCTL_OFF = RING_BYTES, MISC_OFF = LDSCTL_OFF + 320;
constexpr int LDS_BYTES = 154624;
constexpr int CW_TMO = 0, CW_CODE = 1, CW_BAR = 4096;
#define GAS __attribute__((address_space(1)))
#define LAS __attribute__((address_space(3)))
typedef unsigned v4u __attribute__((ext_vector_type(4)));
typedef unsigned v2u __attribute__((ext_vector_type(2)));
typedef float f32x4 __attribute__((ext_vector_type(4)));
typedef float f32x16 __attribute__((ext_vector_type(16)));
typedef short bf16x8 __attribute__((ext_vector_type(8)));
typedef short s16x4 __attribute__((ext_vector_type(4)));
typedef GAS unsigned gu32;
typedef GAS unsigned long long gu64;
#define RLX_AGENT __ATOMIC_RELAXED, __HIP_MEMORY_SCOPE_AGENT
#define LDS_WAIT() asm volatile("s_waitcnt lgkmcnt(0)" ::: "memory")
#define VM_WAIT() asm volatile("s_waitcnt vmcnt(0)" ::: "memory")
__device__ __forceinline__ void glds16(const void* gsrc, unsigned lds_dst) { unsigned keep; const unsigned dst = (unsigned)__builtin_amdgcn_readfirstlane((int)lds_dst);
    asm volatile("s_mov_b32 %0, m0\n\ts_mov_b32 m0, %2\n\ts_nop 0\n\tglobal_load_lds_dwordx4 %1, off\n\ts_mov_b32 m0, %0" : "=&s"(keep) : "v"(gsrc), "s"(dst) : "memory"); }
__device__ __forceinline__ void glds16s(const void* sbase, unsigned voff, unsigned lds_dst) { unsigned keep; const unsigned dst = (unsigned)__builtin_amdgcn_readfirstlane((int)lds_dst);
    const unsigned long long b = (unsigned long long)sbase; const unsigned blo = (unsigned)__builtin_amdgcn_readfirstlane((int)(unsigned)b), bhi = (unsigned)__builtin_amdgcn_readfirstlane((int)(unsigned)(b >> 32));
    const unsigned long long bs = ((unsigned long long)bhi << 32) | blo;
    asm volatile("s_mov_b32 %0, m0\n\ts_mov_b32 m0, %3\n\ts_nop 0\n\tglobal_load_lds_dwordx4 %1, %2\n\ts_mov_b32 m0, %0" : "=&s"(keep) : "v"(voff), "s"(bs), "s"(dst) : "memory"); }
#define XB_TMO      128
#define XB_XCNT(j)  (256  + 64 * (j))
#define XB_XSUB(j)  (1280 + 64 * (j))
#define XB_XGEN(j)  (2304 + 64 * (j))
#define XB_TOP      3328
#define XB_TOPGEN   3392
#define XCD_BAR_WORDS 3456
#define XB_SPIN_CAP (1u << 18)

__device__ __forceinline__ unsigned xb_ld(unsigned* p)              { return __hip_atomic_load(p, __ATOMIC_RELAXED, __HIP_MEMORY_SCOPE_AGENT); }
__device__ __forceinline__ unsigned xb_add(unsigned* p, unsigned v) { return __hip_atomic_fetch_add(p, v, __ATOMIC_RELAXED, __HIP_MEMORY_SCOPE_AGENT); }
__device__ __forceinline__ unsigned xb_xcc_id() { return (unsigned)__builtin_amdgcn_s_getreg((3 << 11) | 20) & 0xFu; }
#define XB_SPIN(cond, bar) do { unsigned _sp = 0; while (cond) { __builtin_amdgcn_s_sleep(1); \
    if ((++_sp & 255u) == 0u) { if (xb_ld(&(bar)[XB_TMO])) break; if (_sp > XB_SPIN_CAP) { atomicAdd(&(bar)[XB_TMO], 1u); break; } } } } while (0)

struct XcdBarrier {
    unsigned* bar; unsigned x;
    volatile LAS unsigned* st;
};

__device__ __forceinline__ XcdBarrier xcd_barrier_post(unsigned* bar, volatile LAS unsigned* st) {
    XcdBarrier b; b.bar = bar; b.x = xb_xcc_id(); b.st = st;
    if (threadIdx.x == 0) (void)xb_add(&bar[XB_XCNT(b.x)], 1u);
    return b;
}
__device__ __forceinline__ void xcd_barrier_complete(unsigned* bar, unsigned x, unsigned& nloc, unsigned& nx) {
    const unsigned G = gridDim.x * gridDim.y * gridDim.z;
    unsigned sum, cnt, mine, sp = 0u;
    for (;;) {
        sum = 0u; cnt = 0u; mine = 0u;
#pragma unroll
        for (unsigned j = 0; j < 16; ++j) { const unsigned c = xb_ld(&bar[XB_XCNT(j)]); sum += c; cnt += (c > 0u) ? 1u : 0u; mine = (j == x) ? c : mine; }
        if (sum == G) break;
        __builtin_amdgcn_s_sleep(1);
        if ((++sp & 255u) == 0u) { if (xb_ld(&bar[XB_TMO])) break; if (sp > XB_SPIN_CAP) { atomicAdd(&bar[XB_TMO], 1u); break; } }
    }
    nloc = mine > 0u ? mine : 1u; nx = cnt > 0u ? cnt : 1u;
}

__device__ __forceinline__ void xcd_barrier(const XcdBarrier& b) {
    asm volatile("s_waitcnt vmcnt(0)" ::: "memory");
    __syncthreads();
    if (threadIdx.x == 0) {
        unsigned* bar = b.bar;
        __builtin_amdgcn_s_waitcnt(0);
        unsigned nloc = b.st[0], nx = b.st[1];
        if (nloc == 0u) { xcd_barrier_complete(bar, b.x, nloc, nx); b.st[0] = nloc; b.st[1] = nx; }
        const unsigned old = xb_add(&bar[XB_XSUB(b.x)], 1u);
        const unsigned gen = old / nloc;
        if (old + 1u == (gen + 1u) * nloc) {
            __builtin_amdgcn_fence(__ATOMIC_RELEASE, "agent");
            asm volatile("s_waitcnt vmcnt(0)" ::: "memory");
            const unsigned og = xb_add(&bar[XB_TOP], 1u);
            const unsigned tg = og / nx;
            if (og + 1u == (tg + 1u) * nx) xb_add(&bar[XB_TOPGEN], 1u);
            else XB_SPIN(xb_ld(&bar[XB_TOPGEN]) == tg, bar);
            __builtin_amdgcn_fence(__ATOMIC_ACQUIRE, "agent");
            xb_add(&bar[XB_XGEN(b.x)], 1u);
            asm volatile("s_waitcnt vmcnt(0)" ::: "memory");
        } else {
            XB_SPIN(xb_ld(&bar[XB_XGEN(b.x)]) == gen, bar);
            __builtin_amdgcn_fence(__ATOMIC_ACQUIRE, "agent");
            asm volatile("s_waitcnt vmcnt(0)" ::: "memory");
        }
    }
    __syncthreads();
}

struct Args { const float* in[13]; float* out; unsigned char* ws; int ph_lo, ph_hi, li, dup_phase, dup_reps, dup_sub; };
struct Frame {
    LAS unsigned char* lds; volatile LAS unsigned* MISC; gu32* ctl;
    int tid, lane, wave, vcu, G;
};
__device__ __forceinline__ float wave_sum(float v) {
#pragma unroll
    for (int o = 1; o < 64; o <<= 1) v += __shfl_xor(v, o);
    return v;
}
__device__ __forceinline__ void p0_transpose_item(const float* W, int K, int N, bf16* WT, LAS float* scr, int item, int lane) {
    const int nblk = N / 32, kb = item / nblk, nb = item % nblk, k0 = 64 * kb, n0 = 32 * nb;
#pragma unroll 8
    for (int i = 0; i < 32; ++i) { const int kk = 2 * i + (lane >> 5); scr[kk * 33 + (lane & 31)] = __builtin_nontemporal_load(W + (size_t)(k0 + kk) * N + n0 + (lane & 31)); }
    LDS_WAIT(); asm volatile("" ::: "memory");
    const int c = lane & 7;
#pragma unroll
    for (int j = 0; j < 4; ++j) { const int n = (lane >> 3) + 8 * j; const LAS float* s = scr + (8 * c) * 33 + n;
        v4u o; o.x = pk2(s[0 * 33], s[1 * 33]); o.y = pk2(s[2 * 33], s[3 * 33]); o.z = pk2(s[4 * 33], s[5 * 33]); o.w = pk2(s[6 * 33], s[7 * 33]);
        *(GAS v4u*)(WT + (size_t)(n0 + n) * K + k0 + 8 * c) = o; }
    LDS_WAIT(); asm volatile("" ::: "memory");
}
__device__ __forceinline__ void p0_mod(Frame& F, const Args& a) {
    const float* c = a.in[1]; const float* w_cond = a.in[2]; const float* b_cond = a.in[3];
    float* mod = (float*)(a.ws + WS_MOD);
    if (F.vcu < 192) {
        LAS float* sc = (LAS float*)(F.lds);
        LAS float* red = (LAS float*)(F.lds + 32768);
        for (int i = F.tid; i < 4 * DM; i += NWAVES * 64) sc[i] = silu_f(c[i]);
        __syncthreads();
        const int cg = F.lane & 7, kr = F.lane >> 3, n0 = 32 * F.vcu + 4 * cg;
        f32x4 acc[4];
#pragma unroll
        for (int b = 0; b < 4; ++b) acc[b] = (f32x4){0.f, 0.f, 0.f, 0.f};
#pragma unroll 8
        for (int it = 0; it < 32; ++it) { const int k = 256 * F.wave + 8 * it + kr;
            const f32x4 w = __builtin_nontemporal_load((const GAS f32x4*)(w_cond + (size_t)k * (3 * DM) + n0));
#pragma unroll
            for (int b = 0; b < 4; ++b) acc[b] += w * sc[b * DM + k]; }
#pragma unroll
        for (int b = 0; b < 4; ++b)
#pragma unroll
            for (int e = 0; e < 4; ++e) { float v = acc[b][e]; v += __shfl_xor(v, 8); v += __shfl_xor(v, 16); v += __shfl_xor(v, 32); acc[b][e] = v; }
        if (kr == 0) {
#pragma unroll
            for (int b = 0; b < 4; ++b) *(LAS f32x4*)(red + (F.wave * 4 + b) * 32 + 4 * cg) = acc[b]; }
        __syncthreads();
        if (F.tid < 128) { const int b = F.tid >> 5, col = F.tid & 31; float s = b_cond[32 * F.vcu + col];
#pragma unroll
            for (int w = 0; w < 8; ++w) s += red[(w * 4 + b) * 32 + col];
            mod[b * 3 * DM + 32 * F.vcu + col] = s; }
        __syncthreads();
    }
}
__device__ __forceinline__ void p1_weights(Frame& F, const Args& a) {
    LAS float* scr = (LAS float*)(F.lds + RING_OFF + F.wave * 16384);
    const int gw = F.vcu * NWAVES + F.wave, NGW = F.G * NWAVES;
    bf16* wint = (bf16*)(a.ws + WS_WINT); bf16* woutt = (bf16*)(a.ws + WS_WOUTT);
    constexpr int I_IN = (DM / 64) * (NPROJ / 32), I_OUT = (DM / 64) * (DM / 32);
    for (int it = gw; it < I_IN + I_OUT; it += NGW) {
        if (it < I_IN) p0_transpose_item(a.in[4], DM, NPROJ, wint, scr, it, F.lane);
        else p0_transpose_item(a.in[11], DM, DM, woutt, scr, it - I_IN, F.lane);
    }
}
__device__ __forceinline__ void p1_h(Frame& F, const Args& a) {
    const float* x = a.in[0]; const float* mod = (const float*)(a.ws + WS_MOD); bf16* h = (bf16*)(a.ws + WS_H);
    const int gw = F.vcu * NWAVES + F.wave, NGW = F.G * NWAVES;
    for (int blk = gw; blk < T / 16; blk += NGW) {
        const int b = (blk * 16) / SEQ;
        const GAS f32x4* shp = (const GAS f32x4*)(mod + b * 3 * DM) + F.lane; const GAS f32x4* scp = (const GAS f32x4*)(mod + b * 3 * DM + DM) + F.lane;
        f32x4 sh[8], sc[8];
#pragma unroll
        for (int j = 0; j < 8; ++j) { sh[j] = shp[64 * j]; sc[j] = scp[64 * j] + 1.0f; }
        for (int r = 0; r < 16; ++r) { const int m = blk * 16 + r;
            const GAS f32x4* xr = (const GAS f32x4*)(x + (size_t)m * DM) + F.lane;
            f32x4 v[8]; float s = 0.f;
#pragma unroll
            for (int j = 0; j < 8; ++j) { v[j] = __builtin_nontemporal_load(xr + 64 * j); s += (v[j].x * v[j].x + v[j].y * v[j].y) + (v[j].z * v[j].z + v[j].w * v[j].w); }
            const float rs = rsqrtf(wave_sum(s) * (1.f / DM) + EPS);
            GAS unsigned long long* o8 = (GAS unsigned long long*)(h + (size_t)m * DM) + F.lane;
#pragma unroll
            for (int j = 0; j < 8; ++j) { const f32x4 o = v[j] * rs * sc[j] + sh[j];
                o8[64 * j] = (unsigned long long)pk2(o.x, o.y) | ((unsigned long long)pk2(o.z, o.w) << 32); } }
    }
}
__device__ __forceinline__ void lr_tail(Frame& F, const Args& a) {
    const bf16* h = (const bf16*)(a.ws + WS_H); const unsigned char* wl = a.ws + WS_WINT + (size_t)7168 * DM * 2; float* lr = (float*)(a.ws + WS_LR);
    constexpr int WROW = 4096 + 32;
    for (int i = F.tid; i < 32 * 256; i += NWAVES * 64) { const int r = i >> 8, c = i & 255; *(LAS v4u*)(F.lds + r * WROW + c * 16) = *(const GAS v4u*)(wl + (size_t)r * 4096 + c * 16); }
    __syncthreads();
    const int gw = F.vcu * NWAVES + F.wave, NGW = F.G * NWAVES, li = F.lane & 15, g = F.lane >> 4;
    const LAS unsigned char* bp0 = F.lds + li * WROW + g * 16; const LAS unsigned char* bp1 = bp0 + 16 * WROW;
    for (int rb = gw; rb < T / 16; rb += NGW) {
        const bf16* ap = h + (size_t)(rb * 16 + li) * DM + 8 * g;
        f32x4 c0 = (f32x4){0.f, 0.f, 0.f, 0.f}, c1 = c0;
        bf16x8 avA[16], avB[16];
#define LRLOAD(D, kb) do { _Pragma("unroll") for (int i_ = 0; i_ < 16; ++i_) D[i_] = __builtin_nontemporal_load((const GAS bf16x8*)(ap + 32 * (16 * (kb) + i_))); } while (0)
#define LRMMA(D, kb) do { _Pragma("unroll") for (int i_ = 0; i_ < 16; ++i_) { const bf16x8 b0_ = *(const LAS bf16x8*)(bp0 + 64 * (16 * (kb) + i_)), b1_ = *(const LAS bf16x8*)(bp1 + 64 * (16 * (kb) + i_)); \
            c0 = __builtin_amdgcn_mfma_f32_16x16x32_bf16(D[i_], b0_, c0, 0, 0, 0); c1 = __builtin_amdgcn_mfma_f32_16x16x32_bf16(D[i_], b1_, c1, 0, 0, 0); } } while (0)
        LRLOAD(avA, 0); __builtin_amdgcn_sched_barrier(0); LRLOAD(avB, 1); __builtin_amdgcn_sched_barrier(0); LRMMA(avA, 0); __builtin_amdgcn_sched_barrier(0);
        LRLOAD(avA, 2); __builtin_amdgcn_sched_barrier(0); LRMMA(avB, 1); __builtin_amdgcn_sched_barrier(0); LRLOAD(avB, 3); __builtin_amdgcn_sched_barrier(0);
        LRMMA(avA, 2); __builtin_amdgcn_sched_barrier(0); LRMMA(avB, 3); __builtin_amdgcn_sched_barrier(0);
#undef LRLOAD
#undef LRMMA
#pragma unroll
        for (int rg = 0; rg < 4; ++rg) { float* o = lr + (size_t)(rb * 16 + 4 * g + rg) * 32 + li; o[0] = c0[rg]; o[16] = c1[rg]; }
    }
    __syncthreads();
}
__device__ __forceinline__ void unpack8(const v4u w, float (&f)[8]) {
    f[0] = __builtin_bit_cast(float, w.x << 16); f[1] = __builtin_bit_cast(float, w.x & 0xffff0000u); f[2] = __builtin_bit_cast(float, w.y << 16); f[3] = __builtin_bit_cast(float, w.y & 0xffff0000u);
    f[4] = __builtin_bit_cast(float, w.z << 16); f[5] = __builtin_bit_cast(float, w.z & 0xffff0000u); f[6] = __builtin_bit_cast(float, w.w << 16); f[7] = __builtin_bit_cast(float, w.w & 0xffff0000u);
}
__device__ __forceinline__ v4u pack8(const float (&f)[8]) { v4u w; w.x = pk2(f[0], f[1]); w.y = pk2(f[2], f[3]); w.z = pk2(f[4], f[5]); w.w = pk2(f[6], f[7]); return w; }
__device__ __forceinline__ void p5_combine(Frame& F, const Args& a) {
    const bf16* op = (const bf16*)(a.ws + WS_OP); const float* lse = (const float*)(a.ws + WS_LSE); const bf16* sag = (const bf16*)(a.ws + WS_SAG);
    const bf16* of = (const bf16*)(a.ws + WS_OF); const bf16* ob = (const bf16*)(a.ws + WS_OB); const bf16* sgg = (const bf16*)(a.ws + WS_SGG); const float* gain = a.in[9];
    bf16* cat = (bf16*)(a.ws + WS_H);
    const int gw = F.vcu * NWAVES + F.wave, NGW = F.G * NWAVES, lane = F.lane;
    float gn[16];
#pragma unroll
    for (int j = 0; j < 4; ++j) { const f32x4 g = *(const GAS f32x4*)(gain + 16 * lane + 4 * j); gn[4 * j] = g.x; gn[4 * j + 1] = g.y; gn[4 * j + 2] = g.z; gn[4 * j + 3] = g.w; }
    for (int t = gw; t < T; t += NGW) {
        const size_t e = (size_t)t * 1024 + 16 * lane; const int hh = lane >> 2;
        const float l0 = __builtin_nontemporal_load(lse + (size_t)t * 16 + hh), l1 = __builtin_nontemporal_load(lse + (size_t)T * 16 + (size_t)t * 16 + hh), l2 = __builtin_nontemporal_load(lse + (size_t)2 * T * 16 + (size_t)t * 16 + hh);
        const float mx = fmaxf(l0, fmaxf(l1, l2)); float w0 = exp2f(l0 - mx), w1 = exp2f(l1 - mx), w2 = exp2f(l2 - mx); const float wi = 1.f / (w0 + w1 + w2); w0 *= wi; w1 *= wi; w2 *= wi;
#pragma unroll
        for (int hf = 0; hf < 2; ++hf) { float p0[8], p1[8], p2[8], g[8], o[8];
            unpack8(__builtin_nontemporal_load((const GAS v4u*)(op + e + 8 * hf)), p0); unpack8(__builtin_nontemporal_load((const GAS v4u*)(op + (size_t)T * 1024 + e + 8 * hf)), p1); unpack8(__builtin_nontemporal_load((const GAS v4u*)(op + (size_t)2 * T * 1024 + e + 8 * hf)), p2);
            unpack8(__builtin_nontemporal_load((const GAS v4u*)(sag + e + 8 * hf)), g);
#pragma unroll
            for (int i = 0; i < 8; ++i) o[i] = (w0 * p0[i] + w1 * p1[i] + w2 * p2[i]) * g[i];
            *(GAS v4u*)(cat + (size_t)t * 2048 + 16 * lane + 8 * hf) = pack8(o); }
        float xv[16], ss = 0.f;
#pragma unroll
        for (int hf = 0; hf < 2; ++hf) { float f[8], b[8]; unpack8(__builtin_nontemporal_load((const GAS v4u*)(of + e + 8 * hf)), f); unpack8(__builtin_nontemporal_load((const GAS v4u*)(ob + e + 8 * hf)), b);
#pragma unroll
            for (int i = 0; i < 8; ++i) { xv[8 * hf + i] = f[i] + b[i]; ss += xv[8 * hf + i] * xv[8 * hf + i]; } }
        ss += __shfl_xor(ss, 1); ss += __shfl_xor(ss, 2); ss += __shfl_xor(ss, 4); ss += __shfl_xor(ss, 8);
        const float r = rsqrtf(ss * (1.f / 256.f) + EPS);
#pragma unroll
        for (int hf = 0; hf < 2; ++hf) { float g[8], o[8]; unpack8(__builtin_nontemporal_load((const GAS v4u*)(sgg + e + 8 * hf)), g);
#pragma unroll
            for (int i = 0; i < 8; ++i) o[i] = xv[8 * hf + i] * r * gn[8 * hf + i] * g[i];
            *(GAS v4u*)(cat + (size_t)t * 2048 + 1024 + 16 * lane + 8 * hf) = pack8(o); }
    }
}
__device__ __forceinline__ void p7_final(Frame& F, const Args& a) {
    float* out = a.out; const float* x = a.in[0]; const float* fg = a.in[12]; const float* mod = (const float*)(a.ws + WS_MOD); const bf16* Y = (const bf16*)(a.ws + WS_Y);
    const int gw = F.vcu * NWAVES + F.wave, NGW = F.G * NWAVES;
    f32x4 g[8];
#pragma unroll
    for (int j = 0; j < 8; ++j) g[j] = *((const GAS f32x4*)fg + F.lane + 64 * j);
    for (int blk = gw; blk < T / 16; blk += NGW) {
        const int b = (blk * 16) / SEQ;
        f32x4 gt[8];
#pragma unroll
        for (int j = 0; j < 8; ++j) gt[j] = *((const GAS f32x4*)(mod + b * 3 * DM + 2 * DM) + F.lane + 64 * j);
        for (int r = 0; r < 16; ++r) { const int m = blk * 16 + r;
            const GAS f32x4* xr = (const GAS f32x4*)(x + (size_t)m * DM) + F.lane; const GAS v2u* yr = (const GAS v2u*)(Y + (size_t)m * DM) + F.lane;
            f32x4 v[8]; float s = 0.f;
#pragma unroll
            for (int j = 0; j < 8; ++j) { const f32x4 xv = __builtin_nontemporal_load(xr + 64 * j); const v2u yw = __builtin_nontemporal_load(yr + 64 * j);
                const f32x4 yv = (f32x4){__builtin_bit_cast(float, yw.x << 16), __builtin_bit_cast(float, yw.x & 0xffff0000u), __builtin_bit_cast(float, yw.y << 16), __builtin_bit_cast(float, yw.y & 0xffff0000u)};
                v[j] = xv + gt[j] * yv; s += (v[j].x * v[j].x + v[j].y * v[j].y) + (v[j].z * v[j].z + v[j].w * v[j].w); }
            const float rs = rsqrtf(wave_sum(s) * (1.f / DM) + EPS);
            GAS f32x4* orow = (GAS f32x4*)(out + (size_t)m * DM) + F.lane;
#pragma unroll
            for (int j = 0; j < 8; ++j) orow[64 * j] = v[j] * rs * g[j]; }
    }
}

namespace att {
constexpr int KCH = 384 * 16, VDH = 384 * 64, K_OFF = 0, V_OFF = 8 * KCH, VBUF = 2 * VDH, BIAS_OFF = V_OFF + 2 * VBUF, BCOPY = 832, RB_OFF = BIAS_OFF + 4 * BCOPY, ATT_LDS = RB_OFF + 2048;
static_assert(ATT_LDS <= RING_BYTES && (V_OFF % 1024) == 0 && (BIAS_OFF % 16) == 0, "attention LDS map");
constexpr int NUNITS = BATCH * 16 * 3 * 32;
__device__ __forceinline__ int crow(int r, int hi) { return (r & 3) + 8 * (r >> 2) + 4 * hi; }
typedef short v4i16_t __attribute__((ext_vector_type(4)));
__device__ __forceinline__ s16x4 vtr(const LAS unsigned char* p) { return __builtin_bit_cast(s16x4, __builtin_amdgcn_ds_read_tr16_b64_v4i16((LAS v4i16_t*)p)); }
__device__ __forceinline__ unsigned cvtpk(float lo, float hi) { typedef float f2 __attribute__((ext_vector_type(2))); typedef __bf16 b2 __attribute__((ext_vector_type(2))); f2 v = {lo, hi}; b2 b = __builtin_convertvector(v, b2); return __builtin_bit_cast(unsigned, b); }
#define ATT_BAR() asm volatile("s_waitcnt lgkmcnt(0)\n\ts_barrier" ::: "memory")

struct UnitGeo { int b, h, p, d, r, L, m0; unsigned rowb; size_t base; };
__device__ __forceinline__ UnitGeo decode(int uid) {
    UnitGeo u; const int bh = uid / 96, w96 = uid % 96, rs = w96 & 31; u.p = w96 >> 5; u.b = bh >> 4; u.h = bh & 15;
    u.d = (u.p == 0) ? 1 : (u.p == 1 ? 4 : 16);
    u.r = (u.p == 0) ? 0 : (u.p == 1 ? (rs >> 3) : (rs >> 1)); const int seg = (u.p == 0) ? rs : (u.p == 1 ? (rs & 7) : (rs & 1));
    u.L = SEQ / u.d; u.m0 = seg * 256; u.rowb = (unsigned)u.d * 2048u; u.base = ((size_t)u.b * SEQ + u.r) * 2048 + u.h * 128; return u;
}
__device__ __forceinline__ void dma_k(const Args& a, const UnitGeo& u, LAS unsigned char* lds, int wid, int lane) {
    const unsigned char* Kb = a.ws + WS_AK + u.base + (lane >> 3) * 16; const unsigned rowb = u.rowb;
#pragma unroll
    for (int j = 0; j < 6; ++j) { const int blk = wid + 8 * j; int m = u.m0 - 64 + 8 * blk + (lane & 7); m = m < 0 ? 0 : (m > u.L - 1 ? u.L - 1 : m);
        glds16(Kb + (size_t)m * rowb, (unsigned)(size_t)lds + K_OFF + blk * 1024); }
}
__device__ __forceinline__ void dma_v(const Args& a, const UnitGeo& u, LAS unsigned char* lds, int vbuf, int wid, int lane) {
    const unsigned char* Vb = a.ws + WS_AV + u.base + (lane >> 5) * 64 + (lane & 3) * 16; const unsigned rowb = u.rowb;
#pragma unroll
    for (int j = 0; j < 6; ++j) { const int blk = wid + 8 * j; int m = u.m0 - 64 + 8 * blk + ((lane >> 2) & 7); m = m < 0 ? 0 : (m > u.L - 1 ? u.L - 1 : m);
        glds16(Vb + (size_t)m * rowb, (unsigned)(size_t)lds + V_OFF + vbuf * VBUF + blk * 1024); }
}
__device__ __forceinline__ void load_q(bf16x8 (&q)[4], const Args& a, const UnitGeo& u, int wid, int r32, int hi) {
    const unsigned char* Qb = a.ws + WS_AQ + u.base + (size_t)(u.m0 + 32 * wid + r32) * u.rowb + hi * 16;
    asm volatile("global_load_dwordx4 %0, %1, off" : "=&v"(q[0]) : "v"(Qb) : "memory");
    asm volatile("global_load_dwordx4 %0, %1, off offset:32" : "=&v"(q[1]) : "v"(Qb) : "memory");
    asm volatile("global_load_dwordx4 %0, %1, off offset:64" : "=&v"(q[2]) : "v"(Qb) : "memory");
    asm volatile("global_load_dwordx4 %0, %1, off offset:96" : "=&v"(q[3]) : "v"(Qb) : "memory");
}
__device__ __forceinline__ void write_bias(const Args& a, const UnitGeo& u, LAS unsigned char* lds, int tid) {
    for (int e = tid; e < 4 * 192; e += 512) { const int s = e / 192, i = e % 192, sp = i + s - 95;
        *(LAS float*)(lds + BIAS_OFF + s * BCOPY + i * 4) = (sp >= -64 && sp <= 64) ? ((const LAS float*)(lds + RB_OFF))[t5_bucket(sp * u.d) * 16 + u.h] : -1e30f; }
}
#define DECODE(x) decode(unit_of(x))
__device__ __forceinline__ UnitGeo decode_p(int uid, bool contig) { UnitGeo u = decode(uid); if (contig) { u.rowb = 128u; u.base = (size_t)(uid / 96) * SEQ * 128 + (size_t)((uid % 96) >> 5) * 16 * 2048; } return u; }
__device__ __forceinline__ void attn_phase(Frame& F, const Args& a, int c, int ncu, const int knobs = 0) {
    const bool nodma = knobs & 1, nomath = knobs & 2, nostore = knobs & 4, noq = knobs & 16;
    if (c < 0 || c >= ncu) return;
    const bool coop = (ncu == 192);
    const int per = coop ? 32 : (NUNITS + ncu - 1) / ncu, u0 = coop ? 0 : c * per, u1 = coop ? 32 : ((u0 + per < NUNITS) ? u0 + per : NUNITS);
    if (u0 >= u1) return;
    const int cx = c / 24, cj = c % 24;
    auto unit_of = [&](int i) -> int { return coop ? ((8 * cx + (i >> 2)) * 96 + cj + 24 * (i & 3)) : i; };
    LAS unsigned char* lds = F.lds;
    const int tid = F.tid, lane = F.lane, wid = F.wave, r32 = lane & 31, hi = lane >> 5;
    UnitGeo cur = DECODE(u0);
    __builtin_amdgcn_s_waitcnt(0);
    asm volatile("s_waitcnt vmcnt(0) lgkmcnt(0)\n\ts_barrier" ::: "memory");
    ((LAS float*)(lds + RB_OFF))[tid] = a.in[10][tid] * LOG2E;
    asm volatile("s_waitcnt vmcnt(0) lgkmcnt(0)\n\ts_barrier" ::: "memory");
    dma_k(a, cur, lds, wid, lane); dma_v(a, cur, lds, 0, wid, lane); write_bias(a, cur, lds, tid);
    bf16x8 qr[4]; load_q(qr, a, cur, wid, r32, hi);
    int vb = 0;
    float* pl = nullptr; float plv = 0.f; GAS unsigned char* po = nullptr; size_t postep = 0; v4u pov[4] = {};
    const int e31 = 31 - r32;
    const LAS unsigned char* bias_b = lds + BIAS_OFF + (e31 & 3) * BCOPY + ((e31 >> 2) + hi) * 16;
    const LAS unsigned char* kb0 = lds + K_OFF + (4 * wid + (r32 >> 3)) * 1024 + hi * 128 + (r32 & 7) * 16;
    for (int uid = u0; uid < u1; ++uid) {
        asm volatile("s_waitcnt vmcnt(0) lgkmcnt(0)\n\ts_barrier" : "+v"(qr[0]), "+v"(qr[1]), "+v"(qr[2]), "+v"(qr[3]) :: "memory");
        if (uid != u0 && !nostore) {
            if (hi == 0) *pl = plv;
#pragma unroll
            for (int i = 0; i < 4; ++i) *(GAS v4u*)(po + i * postep) = pov[i]; }
        const bool has_next = uid + 1 < u1; UnitGeo nxt = cur;
        if (has_next) { nxt = DECODE(uid + 1); if (!nodma) dma_v(a, nxt, lds, vb ^ 1, wid, lane); }
        const int b = cur.b, h = cur.h, d = cur.d, r = cur.r, L = cur.L, m0 = cur.m0;
        {
        f32x16 pS[5];
#define SB() __builtin_amdgcn_sched_barrier(0)
#define LOADKB(KF, kb) do { _Pragma("unroll") for (int k_ = 0; k_ < 4; ++k_) { const f32x4 t_ = *(const LAS f32x4*)(bias_b + 32 * k_ + 128 * (kb)); pS[kb][4 * k_] = t_.x; pS[kb][4 * k_ + 1] = t_.y; pS[kb][4 * k_ + 2] = t_.z; pS[kb][4 * k_ + 3] = t_.w; } \
                            _Pragma("unroll") for (int d_ = 0; d_ < 4; ++d_) KF[d_] = *(const LAS bf16x8*)(kb0 + d_ * 256 + (kb) * 4096); } while (0)
#define MMAKB(KF, kb) do { _Pragma("unroll") for (int d_ = 0; d_ < 4; ++d_) pS[kb] = __builtin_amdgcn_mfma_f32_32x32x16_bf16(KF[d_], qr[d_], pS[kb], 0, 0, 0); } while (0)
        { bf16x8 ka[4], kc[4];
          LOADKB(ka, 0); SB(); LOADKB(kc, 1); SB(); MMAKB(ka, 0); SB(); LOADKB(ka, 2); SB(); MMAKB(kc, 1); SB(); LOADKB(kc, 3); SB(); MMAKB(ka, 2); SB(); LOADKB(ka, 4); SB(); MMAKB(kc, 3); SB(); MMAKB(ka, 4); SB(); }
#undef LOADKB
#undef MMAKB
        {
        ATT_BAR();
        if (has_next) { if (!nodma) dma_k(a, nxt, lds, wid, lane); if (nxt.p != cur.p || nxt.h != cur.h) write_bias(a, nxt, lds, tid); if (!noq) load_q(qr, a, nxt, wid, r32, hi); }
        }
        const int mb = m0 - 64 + 32 * wid;
        if (mb < 0 || mb + 160 > L) {
            const int mbl = mb + 4 * hi;
#pragma unroll
            for (int kb = 0; kb < 5; ++kb)
#pragma unroll
                for (int rg = 0; rg < 16; ++rg) { const int kr0 = 32 * kb + crow(rg, 0); pS[kb][rg] = ((unsigned)(mbl + kr0) < (unsigned)L) ? pS[kb][rg] : -1e30f; }
        }
        float mx = -1e30f;
#pragma unroll
        for (int kb = 0; kb < 5; ++kb)
#pragma unroll
            for (int rg = 0; rg < 16; rg += 2) mx = fmaxf(fmaxf(mx, pS[kb][rg]), pS[kb][rg + 1]);
        mx = fmaxf(mx, __shfl_xor(mx, 32));
        float l = 0.f;
#pragma unroll
        for (int kb = 0; kb < 5; ++kb)
#pragma unroll
            for (int rg = 0; rg < 16; ++rg) { const float e = __builtin_amdgcn_exp2f(pS[kb][rg] - mx); pS[kb][rg] = e; l += e; }
        l += __shfl_xor(l, 32);
        f32x16 o[2];
        o[0] = (f32x16){0.f, 0.f, 0.f, 0.f, 0.f, 0.f, 0.f, 0.f, 0.f, 0.f, 0.f, 0.f, 0.f, 0.f, 0.f, 0.f}; o[1] = o[0];
        const LAS unsigned char* vb0 = lds + V_OFF + vb * VBUF + (4 * wid) * 1024 + (4 * hi + ((lane & 15) >> 2)) * 64 + ((lane >> 4) & 1) * 32 + (lane & 3) * 8;
#define LOADV(VF, kb) do { _Pragma("unroll") for (int s_ = 0; s_ < 2; ++s_) _Pragma("unroll") for (int d_ = 0; d_ < 2; ++d_) { \
            const s16x4 lo_ = vtr(vb0 + d_ * 512 + (2 * (kb) + s_) * 2048), hh_ = vtr(vb0 + d_ * 512 + (2 * (kb) + s_) * 2048 + 1024); \
            VF[s_ * 2 + d_] = (bf16x8){lo_[0], lo_[1], lo_[2], lo_[3], hh_[0], hh_[1], hh_[2], hh_[3]}; } } while (0)
#define MMAV(VF, kb) do { _Pragma("unroll") for (int s_ = 0; s_ < 2; ++s_) { v4u pw_; pw_.x = cvtpk(pS[kb][8 * s_ + 0], pS[kb][8 * s_ + 1]); pw_.y = cvtpk(pS[kb][8 * s_ + 2], pS[kb][8 * s_ + 3]); \
            pw_.z = cvtpk(pS[kb][8 * s_ + 4], pS[kb][8 * s_ + 5]); pw_.w = cvtpk(pS[kb][8 * s_ + 6], pS[kb][8 * s_ + 7]); const bf16x8 pa_ = __builtin_bit_cast(bf16x8, pw_); \
            _Pragma("unroll") for (int d_ = 0; d_ < 2; ++d_) o[d_] = __builtin_amdgcn_mfma_f32_32x32x16_bf16(VF[s_ * 2 + d_], pa_, o[d_], 0, 0, 0); } } while (0)
        { bf16x8 va[4], vc[4];
          LOADV(va, 0); SB(); LOADV(vc, 1); SB(); MMAV(va, 0); SB(); LOADV(va, 2); SB(); MMAV(vc, 1); SB(); LOADV(vc, 3); SB(); MMAV(va, 2); SB(); LOADV(va, 4); SB(); MMAV(vc, 3); SB(); MMAV(va, 4); SB(); }
#undef LOADV
#undef MMAV
#undef SB
        const float li = 1.f / l;
        const size_t tq = (size_t)b * SEQ + (size_t)(m0 + 32 * wid + r32) * d + r;
        {
        pl = (float*)(a.ws + WS_LSE) + (size_t)cur.p * T * 16 + tq * 16 + h; plv = mx + __builtin_amdgcn_logf(l);
        ATT_BAR();
        LAS unsigned char* stg = lds + V_OFF + vb * VBUF + wid * (32 * 144);
#pragma unroll
        for (int d0 = 0; d0 < 2; ++d0)
#pragma unroll
            for (int k = 0; k < 4; ++k)
                *(LAS v2u*)(stg + r32 * 144 + (32 * d0 + 8 * k + 4 * hi) * 2) = (v2u){cvtpk(o[d0][4 * k] * li, o[d0][4 * k + 1] * li), cvtpk(o[d0][4 * k + 2] * li, o[d0][4 * k + 3] * li)};
        LDS_WAIT();
        { const int row = lane >> 3, ch = lane & 7;
          po = (GAS unsigned char*)(a.ws + WS_OP) + ((size_t)cur.p * T + (size_t)b * SEQ + (size_t)(m0 + 32 * wid + row) * d + r) * 2048 + h * 128 + ch * 16; postep = (size_t)8 * d * 2048;
#pragma unroll
          for (int i = 0; i < 4; ++i) pov[i] = *(const LAS v4u*)(stg + (row + 8 * i) * 144 + ch * 16); }
        LDS_WAIT();
        }
        }
        vb ^= 1; cur = nxt;
    }
    { if (hi == 0) *pl = plv;
#pragma unroll
        for (int i = 0; i < 4; ++i) *(GAS v4u*)(po + i * postep) = pov[i]; }
    asm volatile("s_waitcnt vmcnt(0) lgkmcnt(0)\n\ts_barrier" ::: "memory");
}
#undef ATT_BAR
}
namespace gla {
constexpr int PACK_QK = 32768, PACK_ATT = 9216;
constexpr float DKS = 0.08838834764831845f;
__device__ __forceinline__ unsigned cvtpk(float lo, float hi) { typedef float f2 __attribute__((ext_vector_type(2))); typedef __bf16 b2 __attribute__((ext_vector_type(2))); f2 v = {lo, hi}; b2 b = __builtin_convertvector(v, b2); return __builtin_bit_cast(unsigned, b); }
__device__ __forceinline__ int idx32(int g, int jj) { return 16 * (jj >> 2) + 4 * g + (jj & 3); }
__device__ __forceinline__ float fexp(float x) { return __builtin_amdgcn_exp2f(x * LOG2E); }
__device__ __forceinline__ float logsig16(float x) { return (fminf(x, 0.f) - __builtin_amdgcn_logf(1.f + fexp(-fabsf(x))) * 0.6931471805599453f) * (1.f / 16.f); }
typedef short v4i16_t __attribute__((ext_vector_type(4)));
__device__ __forceinline__ s16x4 vtr(const LAS unsigned char* p) { return __builtin_bit_cast(s16x4, __builtin_amdgcn_ds_read_tr16_b64_v4i16((LAS v4i16_t*)p)); }
constexpr int ROWB = 272  , GROW = 136  ;
constexpr int LRROW = 36  ;
constexpr int L_QT = 0, L_KT = 64 * ROWB, L_LR = 2 * 64 * ROWB, L_G = L_LR + 64 * LRROW * 4, L_GT = L_G + 2 * 64 * GROW * 4, L_TOT = L_GT + 4096, L_KBM = L_TOT + 1024  , L_PREP_END = L_KBM + 32768;
static_assert(L_PREP_END <= RING_BYTES, "prep LDS map");

__device__ __forceinline__ void prep_unit(Frame& F, const Args& a, int uid, const int knobs = 0) {
    const int b = uid >> 9, h = (uid >> 7) & 3, n = uid & 127; const size_t t0 = (size_t)b * SEQ + 64 * n;
    const bf16* gq = (const bf16*)(a.ws + WS_GQ); const bf16* gk = (const bf16*)(a.ws + WS_GK); const float* lr = (const float*)(a.ws + WS_LR);
    LAS unsigned char* lds = F.lds; const int tid = F.tid, lane = F.lane, wid = F.wave;
    float upb[2][4], bsv[2];
#pragma unroll
    for (int dir = 0; dir < 2; ++dir) { const float* up = a.in[dir ? 7 : 5] + h * 128 + 16 * wid + (lane & 15); bsv[dir] = a.in[dir ? 8 : 6][h * 128 + 16 * wid + (lane & 15)];
#pragma unroll
        for (int ks = 0; ks < 4; ++ks) upb[dir][ks] = up[(4 * ks + (lane >> 4)) * 512]; }
#pragma unroll
    for (int i = 0; i < 2; ++i) { const int pid = tid + 512 * i, row = pid >> 4, c16 = pid & 15; const size_t off = (t0 + row) * 512 + h * 128 + c16 * 8;
        *(LAS v4u*)(lds + L_QT + row * ROWB + c16 * 16) = __builtin_nontemporal_load((const GAS v4u*)(gq + off)); *(LAS v4u*)(lds + L_KT + row * ROWB + c16 * 16) = __builtin_nontemporal_load((const GAS v4u*)(gk + off)); }
    { const int row = tid >> 3, c16 = tid & 7; *(LAS v4u*)(lds + L_LR + row * (LRROW * 4) + c16 * 16) = __builtin_nontemporal_load((const GAS v4u*)(lr + (t0 + row) * 32 + c16 * 4)); }
    __syncthreads();
    LAS float* G = (LAS float*)(lds + L_G); LAS float* TOT = (LAS float*)(lds + L_TOT); const LAS float* LR = (const LAS float*)(lds + L_LR);
    if (!(knobs & 1)) { const int li2 = lane & 15, g2 = lane >> 4, c = 16 * wid + li2;
#pragma unroll
      for (int dir = 0; dir < 2; ++dir) { f32x4 gl[4];
#pragma unroll
          for (int mt = 0; mt < 4; ++mt) { f32x4 acc = (f32x4){0.f, 0.f, 0.f, 0.f};
#pragma unroll
              for (int ks = 0; ks < 4; ++ks) acc = __builtin_amdgcn_mfma_f32_16x16x4f32(LR[(16 * mt + li2) * LRROW + dir * 16 + 4 * ks + g2], upb[dir][ks], acc, 0, 0, 0);
#pragma unroll
              for (int rg = 0; rg < 4; ++rg) gl[mt][rg] = logsig16(acc[rg] + bsv[dir]); }
          float off = 0.f;
#pragma unroll
          for (int m2 = 0; m2 < 4; ++m2) { const int mt = dir ? 3 - m2 : m2; f32x4 p; float t;
              if (!dir) { p[0] = gl[mt][0]; p[1] = p[0] + gl[mt][1]; p[2] = p[1] + gl[mt][2]; p[3] = p[2] + gl[mt][3]; t = p[3]; }
              else      { p[3] = gl[mt][3]; p[2] = p[3] + gl[mt][2]; p[1] = p[2] + gl[mt][1]; p[0] = p[1] + gl[mt][0]; t = p[0]; }
              float sc = t, u;
              if (!dir) { u = __shfl_up(sc, 16); if (g2 >= 1) sc += u; u = __shfl_up(sc, 32); if (g2 >= 2) sc += u; }
              else      { u = __shfl_down(sc, 16); if (g2 <= 2) sc += u; u = __shfl_down(sc, 32); if (g2 <= 1) sc += u; }
              const float add = sc - t + off;
#pragma unroll
              for (int rg = 0; rg < 4; ++rg) G[(dir * 64 + 16 * mt + 4 * g2 + rg) * GROW + c] = p[rg] + add;
              off += __shfl(sc, (dir ? 0 : 48) + li2); }
          if (g2 == 0) TOT[dir * 128 + c] = off; } }
    __syncthreads();
    if (knobs & 2) { __syncthreads(); return; }
    const int dir = wid >> 2, it = wid & 3, li = lane & 15, g = lane >> 4;
    const int cid = ((b * 4 + h) * 2 + dir) * 128 + n;
    unsigned char* qk_pack = a.ws + WS_H + (size_t)cid * PACK_QK; unsigned char* att_pack = a.ws + WS_ATT + (size_t)cid * PACK_ATT;
    const LAS float* Gd = G + dir * 64 * GROW;
    auto frag = [&](int tile_off, int row, int ks, float sgn, float mul) -> bf16x8 {
        float v[8];
#pragma unroll
        for (int hf = 0; hf < 2; ++hf) { const int c = 32 * ks + 16 * hf + 4 * g;
            const v2u xw = *(const LAS v2u*)(lds + tile_off + row * ROWB + c * 2); const f32x4 bb = *(const LAS f32x4*)(Gd + row * GROW + c);
            v[4 * hf + 0] = __builtin_bit_cast(float, xw.x << 16) * fexp(sgn * bb.x) * mul; v[4 * hf + 1] = __builtin_bit_cast(float, xw.x & 0xffff0000u) * fexp(sgn * bb.y) * mul;
            v[4 * hf + 2] = __builtin_bit_cast(float, xw.y << 16) * fexp(sgn * bb.z) * mul; v[4 * hf + 3] = __builtin_bit_cast(float, xw.y & 0xffff0000u) * fexp(sgn * bb.w) * mul; }
        v4u w; w.x = cvtpk(v[0], v[1]); w.y = cvtpk(v[2], v[3]); w.z = cvtpk(v[4], v[5]); w.w = cvtpk(v[6], v[7]); return __builtin_bit_cast(bf16x8, w); };
    bf16x8 qf[4];
#pragma unroll
    for (int ks = 0; ks < 4; ++ks) { qf[ks] = frag(L_QT, 16 * it + li, ks, 1.f, DKS); *(GAS v4u*)(qk_pack + ((it * 4 + ks) * 64 + lane) * 16) = __builtin_bit_cast(v4u, qf[ks]); }
#pragma unroll
    for (int ks = 0; ks < 4; ++ks) *(LAS v4u*)(lds + L_KBM + (((dir * 4 + it) * 4 + ks) * 64 + lane) * 16) = __builtin_bit_cast(v4u, frag(L_KT, 16 * it + li, ks, -1.f, 1.f));
    __syncthreads();
    f32x4 at[4];
#pragma unroll
    for (int jt = 0; jt < 4; ++jt) { at[jt] = (f32x4){0.f, 0.f, 0.f, 0.f};
#pragma unroll
        for (int ks = 0; ks < 4; ++ks) { const bf16x8 kf = *(const LAS bf16x8*)(lds + L_KBM + (((dir * 4 + jt) * 4 + ks) * 64 + lane) * 16); at[jt] = __builtin_amdgcn_mfma_f32_16x16x32_bf16(kf, qf[ks], at[jt], 0, 0, 0); }
#pragma unroll
        for (int rg = 0; rg < 4; ++rg) { const int j = 16 * jt + 4 * g + rg, i = 16 * it + li; const bool keep = dir ? (j >= i) : (j <= i); at[jt][rg] = keep ? at[jt][rg] : 0.f; } }
#pragma unroll
    for (int ks2 = 0; ks2 < 2; ++ks2) { v4u w; w.x = cvtpk(at[2 * ks2][0], at[2 * ks2][1]); w.y = cvtpk(at[2 * ks2][2], at[2 * ks2][3]); w.z = cvtpk(at[2 * ks2 + 1][0], at[2 * ks2 + 1][1]); w.w = cvtpk(at[2 * ks2 + 1][2], at[2 * ks2 + 1][3]);
        *(GAS v4u*)(att_pack + ((it * 2 + ks2) * 64 + lane) * 16) = w; }
#pragma unroll
    for (int q2 = 0; q2 < 4; ++q2) { const int ct = 2 * it + (q2 >> 1), ks2 = q2 & 1, c = 16 * ct + li; const float te = TOT[dir * 128 + c]; float v[8];
#pragma unroll
        for (int jj = 0; jj < 8; ++jj) { const int j = 32 * ks2 + idx32(g, jj); const float kx = bf2f(*(const LAS bf16*)(lds + L_KT + j * ROWB + c * 2)); v[jj] = kx * fexp(te - Gd[j * GROW + c]); }
        v4u w; w.x = cvtpk(v[0], v[1]); w.y = cvtpk(v[2], v[3]); w.z = cvtpk(v[4], v[5]); w.w = cvtpk(v[6], v[7]);
        *(GAS v4u*)(qk_pack + 16384 + ((ct * 2 + ks2) * 64 + lane) * 16) = w; }
    if (tid < 256) { const int d2 = tid >> 7, c = tid & 127; *(float*)(a.ws + WS_ATT + (size_t)(((b * 4 + h) * 2 + d2) * 128 + n) * PACK_ATT + 8192 + c * 4) = fexp(TOT[d2 * 128 + c]); }
    __syncthreads();
}
__device__ __forceinline__ void prep_phase(Frame& F, const Args& a, int set, int c, int ncu, const int knobs = 0) {
    for (int u = c; u < 1024; u += ncu) { const int nn = u & 63, n = set == 0 ? (nn < 32 ? nn : 64 + nn) : 32 + nn; prep_unit(F, a, ((u >> 6) << 7) | n, knobs); }
}

constexpr int S_ATT = 0, S_DEC = 8192, S_QK = 9216, S_V = 9216 + 32768, S_BUF = S_V + 16384;
constexpr int S_O = 2 * S_BUF, OROW = 272, S_OT = 64 * OROW;
static_assert(S_O + 2 * S_OT <= RING_BYTES && (S_BUF % 1024) == 0, "scan LDS map");
template <class MidFn> __device__ __forceinline__ void scan_unit(Frame& F, const Args& a, int su, const MidFn& mid, const int knobs = 0) {
    const bool nodma = knobs & 1, nomath = knobs & 2, nostore = knobs & 4;
    const int bh = su >> 2, dir = (su >> 1) & 1, half = su & 1, b = bh >> 2, h = bh & 3;
    const int cid0 = ((b * 4 + h) * 2 + dir) * 128;
    LAS unsigned char* lds = F.lds; const int tid = F.tid, lane = F.lane, wid = F.wave, li = lane & 15, g = lane >> 4;
    const unsigned char* gvb = a.ws + WS_GV + (size_t)b * SEQ * 2048 + h * 512 + half * 256;
    unsigned char* ob = a.ws + (dir ? WS_OB : WS_OF) + (size_t)b * SEQ * 2048 + h * 512 + half * 256 + (size_t)(tid >> 4) * 2048 + (tid & 15) * 16;
    const int ow = (16 * wid + 4 * g) * 2 + li * OROW;
    const unsigned lds0 = (unsigned)(size_t)lds;
    int pk[8]; unsigned pvo[8], plo[8];
#pragma unroll
    for (int j = 0; j < 8; ++j) { const int p = wid + 8 * j;
        if (p < 9) { pk[j] = 0; pvo[j] = p * 1024 + lane * 16; plo[j] = S_ATT + p * 1024; }
        else if (p < 41) { pk[j] = 1; pvo[j] = (p - 9) * 1024 + lane * 16; plo[j] = S_QK + (p - 9) * 1024; }
        else if (p < 57) { const int pv = p - 41, row = 4 * pv + (lane >> 4), c = (lane & 15) ^ (2 * (row & 7)); pk[j] = 2; pvo[j] = row * 2048 + c * 16; plo[j] = S_V + pv * 1024; }
        else { pk[j] = 3; pvo[j] = 0; plo[j] = 0; } }
    auto issue = [&](int n, int bufoff) {
        const int cid = cid0 + n; const unsigned char* b0 = a.ws + WS_ATT + (size_t)cid * PACK_ATT; const unsigned char* b1 = a.ws + WS_H + (size_t)cid * PACK_QK; const unsigned char* b2 = gvb + (size_t)(64 * n) * 2048;
#pragma unroll
        for (int j = 0; j < 8; ++j) if (pk[j] != 3) glds16s(pk[j] == 0 ? b0 : (pk[j] == 1 ? b1 : b2), pvo[j], lds0 + bufoff + plo[j]);
    };
    f32x4 S[8];
#pragma unroll
    for (int ct = 0; ct < 8; ++ct) S[ct] = (f32x4){0.f, 0.f, 0.f, 0.f};
    const int vq = li >> 2, vp = li & 3;
    const int voff = (4 * g + vq) * 256 + (((2 * wid + (vp >> 1)) ^ (2 * ((4 * (g & 1) + vq)))) * 16) + 8 * (vp & 1);
    __builtin_amdgcn_s_waitcnt(0);
    auto step = [&](int s, int sb, int se) __attribute__((always_inline)) {
        const int n = dir ? 127 - s : s; const int bufoff = (s & 1) * S_BUF;
        if (!nostore && s > sb) { unsigned char* op = ob + (size_t)(64 * (dir ? n + 1 : n - 1)) * 2048; const LAS unsigned char* ot = lds + S_O + ((s - 1) & 1) * S_OT + (tid >> 4) * OROW + (tid & 15) * 16;
#pragma unroll
          for (int p = 0; p < 2; ++p) *(GAS v4u*)(op + (size_t)(32 * p) * 2048) = *(const LAS v4u*)(ot + 32 * p * OROW); }
        if (s + 1 < se && !nodma) issue(dir ? 126 - s : s + 1, S_BUF - bufoff);
        const LAS unsigned char* B = lds + bufoff;
        if (!nomath) {
        bf16x8 vf[2];
#pragma unroll
        for (int ks2 = 0; ks2 < 2; ++ks2) { const s16x4 lo = vtr(B + S_V + voff + ks2 * 8192), hh = vtr(B + S_V + voff + ks2 * 8192 + 4096); vf[ks2] = (bf16x8){lo[0], lo[1], lo[2], lo[3], hh[0], hh[1], hh[2], hh[3]}; }
        bf16x8 sf[4];
#pragma unroll
        for (int ks = 0; ks < 4; ++ks) { v4u w; w.x = cvtpk(S[2 * ks][0], S[2 * ks][1]); w.y = cvtpk(S[2 * ks][2], S[2 * ks][3]); w.z = cvtpk(S[2 * ks + 1][0], S[2 * ks + 1][1]); w.w = cvtpk(S[2 * ks + 1][2], S[2 * ks + 1][3]); sf[ks] = __builtin_bit_cast(bf16x8, w); }
#define SB() __builtin_amdgcn_sched_barrier(0)
#define LOADO(D, mt) do { _Pragma("unroll") for (int k_ = 0; k_ < 4; ++k_) D[k_] = *(const LAS bf16x8*)(B + S_QK + (((mt) * 4 + k_) * 64 + lane) * 16); \
                          _Pragma("unroll") for (int k_ = 0; k_ < 2; ++k_) D[4 + k_] = *(const LAS bf16x8*)(B + S_ATT + (((mt) * 2 + k_) * 64 + lane) * 16); } while (0)
#define MMAO(D, mt) do { f32x4 o_ = (f32x4){0.f, 0.f, 0.f, 0.f}; _Pragma("unroll") for (int k_ = 0; k_ < 4; ++k_) o_ = __builtin_amdgcn_mfma_f32_16x16x32_bf16(sf[k_], D[k_], o_, 0, 0, 0); \
                         _Pragma("unroll") for (int k_ = 0; k_ < 2; ++k_) o_ = __builtin_amdgcn_mfma_f32_16x16x32_bf16(vf[k_], D[4 + k_], o_, 0, 0, 0); *(LAS v2u*)(otile + (16 * (mt)) * OROW) = (v2u){cvtpk(o_[0], o_[1]), cvtpk(o_[2], o_[3])}; } while (0)
#define LOADS(D, V, c2) do { _Pragma("unroll") for (int k_ = 0; k_ < 4; ++k_) D[k_] = *(const LAS bf16x8*)(B + S_QK + 16384 + (((c2) * 4 + k_) * 64 + lane) * 16); \
                             V[0] = *(const LAS f32x4*)(B + S_DEC + (32 * (c2) + 4 * g) * 4); V[1] = *(const LAS f32x4*)(B + S_DEC + (32 * (c2) + 16 + 4 * g) * 4); } while (0)
#define MMAS(D, V, c2) do { _Pragma("unroll") for (int t_ = 0; t_ < 2; ++t_) { S[2 * (c2) + t_] = S[2 * (c2) + t_] * V[t_]; \
                            _Pragma("unroll") for (int k_ = 0; k_ < 2; ++k_) S[2 * (c2) + t_] = __builtin_amdgcn_mfma_f32_16x16x32_bf16(D[2 * t_ + k_], vf[k_], S[2 * (c2) + t_], 0, 0, 0); } } while (0)
        LAS unsigned char* otile = lds + S_O + (s & 1) * S_OT + ow;
        bf16x8 fa[6], fb[6]; f32x4 da[2], db[2];
        LOADO(fa, 0); SB(); LOADO(fb, 1); SB(); MMAO(fa, 0); SB(); LOADO(fa, 2); SB(); MMAO(fb, 1); SB(); LOADO(fb, 3); SB(); MMAO(fa, 2); SB();
        LOADS(fa, da, 0); SB(); MMAO(fb, 3); SB(); LOADS(fb, db, 1); SB(); MMAS(fa, da, 0); SB(); LOADS(fa, da, 2); SB(); MMAS(fb, db, 1); SB(); LOADS(fb, db, 3); SB(); MMAS(fa, da, 2); SB(); MMAS(fb, db, 3); SB();
#undef LOADO
#undef MMAO
#undef LOADS
#undef MMAS
#undef SB
        }
        asm volatile("s_waitcnt vmcnt(0) lgkmcnt(0)\n\ts_barrier" ::: "memory");
    };
    for (int seg = 0; seg < 2; ++seg) { const int sb = seg ? 32 : 0, se = seg ? 128 : 32;
        asm volatile("s_waitcnt vmcnt(0) lgkmcnt(0)\n\ts_barrier" ::: "memory");
        issue(dir ? 127 - sb : sb, (sb & 1) * S_BUF);
        asm volatile("s_waitcnt vmcnt(0) lgkmcnt(0)\n\ts_barrier" ::: "memory");
        for (int s = sb; s < se; ++s) step(s, sb, se);
        if (!nostore) { unsigned char* op = ob + (size_t)(64 * (dir ? 128 - se : se - 1)) * 2048; const LAS unsigned char* ot = lds + S_O + ((se - 1) & 1) * S_OT + (tid >> 4) * OROW + (tid & 15) * 16;
#pragma unroll
          for (int p = 0; p < 2; ++p) *(GAS v4u*)(op + (size_t)(32 * p) * 2048) = *(const LAS v4u*)(ot + 32 * p * OROW); }
        asm volatile("s_waitcnt vmcnt(0)" ::: "memory");
        if (seg == 0) mid();
    }
}
}
__global__ void __launch_bounds__(NWAVES * 64, 2) mega(Args args) {
    extern __shared__ __attribute__((aligned(16))) unsigned char lds[];
    Frame F;
    F.lds = (LAS unsigned char*)lds; F.MISC = (volatile LAS unsigned*)(F.lds + MISC_OFF);
    F.tid = threadIdx.x; F.lane = F.tid & 63; F.wave = __builtin_amdgcn_readfirstlane(F.tid >> 6);
    F.G = gridDim.x; { const int bx = blockIdx.x; F.vcu = (F.G % 8 == 0) ? (bx % 8) * (F.G / 8) + bx / 8 : bx; }
    unsigned char* ws = args.ws;
    F.ctl = (gu32*)(ws + WS_CTL);
    for (int u = F.tid; u < (LDS_BYTES - LDSCTL_OFF) / 4; u += NWAVES * 64) ((LAS unsigned*)(F.lds + LDSCTL_OFF))[u] = 0u;
    __syncthreads();
    XcdBarrier bar = xcd_barrier_post((unsigned*)(F.ctl + CW_BAR) + args.li * XCD_BAR_WORDS, F.MISC + 8);
    const int lo = args.ph_lo, hi = args.ph_hi;
#define IN(k) (lo <= (k) && (k) < hi)
#define BOTH(k) (IN(k) && IN((k) + 1))
    ProjOut P{(bf16*)(ws + WS_AQ), (bf16*)(ws + WS_AK), (bf16*)(ws + WS_AV), (bf16*)(ws + WS_SAG), (bf16*)(ws + WS_GQ), (bf16*)(ws + WS_GK), (bf16*)(ws + WS_GV), (bf16*)(ws + WS_SGG), (float*)(ws + WS_LR)};
    if (IN(0)) { p0_mod(F, args); if (BOTH(0)) xcd_barrier(bar); }
    if (IN(1)) { p1_h(F, args); p1_weights(F, args); if (BOTH(1)) xcd_barrier(bar); }
    if (IN(2)) {
        pg8::Gemm g{(const bf16*)(ws + WS_H), (const bf16*)(ws + WS_WINT), T, 7168, DM}; pg8::StaticOrder S; S.init(T, 7168, F.G, (int)blockIdx.x);
#ifdef PROBE_G2
        S.reps = 2;
#endif
        pg8::EpiProj E{P};
        pg8::gemm_phase<pg8::EpiProj, pg8::StaticOrder, true, true>(F.lds + RING_OFF, g, S, E);
        lr_tail(F, args);
        if (BOTH(2)) xcd_barrier(bar);
    }
    if (IN(3)) {
#ifdef PROBE_P
        { int q = F.vcu; asm volatile("" : "+s"(q)); gla::prep_phase(F, args, 0, q, F.G, PROBE_P); }
#endif
        gla::prep_phase(F, args, 0, F.vcu, F.G); if (BOTH(3)) xcd_barrier(bar); }
    if (IN(4)) {
        const int ac = (F.vcu >> 2) * 3 + (F.vcu & 3) - 1, anc = (F.G >> 2) * 3;
#ifdef PROBE_S
        if ((F.vcu & 3) == 0) { int q = F.vcu >> 2; asm volatile("" : "+s"(q)); gla::scan_unit(F, args, q, [&]() {}, PROBE_S); }
#endif
        if ((F.vcu & 3) == 0) gla::scan_unit(F, args, F.vcu >> 2, [&]() { xcd_barrier(bar); });
        else { gla::prep_phase(F, args, 1, ac, anc); xcd_barrier(bar);
#ifdef PROBE_A2
            { int q = ac; asm volatile("" : "+s"(q)); att::attn_phase(F, args, q, anc, PROBE_A2); }
#endif
            att::attn_phase(F, args, ac, anc);
        }
        if (BOTH(4)) xcd_barrier(bar); }
    if (IN(5)) { p5_combine(F, args); if (BOTH(5)) xcd_barrier(bar); }
    if (IN(6)) {
        pg8::Gemm g{(const bf16*)(ws + WS_H), (const bf16*)(ws + WS_WOUTT), T, DM, DM}; pg8::StaticOrder S; S.init(T, DM, F.G, (int)blockIdx.x);
#ifdef PROBE_G6
        S.reps = 2;
#endif
        pg8::EpiY E{(bf16*)(ws + WS_Y)};
        pg8::gemm_phase<pg8::EpiY, pg8::StaticOrder, true, true>(F.lds + RING_OFF, g, S, E);
        if (BOTH(6)) xcd_barrier(bar);
    }
    if (IN(7)) { p7_final(F, args); }
#undef IN
#undef BOTH
}
extern "C" void kernel_launch(void* const* d_in, const int* in_sizes, int n_in, void* d_out, int out_size, void* d_ws, size_t ws_size, hipStream_t stream) {
    static int grid = 0;
    if (grid == 0) {
        if (n_in != 13 || ws_size < WS_END || out_size != T * DM) { fprintf(stderr, "kernel_launch: unexpected problem (n_in %d, ws %zu, out %d)\n", n_in, ws_size, out_size); grid = -1; return; }
        int dev = 0, cus = 0, per_cu = 0;
        if (hipGetDevice(&dev) != hipSuccess || hipDeviceGetAttribute(&cus, hipDeviceAttributeMultiprocessorCount, dev) != hipSuccess) { grid = -1; return; }
        if (hipFuncSetAttribute((const void*)mega, hipFuncAttributeMaxDynamicSharedMemorySize, LDS_BYTES) != hipSuccess) { fprintf(stderr, "kernel_launch: hipFuncSetAttribute failed\n"); grid = -1; return; }
        if (hipOccupancyMaxActiveBlocksPerMultiprocessor(&per_cu, (const void*)mega, NWAVES * 64, LDS_BYTES) != hipSuccess || per_cu < 1) { fprintf(stderr, "kernel_launch: occupancy query says %d\n", per_cu); }
        (void)hipGetLastError();
        grid = cus;
    }
    if (grid < 0) return;
    (void)hipMemsetAsync((char*)d_ws + WS_CTL, 0, CTL_ZERO_BYTES, stream);
    Args a{};
    for (int i = 0; i < 13; ++i) a.in[i] = (const float*)d_in[i];
    a.out = (float*)d_out; a.ws = (unsigned char*)d_ws;
    unsigned char* ws = (unsigned char*)d_ws;
#ifndef PROBE_DUP
#define PROBE_DUP -1
#endif
#ifndef PROBE_REPS
#define PROBE_REPS 2
#endif
#ifndef PROBE_SUB
#define PROBE_SUB 2
#endif
    a.ph_lo = 0; a.ph_hi = 8; a.li = 0; a.dup_phase = PROBE_DUP; a.dup_reps = PROBE_REPS; a.dup_sub = PROBE_SUB;
    hipLaunchKernelGGL(mega, dim3(grid), dim3(NWAVES * 64), LDS_BYTES, stream, a);
}
```

```cpp
#include <hip/hip_runtime.h>
#include <stdint.h>
#include <cstdio>
#include <type_traits>

typedef unsigned short bf16;
constexpr int BATCH = 4, SEQ = 8192, DM = 2048, T = BATCH * SEQ;
constexpr int NPROJ = 7200, NPAD = 7424;
constexpr float EPS = 1e-6f;
constexpr float LOG2E = 1.4426950408889634f;
constexpr float C2 = 0.125f * LOG2E;
constexpr size_t MiB = 1u << 20;
constexpr size_t WS_CTL = 0, CTL_ZERO_BYTES = 1 * MiB, WS_MOD = 1 * MiB, WS_SSP = 1 * MiB + 512 * 1024  , WS_WINT = 2 * MiB, WS_WOUTT = 32 * MiB,
                 WS_H = 40 * MiB  ,
                 WS_AQ = 168 * MiB, WS_AK = 232 * MiB, WS_AV = 296 * MiB, WS_SAG = 360 * MiB, WS_GQ = 424 * MiB, WS_GK = 456 * MiB, WS_GV = 488 * MiB,
                 WS_SGG = 552 * MiB, WS_LR = 616 * MiB, WS_OP = 620 * MiB  , WS_LSE = 812 * MiB  , WS_OF = 818 * MiB, WS_OB = 882 * MiB,
                 WS_SS = 946 * MiB  , WS_ATT = 950 * MiB  ,
                 WS_Y = WS_AQ  ,
                 WS_END = 986 * MiB;

__device__ __forceinline__ unsigned f2bf(float f) { unsigned u = __builtin_bit_cast(unsigned, f); return (u + 0x7fffu + ((u >> 16) & 1u)) >> 16; }
__device__ __forceinline__ unsigned pk2(float lo, float hi) { typedef float f2_ __attribute__((ext_vector_type(2))); typedef __bf16 b2_ __attribute__((ext_vector_type(2))); f2_ v = {lo, hi}; b2_ b = __builtin_convertvector(v, b2_); return __builtin_bit_cast(unsigned, b); }
__device__ __forceinline__ float bf2f(bf16 h) { return __builtin_bit_cast(float, (unsigned)h << 16); }
__device__ __forceinline__ float silu_f(float x) { return x / (1.f + __expf(-x)); }
__device__ __forceinline__ float log_sigmoid_f(float x) { return fminf(x, 0.f) - log1pf(__expf(-fabsf(x))); }
__device__ __forceinline__ int t5_bucket(int rel) {
    const int n = rel < 0 ? -rel : rel;
    int v;
    if (n < 8) v = n;
    else v = 8 + (n >= 15) + (n >= 27) + (n >= 50) + (n >= 91) + (n >= 166) + (n >= 305) + (n >= 559);
    return (rel > 0 ? 16 : 0) + v;
}
struct ProjOut { bf16 *aq, *ak, *av, *sag, *gq, *gk, *gv, *sgg; float* lr; };
namespace pg8 {
#define PG8_LAS __attribute__((address_space(3)))
typedef unsigned short bf16_t;
typedef short bf16x8 __attribute__((ext_vector_type(8)));
typedef float f32x4 __attribute__((ext_vector_type(4)));
typedef unsigned u32x4 __attribute__((ext_vector_type(4)));
constexpr int BM = 256, BK = 64, HALF = 128, HTB = HALF * BK * 2  , STAGE_BYTES = 8 * HTB, NXCD = 8, WGM = 8;

__host__ __device__ __forceinline__ int lds_byte(int r, int c) { const int st = (r >> 4) * 2 + (c >> 5), rr = r & 15, cc = c & 31, ob = rr * 64 + cc * 2; return st * 1024 + (ob ^ (((ob >> 9) & 1) << 5)); }
__host__ __device__ __forceinline__ void stage_rc(int b, int& R, int& C) { const int st = b / 1024, sb = b % 1024, swz = sb ^ (((sb >> 9) & 1) << 5); R = (st >> 1) * 16 + swz / 64; C = (st & 1) * 32 + (swz % 64) / 2; }
__host__ __device__ __forceinline__ int perm32(int rho) { const int n = rho >> 4, i = rho & 15; return 8 * (i >> 2) + 4 * n + (i & 3); }

struct Unit { int pm, pn; };
struct Gemm { const bf16_t* A; const bf16_t* Bt; int M, N, K; };

struct StaticOrder {
    int nM, nN, nwg, G, c, reps;
    __host__ __device__ void init(int M, int N, int G_, int c_) { nM = M / BM; nN = N / BM; nwg = nM * nN; G = G_; c = c_; reps = 1; }
    __host__ __device__ bool next(int i, Unit& u) const {
        const long L = (long)i * G + c; if (L >= (long)nwg * reps) return false;
        int wgid = (int)(L % nwg); { const int q = nwg / NXCD, r = nwg % NXCD, xcd = wgid % NXCD, off = wgid / NXCD; wgid = (xcd < r ? xcd * (q + 1) : r * (q + 1) + (xcd - r) * q) + off; }
        const int nig = WGM * nN, gid = wgid / nig, fm = gid * WGM, gsz = (nM - fm) < WGM ? (nM - fm) : WGM;
        u.pm = fm + ((wgid % nig) % gsz); u.pn = (wgid % nig) / gsz; return true;
    }
    __device__ __forceinline__ void a_ready(const Unit&) const {}
    __device__ __forceinline__ void done(const Unit&) const {}
};

__device__ __forceinline__ unsigned cvt_pk_bf16(float lo, float hi) { unsigned r; asm volatile("v_cvt_pk_bf16_f32 %0, %1, %2" : "=v"(r) : "v"(lo), "v"(hi)); return r; }
struct EpiProj {
    static constexpr bool PERM = true, AFTER_DRAIN = false;
    ProjOut P;
    __device__ __forceinline__ void operator()(const f32x4 (&acc)[2][2][4][2], const Unit& u, int wr, int wc, int fr, int fq) const {
        const int row0 = u.pm * BM + wr * 64 + fr; const int pn = u.pn;
        if (pn == 28) {
            if (wc == 0) {
#pragma unroll
                for (int ai = 0; ai < 2; ++ai)
#pragma unroll
                    for (int m = 0; m < 4; ++m) { float* rowp = P.lr + (size_t)(row0 + ai * HALF + m * 16) * 32 + 8 * fq;
                        *(f32x4*)(rowp) = acc[ai][0][m][0]; *(f32x4*)(rowp + 4) = acc[ai][0][m][1]; }
            }
            return;
        }
        bf16_t* base; int ld, ct; int act = 0; float sc = 1.f;
        if (pn < 4) { base = P.aq; ld = 1024; ct = pn; sc = C2; }
        else if (pn < 8) { base = P.ak; ld = 1024; ct = pn - 4; }
        else if (pn < 12) { base = P.av; ld = 1024; ct = pn - 8; }
        else if (pn < 16) { base = P.sag; ld = 1024; ct = pn - 12; act = 1; }
        else if (pn < 18) { base = P.gq; ld = 512; ct = pn - 16; }
        else if (pn < 20) { base = P.gk; ld = 512; ct = pn - 18; }
        else if (pn < 24) { base = P.gv; ld = 1024; ct = pn - 20; }
        else { base = P.sgg; ld = 1024; ct = pn - 24; act = 1; }
        const int col0 = ct * BM + wc * 32 + 8 * fq;
#pragma unroll
        for (int ai = 0; ai < 2; ++ai)
#pragma unroll
            for (int m = 0; m < 4; ++m) { bf16_t* rowp = base + (size_t)(row0 + ai * HALF + m * 16) * ld + col0;
#pragma unroll
                for (int bj = 0; bj < 2; ++bj) { f32x4 v0 = acc[ai][bj][m][0], v1 = acc[ai][bj][m][1];
                    if (act) {
#pragma unroll
                        for (int e = 0; e < 4; ++e) { v0[e] = v0[e] * __builtin_amdgcn_rcpf(1.f + __expf(-v0[e])); v1[e] = v1[e] * __builtin_amdgcn_rcpf(1.f + __expf(-v1[e])); } }
                    v0 = v0 * sc; v1 = v1 * sc; u32x4 w; w.x = cvt_pk_bf16(v0[0], v0[1]); w.y = cvt_pk_bf16(v0[2], v0[3]); w.z = cvt_pk_bf16(v1[0], v1[1]); w.w = cvt_pk_bf16(v1[2], v1[3]);
                    __builtin_nontemporal_store(w, (u32x4*)(rowp + bj * HALF)); } }
    }
};
struct EpiY {
    static constexpr bool PERM = true, AFTER_DRAIN = false;
    bf16_t* Y;
    __device__ __forceinline__ void operator()(const f32x4 (&acc)[2][2][4][2], const Unit& u, int wr, int wc, int fr, int fq) const {
        const int row0 = u.pm * BM + wr * 64 + fr, col0 = u.pn * BM + wc * 32 + 8 * fq;
#pragma unroll
        for (int ai = 0; ai < 2; ++ai)
#pragma unroll
            for (int m = 0; m < 4; ++m) { bf16_t* rowp = Y + (size_t)(row0 + ai * HALF + m * 16) * DM + col0;
#pragma unroll
                for (int bj = 0; bj < 2; ++bj) { const f32x4 v0 = acc[ai][bj][m][0], v1 = acc[ai][bj][m][1];
                    u32x4 w; w.x = cvt_pk_bf16(v0[0], v0[1]); w.y = cvt_pk_bf16(v0[2], v0[3]); w.z = cvt_pk_bf16(v1[0], v1[1]); w.w = cvt_pk_bf16(v1[2], v1[3]);
                    *(u32x4*)(rowp + bj * HALF) = w; } }
    }
};
template <class Epi, class Sched, bool ALIGN_EPI = false, bool SP2 = false>
__device__ __forceinline__ void gemm_phase(PG8_LAS unsigned char* lds, const Gemm g, const Sched& S, const Epi& E) {
    const int tid = threadIdx.x, wid = __builtin_amdgcn_readfirstlane(tid >> 6), lane = tid & 63, wr = wid >> 2, wc = wid & 3, fr = lane & 15, fq = lane >> 4;
    const int K = g.K, nt = K / BK;
    unsigned voffA[2], voffB[2];
#pragma unroll
    for (int i = 0; i < 2; ++i) { int R, C; stage_rc(tid * 16 + i * 8192, R, C); const int Rb = Epi::PERM ? ((R & ~31) + perm32(R & 31)) : R;
        voffA[i] = (unsigned)(R * K + C) * 2u; voffB[i] = (unsigned)(Rb * K + C) * 2u; }
    const size_t kstep = (size_t)(BK * 2);
    const size_t hstep = (size_t)HALF * K * 2;
    const size_t tstep = 2 * hstep;
    const unsigned ldsw = (unsigned)wid * 1024u;
    const int aoff = lds_byte(wr * 64 + fr, fq * 8), boff = lds_byte(wc * 32 + fr, fq * 8);
#define PG8_SA(b, h) (((b) * 2 + (h)) * HTB)
#define PG8_SB(b, h) ((4 + (b) * 2 + (h)) * HTB)
#define PG8_STAGE(bufoff, gbase, voff) do { _Pragma("unroll") for (int _i = 0; _i < 2; ++_i) \
        __builtin_amdgcn_global_load_lds((const unsigned*)((const char*)(gbase) + (voff)[_i]), (PG8_LAS unsigned*)(lds + (bufoff) + ldsw + _i * 8192), 16, 0, 0); } while (0)
#define PG8_LDA(dst, b, h) do { _Pragma("unroll") for (int m = 0; m < 4; ++m) _Pragma("unroll") for (int k = 0; k < 2; ++k) dst[m][k] = *(const PG8_LAS bf16x8*)(lds + PG8_SA(b, h) + aoff + m * 2048 + k * 1024); } while (0)
#define PG8_LDB(dst, b, h) do { _Pragma("unroll") for (int n = 0; n < 2; ++n) _Pragma("unroll") for (int k = 0; k < 2; ++k) dst[n][k] = *(const PG8_LAS bf16x8*)(lds + PG8_SB(b, h) + boff + n * 2048 + k * 1024); } while (0)
#define PG8_MMA(ai, bj, At, Bt) do { __builtin_amdgcn_s_setprio(1); _Pragma("unroll") for (int m = 0; m < 4; ++m) _Pragma("unroll") for (int n = 0; n < 2; ++n) _Pragma("unroll") for (int k = 0; k < 2; ++k) \
        acc[ai][bj][m][n] = __builtin_amdgcn_mfma_f32_16x16x32_bf16(Bt[n][k], At[m][k], acc[ai][bj][m][n], 0, 0, 0); __builtin_amdgcn_s_setprio(0); } while (0)
#define PG8_WAIT_V(n) asm volatile("s_waitcnt vmcnt(" #n ")" ::: "memory")
#define PG8_WAIT_L(n) asm volatile("s_waitcnt lgkmcnt(" #n ")" ::: "memory")
#define PG8_BAR __builtin_amdgcn_s_barrier()
#define PG8_SCHED __builtin_amdgcn_sched_barrier(0)
    Unit cur, nxt; int ui = 0;
    if (!S.next(0, cur)) return;
    f32x4 acc[2][2][4][2];
#pragma unroll
    for (int a = 0; a < 2; ++a)
#pragma unroll
        for (int b = 0; b < 2; ++b)
#pragma unroll
            for (int m = 0; m < 4; ++m)
#pragma unroll
                for (int n = 0; n < 2; ++n) acc[a][b][m][n] = (f32x4){0.f, 0.f, 0.f, 0.f};
    bf16x8 At[4][2], B0[2][2], B1[2][2];
    const char* cA = (const char*)g.A + (size_t)cur.pm * tstep; const char* cB = (const char*)g.Bt + (size_t)cur.pn * tstep;
    S.a_ready(cur);
    if constexpr (SP2) {
        PG8_STAGE(PG8_SB(0, 0), cB, voffB); PG8_STAGE(PG8_SB(0, 1), cB + hstep, voffB); PG8_STAGE(PG8_SA(0, 0), cA, voffA); PG8_STAGE(PG8_SA(0, 1), cA + hstep, voffA);
        if (wr == 1) PG8_BAR;
        PG8_WAIT_V(2); PG8_BAR;
        PG8_STAGE(PG8_SB(1, 0), cB + kstep, voffB); PG8_STAGE(PG8_SA(1, 0), cA + kstep, voffA); PG8_STAGE(PG8_SB(1, 1), cB + hstep + kstep, voffB);
        PG8_WAIT_V(6); PG8_BAR;
    } else {
        PG8_STAGE(PG8_SB(0, 0), cB, voffB); PG8_STAGE(PG8_SA(0, 0), cA, voffA); PG8_STAGE(PG8_SB(0, 1), cB + hstep, voffB); PG8_STAGE(PG8_SA(0, 1), cA + hstep, voffA);
        if (wr == 1) PG8_BAR;
        PG8_WAIT_V(4); PG8_BAR;
        PG8_STAGE(PG8_SB(1, 0), cB + kstep, voffB); PG8_STAGE(PG8_SA(1, 0), cA + kstep, voffA); PG8_STAGE(PG8_SB(1, 1), cB + hstep + kstep, voffB);
        PG8_WAIT_V(6); PG8_BAR;
    }
    for (;;) {
        const bool has_next = S.next(ui + 1, nxt);
        const char* nA = has_next ? (const char*)g.A + (size_t)nxt.pm * tstep : cA; const char* nB = has_next ? (const char*)g.Bt + (size_t)nxt.pn * tstep : cB;
        for (int t = 0; t < nt; t += 2) {
            const bool last = (t == nt - 2);
            const char* a1 = cA + (size_t)(t + 1) * kstep;
            const char* a2 = last ? nA : cA + (size_t)(t + 2) * kstep; const char* b2 = last ? nB : cB + (size_t)(t + 2) * kstep;
            const char* a3 = a2 + kstep; const char* b3 = b2 + kstep;
            if (last && has_next) S.a_ready(nxt);
            if constexpr (SP2) {
            PG8_LDB(B0, 0, 0); PG8_LDB(B1, 0, 1); PG8_SCHED; PG8_LDA(At, 0, 0); PG8_STAGE(PG8_SA(1, 1), a1 + hstep, voffA);
            PG8_WAIT_V(8); PG8_WAIT_L(0); PG8_BAR; PG8_MMA(0, 0, At, B0); PG8_MMA(0, 1, At, B1); PG8_BAR; PG8_SCHED;
            PG8_LDA(At, 0, 1); PG8_STAGE(PG8_SB(0, 0), b2, voffB); PG8_STAGE(PG8_SB(0, 1), b2 + hstep, voffB); PG8_STAGE(PG8_SA(0, 0), a2, voffA);
            PG8_WAIT_V(8); PG8_WAIT_L(0); PG8_BAR; PG8_MMA(1, 0, At, B0); PG8_MMA(1, 1, At, B1); PG8_BAR; PG8_SCHED;
            PG8_LDB(B0, 1, 0); PG8_LDB(B1, 1, 1); PG8_SCHED; PG8_LDA(At, 1, 0); PG8_STAGE(PG8_SA(0, 1), a2 + hstep, voffA);
            PG8_WAIT_V(8); PG8_WAIT_L(0); PG8_BAR; PG8_MMA(0, 0, At, B0); PG8_MMA(0, 1, At, B1); PG8_BAR; PG8_SCHED;
            PG8_LDA(At, 1, 1); PG8_STAGE(PG8_SB(1, 0), b3, voffB); PG8_STAGE(PG8_SB(1, 1), b3 + hstep, voffB); PG8_STAGE(PG8_SA(1, 0), a3, voffA);
            PG8_WAIT_V(8); PG8_WAIT_L(0); PG8_BAR; PG8_MMA(1, 0, At, B0); PG8_MMA(1, 1, At, B1); PG8_BAR; PG8_SCHED;
            } else {
            PG8_LDB(B0, 0, 0); PG8_SCHED; PG8_LDA(At, 0, 0); PG8_STAGE(PG8_SA(1, 1), a1 + hstep, voffA);
            PG8_WAIT_L(8); PG8_BAR; PG8_WAIT_L(0); PG8_MMA(0, 0, At, B0); PG8_BAR; PG8_SCHED;
            PG8_LDB(B1, 0, 1); PG8_STAGE(PG8_SB(0, 0), b2, voffB);
            PG8_BAR; PG8_WAIT_L(0); PG8_MMA(0, 1, At, B1); PG8_BAR;
            PG8_LDA(At, 0, 1); PG8_STAGE(PG8_SA(0, 0), a2, voffA);
            PG8_BAR; PG8_WAIT_L(0); PG8_MMA(1, 0, At, B0); PG8_BAR; PG8_SCHED;
            PG8_STAGE(PG8_SB(0, 1), b2 + hstep, voffB);
            PG8_WAIT_V(6); PG8_BAR; PG8_MMA(1, 1, At, B1); PG8_BAR;
            PG8_LDB(B0, 1, 0); PG8_SCHED; PG8_LDA(At, 1, 0); PG8_STAGE(PG8_SA(0, 1), a2 + hstep, voffA);
            PG8_WAIT_L(8); PG8_BAR; PG8_WAIT_L(0); PG8_MMA(0, 0, At, B0); PG8_BAR; PG8_SCHED;
            PG8_LDB(B1, 1, 1); PG8_STAGE(PG8_SB(1, 0), b3, voffB);
            PG8_BAR; PG8_WAIT_L(0); PG8_MMA(0, 1, At, B1); PG8_BAR;
            PG8_LDA(At, 1, 1); PG8_STAGE(PG8_SA(1, 0), a3, voffA);
            PG8_BAR; PG8_WAIT_L(0); PG8_MMA(1, 0, At, B0); PG8_BAR; PG8_SCHED;
            PG8_STAGE(PG8_SB(1, 1), b3 + hstep, voffB);
            PG8_WAIT_V(6); PG8_BAR; PG8_MMA(1, 1, At, B1); PG8_BAR;
            }
        }
        if constexpr (ALIGN_EPI) { if (wr == 0) PG8_BAR; }
        if constexpr (!Epi::AFTER_DRAIN) { E(acc, cur, wr, wc, fr, fq); S.done(cur); }
        if (!has_next) break;
#pragma unroll
        for (int a = 0; a < 2; ++a)
#pragma unroll
            for (int b = 0; b < 2; ++b)
#pragma unroll
                for (int m = 0; m < 4; ++m)
#pragma unroll
                    for (int n = 0; n < 2; ++n) acc[a][b][m][n] = (f32x4){0.f, 0.f, 0.f, 0.f};
        cur = nxt; cA = nA; cB = nB; ++ui;
        if constexpr (ALIGN_EPI) { if (wr == 1) PG8_BAR; }
    }
    PG8_WAIT_V(0);
    if constexpr (!ALIGN_EPI) { if (wr == 0) PG8_BAR; }
    PG8_BAR;
    if constexpr (Epi::AFTER_DRAIN) { E.fused(acc, cur, wr, wc, fr, fq, lds, wid, lane); S.done(cur); }
#undef PG8_SA
#undef PG8_SB
#undef PG8_STAGE
#undef PG8_LDA
#undef PG8_LDB
#undef PG8_MMA
#undef PG8_WAIT_V
#undef PG8_WAIT_L
#undef PG8_BAR
#undef PG8_SCHED
}
}
constexpr int NWAVES = 8;
constexpr int RING_OFF = 0, RING_BYTES = 153600;
constexpr int LDSCTL_OFF = RING_BYTES, MISC_OFF = LDSCTL_OFF + 320;
constexpr int LDS_BYTES = 154624;
constexpr int CW_TMO = 0, CW_CODE = 1, CW_BAR = 4096;
#define GAS __attribute__((address_space(1)))
#define LAS __attribute__((address_space(3)))
typedef unsigned v4u __attribute__((ext_vector_type(4)));
typedef unsigned v2u __attribute__((ext_vector_type(2)));
typedef float f32x4 __attribute__((ext_vector_type(4)));
typedef float f32x16 __attribute__((ext_vector_type(16)));
typedef short bf16x8 __attribute__((ext_vector_type(8)));
typedef short s16x4 __attribute__((ext_vector_type(4)));
typedef GAS unsigned gu32;
typedef GAS unsigned long long gu64;
#define RLX_AGENT __ATOMIC_RELAXED, __HIP_MEMORY_SCOPE_AGENT
#define LDS_WAIT() asm volatile("s_waitcnt lgkmcnt(0)" ::: "memory")
#define VM_WAIT() asm volatile("s_waitcnt vmcnt(0)" ::: "memory")
__device__ __forceinline__ void glds16(const void* gsrc, unsigned lds_dst) { unsigned keep; const unsigned dst = (unsigned)__builtin_amdgcn_readfirstlane((int)lds_dst);
    asm volatile("s_mov_b32 %0, m0\n\ts_mov_b32 m0, %2\n\ts_nop 0\n\tglobal_load_lds_dwordx4 %1, off\n\ts_mov_b32 m0, %0" : "=&s"(keep) : "v"(gsrc), "s"(dst) : "memory"); }
template <bool NT = false> __device__ __forceinline__ void glds16s(const void* sbase, unsigned voff, unsigned lds_dst) { unsigned keep; const unsigned dst = (unsigned)__builtin_amdgcn_readfirstlane((int)lds_dst);
    const unsigned long long b = (unsigned long long)sbase; const unsigned blo = (unsigned)__builtin_amdgcn_readfirstlane((int)(unsigned)b), bhi = (unsigned)__builtin_amdgcn_readfirstlane((int)(unsigned)(b >> 32));
    const unsigned long long bs = ((unsigned long long)bhi << 32) | blo;
    if constexpr (NT) asm volatile("s_mov_b32 %0, m0\n\ts_mov_b32 m0, %3\n\ts_nop 0\n\tglobal_load_lds_dwordx4 %1, %2 nt\n\ts_mov_b32 m0, %0" : "=&s"(keep) : "v"(voff), "s"(bs), "s"(dst) : "memory");
    else              asm volatile("s_mov_b32 %0, m0\n\ts_mov_b32 m0, %3\n\ts_nop 0\n\tglobal_load_lds_dwordx4 %1, %2\n\ts_mov_b32 m0, %0" : "=&s"(keep) : "v"(voff), "s"(bs), "s"(dst) : "memory"); }
#define XB_TMO      128
#define XB_XCNT(j)  (256  + 64 * (j))
#define XB_XSUB(j)  (1280 + 64 * (j))
#define XB_XGEN(j)  (2304 + 64 * (j))
#define XB_TOP      3328
#define XB_TOPGEN   3392
#define XCD_BAR_WORDS 3456
#define XB_SPIN_CAP (1u << 18)

__device__ __forceinline__ unsigned xb_ld(unsigned* p)              { return __hip_atomic_load(p, __ATOMIC_RELAXED, __HIP_MEMORY_SCOPE_AGENT); }
__device__ __forceinline__ unsigned xb_add(unsigned* p, unsigned v) { return __hip_atomic_fetch_add(p, v, __ATOMIC_RELAXED, __HIP_MEMORY_SCOPE_AGENT); }
__device__ __forceinline__ unsigned xb_xcc_id() { return (unsigned)__builtin_amdgcn_s_getreg((3 << 11) | 20) & 0xFu; }
#define XB_SPIN(cond, bar) do { unsigned _sp = 0; while (cond) { __builtin_amdgcn_s_sleep(1); \
    if ((++_sp & 255u) == 0u) { if (xb_ld(&(bar)[XB_TMO])) break; if (_sp > XB_SPIN_CAP) { atomicAdd(&(bar)[XB_TMO], 1u); break; } } } } while (0)

struct XcdBarrier {
    unsigned* bar; unsigned x;
    volatile LAS unsigned* st;
};

__device__ __forceinline__ XcdBarrier xcd_barrier_post(unsigned* bar, volatile LAS unsigned* st) {
    XcdBarrier b; b.bar = bar; b.x = xb_xcc_id(); b.st = st;
    if (threadIdx.x == 0) (void)xb_add(&bar[XB_XCNT(b.x)], 1u);
    return b;
}
__device__ __forceinline__ void xcd_barrier_complete(unsigned* bar, unsigned x, unsigned& nloc, unsigned& nx) {
    const unsigned G = gridDim.x * gridDim.y * gridDim.z;
    unsigned sum, cnt, mine, sp = 0u;
    for (;;) {
        sum = 0u; cnt = 0u; mine = 0u;
#pragma unroll
        for (unsigned j = 0; j < 16; ++j) { const unsigned c = xb_ld(&bar[XB_XCNT(j)]); sum += c; cnt += (c > 0u) ? 1u : 0u; mine = (j == x) ? c : mine; }
        if (sum == G) break;
        __builtin_amdgcn_s_sleep(1);
        if ((++sp & 255u) == 0u) { if (xb_ld(&bar[XB_TMO])) break; if (sp > XB_SPIN_CAP) { atomicAdd(&bar[XB_TMO], 1u); break; } }
    }
    nloc = mine > 0u ? mine : 1u; nx = cnt > 0u ? cnt : 1u;
}

__device__ __forceinline__ void xcd_barrier(const XcdBarrier& b) {
    asm volatile("s_waitcnt vmcnt(0)" ::: "memory");
    __syncthreads();
    if (threadIdx.x == 0) {
        unsigned* bar = b.bar;
        __builtin_amdgcn_s_waitcnt(0);
        unsigned nloc = b.st[0], nx = b.st[1];
        if (nloc == 0u) { xcd_barrier_complete(bar, b.x, nloc, nx); b.st[0] = nloc; b.st[1] = nx; }
        const unsigned old = xb_add(&bar[XB_XSUB(b.x)], 1u);
        const unsigned gen = old / nloc;
        if (old + 1u == (gen + 1u) * nloc) {
            __builtin_amdgcn_fence(__ATOMIC_RELEASE, "agent");
            asm volatile("s_waitcnt vmcnt(0)" ::: "memory");
            const unsigned og = xb_add(&bar[XB_TOP], 1u);
            const unsigned tg = og / nx;
            if (og + 1u == (tg + 1u) * nx) xb_add(&bar[XB_TOPGEN], 1u);
            else XB_SPIN(xb_ld(&bar[XB_TOPGEN]) == tg, bar);
            __builtin_amdgcn_fence(__ATOMIC_ACQUIRE, "agent");
            xb_add(&bar[XB_XGEN(b.x)], 1u);
            asm volatile("s_waitcnt vmcnt(0)" ::: "memory");
        } else {
            XB_SPIN(xb_ld(&bar[XB_XGEN(b.x)]) == gen, bar);
            __builtin_amdgcn_fence(__ATOMIC_ACQUIRE, "agent");
            asm volatile("s_waitcnt vmcnt(0)" ::: "memory");
        }
    }
    __syncthreads();
}

struct Args { const float* in[13]; float* out; unsigned char* ws; int ph_lo, ph_hi, li, dup_phase, dup_reps, dup_sub; };
struct Frame {
    LAS unsigned char* lds; volatile LAS unsigned* MISC; gu32* ctl;
    int tid, lane, wave, vcu, G;
};
__device__ __forceinline__ float wave_sum(float v) {
#pragma unroll
    for (int o = 1; o < 64; o <<= 1) v += __shfl_xor(v, o);
    return v;
}
__device__ __forceinline__ void p0_transpose_item(const float* W, int K, int N, bf16* WT, LAS float* scr, int item, int lane) {
    const int nblk = N / 32, kb = item / nblk, nb = item % nblk, k0 = 64 * kb, n0 = 32 * nb;
#pragma unroll 8
    for (int i = 0; i < 32; ++i) { const int kk = 2 * i + (lane >> 5); scr[kk * 33 + (lane & 31)] = __builtin_nontemporal_load(W + (size_t)(k0 + kk) * N + n0 + (lane & 31)); }
    LDS_WAIT(); asm volatile("" ::: "memory");
    const int c = lane & 7;
#pragma unroll
    for (int j = 0; j < 4; ++j) { const int n = (lane >> 3) + 8 * j; const LAS float* s = scr + (8 * c) * 33 + n;
        v4u o; o.x = pk2(s[0 * 33], s[1 * 33]); o.y = pk2(s[2 * 33], s[3 * 33]); o.z = pk2(s[4 * 33], s[5 * 33]); o.w = pk2(s[6 * 33], s[7 * 33]);
        *(GAS v4u*)(WT + (size_t)(n0 + n) * K + k0 + 8 * c) = o; }
    LDS_WAIT(); asm volatile("" ::: "memory");
}
__device__ __forceinline__ void p0_mod(Frame& F, const Args& a) {
    const float* c = a.in[1]; const float* w_cond = a.in[2]; const float* b_cond = a.in[3];
    float* mod = (float*)(a.ws + WS_MOD);
    if (F.vcu < 192) {
        LAS float* sc = (LAS float*)(F.lds);
        LAS float* red = (LAS float*)(F.lds + 32768);
        for (int i = F.tid; i < 4 * DM; i += NWAVES * 64) sc[i] = silu_f(c[i]);
        __syncthreads();
        const int cg = F.lane & 7, kr = F.lane >> 3, n0 = 32 * F.vcu + 4 * cg;
        f32x4 acc[4];
#pragma unroll
        for (int b = 0; b < 4; ++b) acc[b] = (f32x4){0.f, 0.f, 0.f, 0.f};
#pragma unroll 8
        for (int it = 0; it < 32; ++it) { const int k = 256 * F.wave + 8 * it + kr;
            const f32x4 w = __builtin_nontemporal_load((const GAS f32x4*)(w_cond + (size_t)k * (3 * DM) + n0));
#pragma unroll
            for (int b = 0; b < 4; ++b) acc[b] += w * sc[b * DM + k]; }
#pragma unroll
        for (int b = 0; b < 4; ++b)
#pragma unroll
            for (int e = 0; e < 4; ++e) { float v = acc[b][e]; v += __shfl_xor(v, 8); v += __shfl_xor(v, 16); v += __shfl_xor(v, 32); acc[b][e] = v; }
        if (kr == 0) {
#pragma unroll
            for (int b = 0; b < 4; ++b) *(LAS f32x4*)(red + (F.wave * 4 + b) * 32 + 4 * cg) = acc[b]; }
        __syncthreads();
        if (F.tid < 128) { const int b = F.tid >> 5, col = F.tid & 31; float s = b_cond[32 * F.vcu + col];
#pragma unroll
            for (int w = 0; w < 8; ++w) s += red[(w * 4 + b) * 32 + col];
            mod[b * 3 * DM + 32 * F.vcu + col] = s; }
        __syncthreads();
    }
}
__device__ __forceinline__ void p1_weights(Frame& F, const Args& a) {
    LAS float* scr = (LAS float*)(F.lds + RING_OFF + F.wave * 16384);
    const int gw = F.vcu * NWAVES + F.wave, NGW = F.G * NWAVES;
    bf16* wint = (bf16*)(a.ws + WS_WINT); bf16* woutt = (bf16*)(a.ws + WS_WOUTT);
    constexpr int I_IN = (DM / 64) * (NPROJ / 32), I_OUT = (DM / 64) * (DM / 32);
    for (int it = gw; it < I_IN + I_OUT; it += NGW) {
        if (it < I_IN) p0_transpose_item(a.in[4], DM, NPROJ, wint, scr, it, F.lane);
        else p0_transpose_item(a.in[11], DM, DM, woutt, scr, it - I_IN, F.lane);
    }
}
__device__ __forceinline__ void p1_h(Frame& F, const Args& a) {
    const float* x = a.in[0]; const float* mod = (const float*)(a.ws + WS_MOD); bf16* h = (bf16*)(a.ws + WS_H);
    const int gw = F.vcu * NWAVES + F.wave, NGW = F.G * NWAVES;
    for (int blk = gw; blk < T / 16; blk += NGW) {
        const int b = (blk * 16) / SEQ;
        const GAS f32x4* shp = (const GAS f32x4*)(mod + b * 3 * DM) + F.lane; const GAS f32x4* scp = (const GAS f32x4*)(mod + b * 3 * DM + DM) + F.lane;
        f32x4 sh[8], sc[8];
#pragma unroll
        for (int j = 0; j < 8; ++j) { sh[j] = shp[64 * j]; sc[j] = scp[64 * j] + 1.0f; }
        for (int r = 0; r < 16; ++r) { const int m = blk * 16 + r;
            const GAS f32x4* xr = (const GAS f32x4*)(x + (size_t)m * DM) + F.lane;
            f32x4 v[8]; float s = 0.f;
#pragma unroll
            for (int j = 0; j < 8; ++j) { v[j] = __builtin_nontemporal_load(xr + 64 * j); s += (v[j].x * v[j].x + v[j].y * v[j].y) + (v[j].z * v[j].z + v[j].w * v[j].w); }
            const float rs = rsqrtf(wave_sum(s) * (1.f / DM) + EPS);
            GAS unsigned long long* o8 = (GAS unsigned long long*)(h + (size_t)m * DM) + F.lane;
#pragma unroll
            for (int j = 0; j < 8; ++j) { const f32x4 o = v[j] * rs * sc[j] + sh[j];
                o8[64 * j] = (unsigned long long)pk2(o.x, o.y) | ((unsigned long long)pk2(o.z, o.w) << 32); } }
    }
}
__device__ __forceinline__ void lr_tail(Frame& F, const Args& a) {
    const bf16* h = (const bf16*)(a.ws + WS_H); const unsigned char* wl = a.ws + WS_WINT + (size_t)7168 * DM * 2; float* lr = (float*)(a.ws + WS_LR);
    constexpr int WROW = 4096 + 32;
    for (int i = F.tid; i < 32 * 256; i += NWAVES * 64) { const int r = i >> 8, c = i & 255; *(LAS v4u*)(F.lds + r * WROW + c * 16) = *(const GAS v4u*)(wl + (size_t)r * 4096 + c * 16); }
    __syncthreads();
    const int gw = F.vcu * NWAVES + F.wave, NGW = F.G * NWAVES, li = F.lane & 15, g = F.lane >> 4;
    const LAS unsigned char* bp0 = F.lds + li * WROW + g * 16; const LAS unsigned char* bp1 = bp0 + 16 * WROW;
    for (int rb = gw; rb < T / 16; rb += NGW) {
        const bf16* ap = h + (size_t)(rb * 16 + li) * DM + 8 * g;
        f32x4 c0 = (f32x4){0.f, 0.f, 0.f, 0.f}, c1 = c0;
        bf16x8 avA[16], avB[16];
#define LRLOAD(D, kb) do { _Pragma("unroll") for (int i_ = 0; i_ < 16; ++i_) D[i_] = __builtin_nontemporal_load((const GAS bf16x8*)(ap + 32 * (16 * (kb) + i_))); } while (0)
#define LRMMA(D, kb) do { _Pragma("unroll") for (int i_ = 0; i_ < 16; ++i_) { const bf16x8 b0_ = *(const LAS bf16x8*)(bp0 + 64 * (16 * (kb) + i_)), b1_ = *(const LAS bf16x8*)(bp1 + 64 * (16 * (kb) + i_)); \
            c0 = __builtin_amdgcn_mfma_f32_16x16x32_bf16(D[i_], b0_, c0, 0, 0, 0); c1 = __builtin_amdgcn_mfma_f32_16x16x32_bf16(D[i_], b1_, c1, 0, 0, 0); } } while (0)
        LRLOAD(avA, 0); __builtin_amdgcn_sched_barrier(0); LRLOAD(avB, 1); __builtin_amdgcn_sched_barrier(0); LRMMA(avA, 0); __builtin_amdgcn_sched_barrier(0);
        LRLOAD(avA, 2); __builtin_amdgcn_sched_barrier(0); LRMMA(avB, 1); __builtin_amdgcn_sched_barrier(0); LRLOAD(avB, 3); __builtin_amdgcn_sched_barrier(0);
        LRMMA(avA, 2); __builtin_amdgcn_sched_barrier(0); LRMMA(avB, 3); __builtin_amdgcn_sched_barrier(0);
#undef LRLOAD
#undef LRMMA
#pragma unroll
        for (int rg = 0; rg < 4; ++rg) { float* o = lr + (size_t)(rb * 16 + 4 * g + rg) * 32 + li; o[0] = c0[rg]; o[16] = c1[rg]; }
    }
    __syncthreads();
}
__device__ __forceinline__ void unpack8(const v4u w, float (&f)[8]) {
    f[0] = __builtin_bit_cast(float, w.x << 16); f[1] = __builtin_bit_cast(float, w.x & 0xffff0000u); f[2] = __builtin_bit_cast(float, w.y << 16); f[3] = __builtin_bit_cast(float, w.y & 0xffff0000u);
    f[4] = __builtin_bit_cast(float, w.z << 16); f[5] = __builtin_bit_cast(float, w.z & 0xffff0000u); f[6] = __builtin_bit_cast(float, w.w << 16); f[7] = __builtin_bit_cast(float, w.w & 0xffff0000u);
}
__device__ __forceinline__ v4u pack8(const float (&f)[8]) { v4u w; w.x = pk2(f[0], f[1]); w.y = pk2(f[2], f[3]); w.z = pk2(f[4], f[5]); w.w = pk2(f[6], f[7]); return w; }
__device__ __forceinline__ void p5_combine(Frame& F, const Args& a) {
    const bf16* op = (const bf16*)(a.ws + WS_OP); const float* lse = (const float*)(a.ws + WS_LSE); const bf16* sag = (const bf16*)(a.ws + WS_SAG);
    const bf16* of = (const bf16*)(a.ws + WS_OF); const bf16* ob = (const bf16*)(a.ws + WS_OB); const bf16* sgg = (const bf16*)(a.ws + WS_SGG); const float* gain = a.in[9];
    bf16* cat = (bf16*)(a.ws + WS_H);
    const int gw = F.vcu * NWAVES + F.wave, NGW = F.G * NWAVES, lane = F.lane;
    float gn[16];
#pragma unroll
    for (int j = 0; j < 4; ++j) { const f32x4 g = *(const GAS f32x4*)(gain + 16 * lane + 4 * j); gn[4 * j] = g.x; gn[4 * j + 1] = g.y; gn[4 * j + 2] = g.z; gn[4 * j + 3] = g.w; }
    for (int t = gw; t < T; t += NGW) {
        const size_t e = (size_t)t * 1024 + 16 * lane; const int hh = lane >> 2;
        const float l0 = __builtin_nontemporal_load(lse + (size_t)t * 16 + hh), l1 = __builtin_nontemporal_load(lse + (size_t)T * 16 + (size_t)t * 16 + hh), l2 = __builtin_nontemporal_load(lse + (size_t)2 * T * 16 + (size_t)t * 16 + hh);
        const float mx = fmaxf(l0, fmaxf(l1, l2)); float w0 = exp2f(l0 - mx), w1 = exp2f(l1 - mx), w2 = exp2f(l2 - mx); const float wi = 1.f / (w0 + w1 + w2); w0 *= wi; w1 *= wi; w2 *= wi;
#pragma unroll
        for (int hf = 0; hf < 2; ++hf) { float p0[8], p1[8], p2[8], g[8], o[8];
            unpack8(__builtin_nontemporal_load((const GAS v4u*)(op + e + 8 * hf)), p0); unpack8(__builtin_nontemporal_load((const GAS v4u*)(op + (size_t)T * 1024 + e + 8 * hf)), p1); unpack8(__builtin_nontemporal_load((const GAS v4u*)(op + (size_t)2 * T * 1024 + e + 8 * hf)), p2);
            unpack8(__builtin_nontemporal_load((const GAS v4u*)(sag + e + 8 * hf)), g);
#pragma unroll
            for (int i = 0; i < 8; ++i) o[i] = (w0 * p0[i] + w1 * p1[i] + w2 * p2[i]) * g[i];
            *(GAS v4u*)(cat + (size_t)t * 2048 + 16 * lane + 8 * hf) = pack8(o); }
        float xv[16], ss = 0.f;
#pragma unroll
        for (int hf = 0; hf < 2; ++hf) { float f[8], b[8]; unpack8(__builtin_nontemporal_load((const GAS v4u*)(of + e + 8 * hf)), f); unpack8(__builtin_nontemporal_load((const GAS v4u*)(ob + e + 8 * hf)), b);
#pragma unroll
            for (int i = 0; i < 8; ++i) { xv[8 * hf + i] = f[i] + b[i]; ss += xv[8 * hf + i] * xv[8 * hf + i]; } }
        ss += __shfl_xor(ss, 1); ss += __shfl_xor(ss, 2); ss += __shfl_xor(ss, 4); ss += __shfl_xor(ss, 8);
        const float r = rsqrtf(ss * (1.f / 256.f) + EPS);
#pragma unroll
        for (int hf = 0; hf < 2; ++hf) { float g[8], o[8]; unpack8(__builtin_nontemporal_load((const GAS v4u*)(sgg + e + 8 * hf)), g);
#pragma unroll
            for (int i = 0; i < 8; ++i) o[i] = xv[8 * hf + i] * r * gn[8 * hf + i] * g[i];
            *(GAS v4u*)(cat + (size_t)t * 2048 + 1024 + 16 * lane + 8 * hf) = pack8(o); }
    }
}
__device__ __forceinline__ void p7_final(Frame& F, const Args& a) {
    float* out = a.out; const float* x = a.in[0]; const float* fg = a.in[12]; const float* mod = (const float*)(a.ws + WS_MOD); const bf16* Y = (const bf16*)(a.ws + WS_Y);
    const int gw = F.vcu * NWAVES + F.wave, NGW = F.G * NWAVES;
    f32x4 g[8];
#pragma unroll
    for (int j = 0; j < 8; ++j) g[j] = *((const GAS f32x4*)fg + F.lane + 64 * j);
    for (int blk = gw; blk < T / 16; blk += NGW) {
        const int b = (blk * 16) / SEQ;
        f32x4 gt[8];
#pragma unroll
        for (int j = 0; j < 8; ++j) gt[j] = *((const GAS f32x4*)(mod + b * 3 * DM + 2 * DM) + F.lane + 64 * j);
        for (int r = 0; r < 16; ++r) { const int m = blk * 16 + r;
            const GAS f32x4* xr = (const GAS f32x4*)(x + (size_t)m * DM) + F.lane; const GAS v2u* yr = (const GAS v2u*)(Y + (size_t)m * DM) + F.lane;
            f32x4 v[8]; float s = 0.f;
#pragma unroll
            for (int j = 0; j < 8; ++j) { const f32x4 xv = __builtin_nontemporal_load(xr + 64 * j); const v2u yw = __builtin_nontemporal_load(yr + 64 * j);
                const f32x4 yv = (f32x4){__builtin_bit_cast(float, yw.x << 16), __builtin_bit_cast(float, yw.x & 0xffff0000u), __builtin_bit_cast(float, yw.y << 16), __builtin_bit_cast(float, yw.y & 0xffff0000u)};
                v[j] = xv + gt[j] * yv; s += (v[j].x * v[j].x + v[j].y * v[j].y) + (v[j].z * v[j].z + v[j].w * v[j].w); }
            const float rs = rsqrtf(wave_sum(s) * (1.f / DM) + EPS);
            GAS f32x4* orow = (GAS f32x4*)(out + (size_t)m * DM) + F.lane;
#pragma unroll
            for (int j = 0; j < 8; ++j) orow[64 * j] = v[j] * rs * g[j]; }
    }
}

namespace att {
constexpr int KCH = 384 * 16, VDH = 384 * 64, K_OFF = 0, V_OFF = 8 * KCH, VBUF = 2 * VDH, BIAS_OFF = V_OFF + 2 * VBUF, BCOPY = 832, RB_OFF = BIAS_OFF + 4 * BCOPY, ATT_LDS = RB_OFF + 2048;
static_assert(ATT_LDS <= RING_BYTES && (V_OFF % 1024) == 0 && (BIAS_OFF % 16) == 0, "attention LDS map");
constexpr int NUNITS = BATCH * 16 * 3 * 32;
__device__ __forceinline__ int crow(int r, int hi) { return (r & 3) + 8 * (r >> 2) + 4 * hi; }
typedef short v4i16_t __attribute__((ext_vector_type(4)));
__device__ __forceinline__ s16x4 vtr(const LAS unsigned char* p) { return __builtin_bit_cast(s16x4, __builtin_amdgcn_ds_read_tr16_b64_v4i16((LAS v4i16_t*)p)); }
__device__ __forceinline__ unsigned cvtpk(float lo, float hi) { typedef float f2 __attribute__((ext_vector_type(2))); typedef __bf16 b2 __attribute__((ext_vector_type(2))); f2 v = {lo, hi}; b2 b = __builtin_convertvector(v, b2); return __builtin_bit_cast(unsigned, b); }
#define ATT_BAR() asm volatile("s_waitcnt lgkmcnt(0)\n\ts_barrier" ::: "memory")

struct UnitGeo { int b, h, p, d, r, L, m0; unsigned rowb; size_t base; };
__device__ __forceinline__ UnitGeo decode(int uid) {
    UnitGeo u; const int bh = uid / 96, w96 = uid % 96, rs = w96 & 31; u.p = w96 >> 5; u.b = bh >> 4; u.h = bh & 15;
    u.d = (u.p == 0) ? 1 : (u.p == 1 ? 4 : 16);
    u.r = (u.p == 0) ? 0 : (u.p == 1 ? (rs >> 3) : (rs >> 1)); const int seg = (u.p == 0) ? rs : (u.p == 1 ? (rs & 7) : (rs & 1));
    u.L = SEQ / u.d; u.m0 = seg * 256; u.rowb = (unsigned)u.d * 2048u; u.base = ((size_t)u.b * SEQ + u.r) * 2048 + u.h * 128; return u;
}
__device__ __forceinline__ void dma_k(const Args& a, const UnitGeo& u, LAS unsigned char* lds, int wid, int lane) {
    const unsigned char* Kb = a.ws + WS_AK + u.base + (lane >> 3) * 16; const unsigned rowb = u.rowb;
#pragma unroll
    for (int j = 0; j < 6; ++j) { const int blk = wid + 8 * j; int m = u.m0 - 64 + 8 * blk + (lane & 7); m = m < 0 ? 0 : (m > u.L - 1 ? u.L - 1 : m);
        glds16(Kb + (size_t)m * rowb, (unsigned)(size_t)lds + K_OFF + blk * 1024); }
}
__device__ __forceinline__ void dma_v(const Args& a, const UnitGeo& u, LAS unsigned char* lds, int vbuf, int wid, int lane) {
    const unsigned char* Vb = a.ws + WS_AV + u.base + (lane >> 5) * 64 + (lane & 3) * 16; const unsigned rowb = u.rowb;
#pragma unroll
    for (int j = 0; j < 6; ++j) { const int blk = wid + 8 * j; int m = u.m0 - 64 + 8 * blk + ((lane >> 2) & 7); m = m < 0 ? 0 : (m > u.L - 1 ? u.L - 1 : m);
        glds16(Vb + (size_t)m * rowb, (unsigned)(size_t)lds + V_OFF + vbuf * VBUF + blk * 1024); }
}
__device__ __forceinline__ void load_q(bf16x8 (&q)[4], const Args& a, const UnitGeo& u, int wid, int r32, int hi) {
    const unsigned char* Qb = a.ws + WS_AQ + u.base + (size_t)(u.m0 + 32 * wid + r32) * u.rowb + hi * 16;
    asm volatile("global_load_dwordx4 %0, %1, off" : "=&v"(q[0]) : "v"(Qb) : "memory");
    asm volatile("global_load_dwordx4 %0, %1, off offset:32" : "=&v"(q[1]) : "v"(Qb) : "memory");
    asm volatile("global_load_dwordx4 %0, %1, off offset:64" : "=&v"(q[2]) : "v"(Qb) : "memory");
    asm volatile("global_load_dwordx4 %0, %1, off offset:96" : "=&v"(q[3]) : "v"(Qb) : "memory");
}
__device__ __forceinline__ void write_bias(const Args& a, const UnitGeo& u, LAS unsigned char* lds, int tid) {
    for (int e = tid; e < 4 * 192; e += 512) { const int s = e / 192, i = e % 192, sp = i + s - 95;
        *(LAS float*)(lds + BIAS_OFF + s * BCOPY + i * 4) = (sp >= -64 && sp <= 64) ? ((const LAS float*)(lds + RB_OFF))[t5_bucket(sp * u.d) * 16 + u.h] : -1e30f; }
}
#define DECODE(x) decode(unit_of(x))
__device__ __forceinline__ UnitGeo decode_p(int uid, bool contig) { UnitGeo u = decode(uid); if (contig) { u.rowb = 128u; u.base = (size_t)(uid / 96) * SEQ * 128 + (size_t)((uid % 96) >> 5) * 16 * 2048; } return u; }
__device__ __forceinline__ void attn_phase(Frame& F, const Args& a, int c, int ncu, const int knobs = 0) {
    const bool nodma = knobs & 1, nomath = knobs & 2, nostore = knobs & 4, noq = knobs & 16;
    if (c < 0 || c >= ncu) return;
    const bool coop = (ncu == 192);
    const int per = coop ? 32 : (NUNITS + ncu - 1) / ncu, u0 = coop ? 0 : c * per, u1 = coop ? 32 : ((u0 + per < NUNITS) ? u0 + per : NUNITS);
    if (u0 >= u1) return;
    const int cx = c / 24, cj = c % 24;
    auto unit_of = [&](int i) -> int { return coop ? ((8 * cx + (i >> 2)) * 96 + cj + 24 * (i & 3)) : i; };
    LAS unsigned char* lds = F.lds;
    const int tid = F.tid, lane = F.lane, wid = F.wave, r32 = lane & 31, hi = lane >> 5;
    UnitGeo cur = DECODE(u0);
    __builtin_amdgcn_s_waitcnt(0);
    asm volatile("s_waitcnt vmcnt(0) lgkmcnt(0)\n\ts_barrier" ::: "memory");
    ((LAS float*)(lds + RB_OFF))[tid] = a.in[10][tid] * LOG2E;
    asm volatile("s_waitcnt vmcnt(0) lgkmcnt(0)\n\ts_barrier" ::: "memory");
    dma_k(a, cur, lds, wid, lane); dma_v(a, cur, lds, 0, wid, lane); write_bias(a, cur, lds, tid);
    bf16x8 qr[4]; load_q(qr, a, cur, wid, r32, hi);
    int vb = 0;
    float* pl = nullptr; float plv = 0.f; GAS unsigned char* po = nullptr; size_t postep = 0; v4u pov[4] = {};
    const int e31 = 31 - r32;
    const LAS unsigned char* bias_b = lds + BIAS_OFF + (e31 & 3) * BCOPY + ((e31 >> 2) + hi) * 16;
    const LAS unsigned char* kb0 = lds + K_OFF + (4 * wid + (r32 >> 3)) * 1024 + hi * 128 + (r32 & 7) * 16;
    for (int uid = u0; uid < u1; ++uid) {
        asm volatile("s_waitcnt vmcnt(0) lgkmcnt(0)\n\ts_barrier" : "+v"(qr[0]), "+v"(qr[1]), "+v"(qr[2]), "+v"(qr[3]) :: "memory");
        if (uid != u0 && !nostore) {
            if (hi == 0) *pl = plv;
#pragma unroll
            for (int i = 0; i < 4; ++i) *(GAS v4u*)(po + i * postep) = pov[i]; }
        const bool has_next = uid + 1 < u1; UnitGeo nxt = cur;
        if (has_next) { nxt = DECODE(uid + 1); if (!nodma) dma_v(a, nxt, lds, vb ^ 1, wid, lane); }
        const int b = cur.b, h = cur.h, d = cur.d, r = cur.r, L = cur.L, m0 = cur.m0;
        {
        f32x16 pS[5];
#define SB() __builtin_amdgcn_sched_barrier(0)
#define LOADKB(KF, kb) do { _Pragma("unroll") for (int k_ = 0; k_ < 4; ++k_) { const f32x4 t_ = *(const LAS f32x4*)(bias_b + 32 * k_ + 128 * (kb)); pS[kb][4 * k_] = t_.x; pS[kb][4 * k_ + 1] = t_.y; pS[kb][4 * k_ + 2] = t_.z; pS[kb][4 * k_ + 3] = t_.w; } \
                            _Pragma("unroll") for (int d_ = 0; d_ < 4; ++d_) KF[d_] = *(const LAS bf16x8*)(kb0 + d_ * 256 + (kb) * 4096); } while (0)
#define MMAKB(KF, kb) do { _Pragma("unroll") for (int d_ = 0; d_ < 4; ++d_) pS[kb] = __builtin_amdgcn_mfma_f32_32x32x16_bf16(KF[d_], qr[d_], pS[kb], 0, 0, 0); } while (0)
        { bf16x8 ka[4], kc[4];
          LOADKB(ka, 0); SB(); LOADKB(kc, 1); SB(); MMAKB(ka, 0); SB(); LOADKB(ka, 2); SB(); MMAKB(kc, 1); SB(); LOADKB(kc, 3); SB(); MMAKB(ka, 2); SB(); LOADKB(ka, 4); SB(); MMAKB(kc, 3); SB(); MMAKB(ka, 4); SB(); }
#undef LOADKB
#undef MMAKB
        {
        ATT_BAR();
        if (has_next) { if (!nodma) dma_k(a, nxt, lds, wid, lane); if (nxt.p != cur.p || nxt.h != cur.h) write_bias(a, nxt, lds, tid); if (!noq) load_q(qr, a, nxt, wid, r32, hi); }
        }
        const int mb = m0 - 64 + 32 * wid;
        if (mb < 0 || mb + 160 > L) {
            const int mbl = mb + 4 * hi;
#pragma unroll
            for (int kb = 0; kb < 5; ++kb)
#pragma unroll
                for (int rg = 0; rg < 16; ++rg) { const int kr0 = 32 * kb + crow(rg, 0); pS[kb][rg] = ((unsigned)(mbl + kr0) < (unsigned)L) ? pS[kb][rg] : -1e30f; }
        }
        float mx = -1e30f;
#pragma unroll
        for (int kb = 0; kb < 5; ++kb)
#pragma unroll
            for (int rg = 0; rg < 16; rg += 2) mx = fmaxf(fmaxf(mx, pS[kb][rg]), pS[kb][rg + 1]);
        mx = fmaxf(mx, __shfl_xor(mx, 32));
        float l = 0.f;
#pragma unroll
        for (int kb = 0; kb < 5; ++kb)
#pragma unroll
            for (int rg = 0; rg < 16; ++rg) { const float e = __builtin_amdgcn_exp2f(pS[kb][rg] - mx); pS[kb][rg] = e; l += e; }
        l += __shfl_xor(l, 32);
        f32x16 o[2];
        o[0] = (f32x16){0.f, 0.f, 0.f, 0.f, 0.f, 0.f, 0.f, 0.f, 0.f, 0.f, 0.f, 0.f, 0.f, 0.f, 0.f, 0.f}; o[1] = o[0];
        const LAS unsigned char* vb0 = lds + V_OFF + vb * VBUF + (4 * wid) * 1024 + (4 * hi + ((lane & 15) >> 2)) * 64 + ((lane >> 4) & 1) * 32 + (lane & 3) * 8;
#define LOADV(VF, kb) do { _Pragma("unroll") for (int s_ = 0; s_ < 2; ++s_) _Pragma("unroll") for (int d_ = 0; d_ < 2; ++d_) { \
            const s16x4 lo_ = vtr(vb0 + d_ * 512 + (2 * (kb) + s_) * 2048), hh_ = vtr(vb0 + d_ * 512 + (2 * (kb) + s_) * 2048 + 1024); \
            VF[s_ * 2 + d_] = (bf16x8){lo_[0], lo_[1], lo_[2], lo_[3], hh_[0], hh_[1], hh_[2], hh_[3]}; } } while (0)
#define MMAV(VF, kb) do { _Pragma("unroll") for (int s_ = 0; s_ < 2; ++s_) { v4u pw_; pw_.x = cvtpk(pS[kb][8 * s_ + 0], pS[kb][8 * s_ + 1]); pw_.y = cvtpk(pS[kb][8 * s_ + 2], pS[kb][8 * s_ + 3]); \
            pw_.z = cvtpk(pS[kb][8 * s_ + 4], pS[kb][8 * s_ + 5]); pw_.w = cvtpk(pS[kb][8 * s_ + 6], pS[kb][8 * s_ + 7]); const bf16x8 pa_ = __builtin_bit_cast(bf16x8, pw_); \
            _Pragma("unroll") for (int d_ = 0; d_ < 2; ++d_) o[d_] = __builtin_amdgcn_mfma_f32_32x32x16_bf16(VF[s_ * 2 + d_], pa_, o[d_], 0, 0, 0); } } while (0)
        { bf16x8 va[4], vc[4];
          LOADV(va, 0); SB(); LOADV(vc, 1); SB(); MMAV(va, 0); SB(); LOADV(va, 2); SB(); MMAV(vc, 1); SB(); LOADV(vc, 3); SB(); MMAV(va, 2); SB(); LOADV(va, 4); SB(); MMAV(vc, 3); SB(); MMAV(va, 4); SB(); }
#undef LOADV
#undef MMAV
#undef SB
        const float li = 1.f / l;
        const size_t tq = (size_t)b * SEQ + (size_t)(m0 + 32 * wid + r32) * d + r;
        {
        pl = (float*)(a.ws + WS_LSE) + (size_t)cur.p * T * 16 + tq * 16 + h; plv = mx + __builtin_amdgcn_logf(l);
        ATT_BAR();
        LAS unsigned char* stg = lds + V_OFF + vb * VBUF + wid * (32 * 144);
#pragma unroll
        for (int d0 = 0; d0 < 2; ++d0)
#pragma unroll
            for (int k = 0; k < 4; ++k)
                *(LAS v2u*)(stg + r32 * 144 + (32 * d0 + 8 * k + 4 * hi) * 2) = (v2u){cvtpk(o[d0][4 * k] * li, o[d0][4 * k + 1] * li), cvtpk(o[d0][4 * k + 2] * li, o[d0][4 * k + 3] * li)};
        LDS_WAIT();
        { const int row = lane >> 3, ch = lane & 7;
          po = (GAS unsigned char*)(a.ws + WS_OP) + ((size_t)cur.p * T + (size_t)b * SEQ + (size_t)(m0 + 32 * wid + row) * d + r) * 2048 + h * 128 + ch * 16; postep = (size_t)8 * d * 2048;
#pragma unroll
          for (int i = 0; i < 4; ++i) pov[i] = *(const LAS v4u*)(stg + (row + 8 * i) * 144 + ch * 16); }
        LDS_WAIT();
        }
        }
        vb ^= 1; cur = nxt;
    }
    { if (hi == 0) *pl = plv;
#pragma unroll
        for (int i = 0; i < 4; ++i) *(GAS v4u*)(po + i * postep) = pov[i]; }
    asm volatile("s_waitcnt vmcnt(0) lgkmcnt(0)\n\ts_barrier" ::: "memory");
}
#undef ATT_BAR
}
namespace gla {
constexpr int PACK_QK = 32768, PACK_ATT = 9216;
constexpr float DKS = 0.08838834764831845f;
__device__ __forceinline__ unsigned cvtpk(float lo, float hi) { typedef float f2 __attribute__((ext_vector_type(2))); typedef __bf16 b2 __attribute__((ext_vector_type(2))); f2 v = {lo, hi}; b2 b = __builtin_convertvector(v, b2); return __builtin_bit_cast(unsigned, b); }
__device__ __forceinline__ int idx32(int g, int jj) { return 16 * (jj >> 2) + 4 * g + (jj & 3); }
__device__ __forceinline__ float fexp(float x) { return __builtin_amdgcn_exp2f(x * LOG2E); }
__device__ __forceinline__ float logsig16(float x) { return (fminf(x, 0.f) - __builtin_amdgcn_logf(1.f + fexp(-fabsf(x))) * 0.6931471805599453f) * (1.f / 16.f); }
typedef short v4i16_t __attribute__((ext_vector_type(4)));
__device__ __forceinline__ s16x4 vtr(const LAS unsigned char* p) { return __builtin_bit_cast(s16x4, __builtin_amdgcn_ds_read_tr16_b64_v4i16((LAS v4i16_t*)p)); }
constexpr int ROWB = 272  , GROW = 136  ;
constexpr int LRROW = 36  ;
constexpr int L_QT = 0, L_KT = 64 * ROWB, L_LR = 2 * 64 * ROWB, L_G = L_LR + 64 * LRROW * 4, L_GT = L_G + 2 * 64 * GROW * 4, L_TOT = L_GT + 4096, L_KBM = L_TOT + 1024  , L_PREP_END = L_KBM + 32768;
static_assert(L_PREP_END <= RING_BYTES, "prep LDS map");

__device__ __forceinline__ void prep_unit(Frame& F, const Args& a, int uid, const int knobs = 0) {
    const int b = uid >> 9, h = (uid >> 7) & 3, n = uid & 127; const size_t t0 = (size_t)b * SEQ + 64 * n;
    const bf16* gq = (const bf16*)(a.ws + WS_GQ); const bf16* gk = (const bf16*)(a.ws + WS_GK); const float* lr = (const float*)(a.ws + WS_LR);
    LAS unsigned char* lds = F.lds; const int tid = F.tid, lane = F.lane, wid = F.wave;
    float upb[2][4], bsv[2];
#pragma unroll
    for (int dir = 0; dir < 2; ++dir) { const float* up = a.in[dir ? 7 : 5] + h * 128 + 16 * wid + (lane & 15); bsv[dir] = a.in[dir ? 8 : 6][h * 128 + 16 * wid + (lane & 15)];
#pragma unroll
        for (int ks = 0; ks < 4; ++ks) upb[dir][ks] = up[(4 * ks + (lane >> 4)) * 512]; }
#pragma unroll
    for (int i = 0; i < 2; ++i) { const int pid = tid + 512 * i, row = pid >> 4, c16 = pid & 15; const size_t off = (t0 + row) * 512 + h * 128 + c16 * 8;
        *(LAS v4u*)(lds + L_QT + row * ROWB + c16 * 16) = __builtin_nontemporal_load((const GAS v4u*)(gq + off)); *(LAS v4u*)(lds + L_KT + row * ROWB + c16 * 16) = __builtin_nontemporal_load((const GAS v4u*)(gk + off)); }
    { const int row = tid >> 3, c16 = tid & 7; *(LAS v4u*)(lds + L_LR + row * (LRROW * 4) + c16 * 16) = __builtin_nontemporal_load((const GAS v4u*)(lr + (t0 + row) * 32 + c16 * 4)); }
    __syncthreads();
    LAS float* G = (LAS float*)(lds + L_G); LAS float* TOT = (LAS float*)(lds + L_TOT); const LAS float* LR = (const LAS float*)(lds + L_LR);
    if (!(knobs & 1)) { const int li2 = lane & 15, g2 = lane >> 4, c = 16 * wid + li2;
#pragma unroll
      for (int dir = 0; dir < 2; ++dir) { f32x4 gl[4];
#pragma unroll
          for (int mt = 0; mt < 4; ++mt) { f32x4 acc = (f32x4){0.f, 0.f, 0.f, 0.f};
#pragma unroll
              for (int ks = 0; ks < 4; ++ks) acc = __builtin_amdgcn_mfma_f32_16x16x4f32(LR[(16 * mt + li2) * LRROW + dir * 16 + 4 * ks + g2], upb[dir][ks], acc, 0, 0, 0);
#pragma unroll
              for (int rg = 0; rg < 4; ++rg) gl[mt][rg] = logsig16(acc[rg] + bsv[dir]); }
          float off = 0.f;
#pragma unroll
          for (int m2 = 0; m2 < 4; ++m2) { const int mt = dir ? 3 - m2 : m2; f32x4 p; float t;
              if (!dir) { p[0] = gl[mt][0]; p[1] = p[0] + gl[mt][1]; p[2] = p[1] + gl[mt][2]; p[3] = p[2] + gl[mt][3]; t = p[3]; }
              else      { p[3] = gl[mt][3]; p[2] = p[3] + gl[mt][2]; p[1] = p[2] + gl[mt][1]; p[0] = p[1] + gl[mt][0]; t = p[0]; }
              float sc = t, u;
              if (!dir) { u = __shfl_up(sc, 16); if (g2 >= 1) sc += u; u = __shfl_up(sc, 32); if (g2 >= 2) sc += u; }
              else      { u = __shfl_down(sc, 16); if (g2 <= 2) sc += u; u = __shfl_down(sc, 32); if (g2 <= 1) sc += u; }
              const float add = sc - t + off;
#pragma unroll
              for (int rg = 0; rg < 4; ++rg) G[(dir * 64 + 16 * mt + 4 * g2 + rg) * GROW + c] = p[rg] + add;
              off += __shfl(sc, (dir ? 0 : 48) + li2); }
          if (g2 == 0) TOT[dir * 128 + c] = off; } }
    __syncthreads();
    if (knobs & 2) { __syncthreads(); return; }
    const int dir = wid >> 2, it = wid & 3, li = lane & 15, g = lane >> 4;
    const int cid = ((b * 4 + h) * 2 + dir) * 128 + n;
    unsigned char* qk_pack = a.ws + WS_H + (size_t)cid * PACK_QK; unsigned char* att_pack = a.ws + WS_ATT + (size_t)cid * PACK_ATT;
    const LAS float* Gd = G + dir * 64 * GROW;
    auto frag = [&](int tile_off, int row, int ks, float sgn, float mul) -> bf16x8 {
        float v[8];
#pragma unroll
        for (int hf = 0; hf < 2; ++hf) { const int c = 32 * ks + 16 * hf + 4 * g;
            const v2u xw = *(const LAS v2u*)(lds + tile_off + row * ROWB + c * 2); const f32x4 bb = *(const LAS f32x4*)(Gd + row * GROW + c);
            v[4 * hf + 0] = __builtin_bit_cast(float, xw.x << 16) * fexp(sgn * bb.x) * mul; v[4 * hf + 1] = __builtin_bit_cast(float, xw.x & 0xffff0000u) * fexp(sgn * bb.y) * mul;
            v[4 * hf + 2] = __builtin_bit_cast(float, xw.y << 16) * fexp(sgn * bb.z) * mul; v[4 * hf + 3] = __builtin_bit_cast(float, xw.y & 0xffff0000u) * fexp(sgn * bb.w) * mul; }
        v4u w; w.x = cvtpk(v[0], v[1]); w.y = cvtpk(v[2], v[3]); w.z = cvtpk(v[4], v[5]); w.w = cvtpk(v[6], v[7]); return __builtin_bit_cast(bf16x8, w); };
    bf16x8 qf[4];
#pragma unroll
    for (int ks = 0; ks < 4; ++ks) { qf[ks] = frag(L_QT, 16 * it + li, ks, 1.f, DKS); __builtin_nontemporal_store((v4u)(__builtin_bit_cast(v4u, qf[ks])), (GAS v4u*)(qk_pack + ((it * 4 + ks) * 64 + lane) * 16)); }
#pragma unroll
    for (int ks = 0; ks < 4; ++ks) *(LAS v4u*)(lds + L_KBM + (((dir * 4 + it) * 4 + ks) * 64 + lane) * 16) = __builtin_bit_cast(v4u, frag(L_KT, 16 * it + li, ks, -1.f, 1.f));
    __syncthreads();
    f32x4 at[4];
#pragma unroll
    for (int jt = 0; jt < 4; ++jt) { at[jt] = (f32x4){0.f, 0.f, 0.f, 0.f};
#pragma unroll
        for (int ks = 0; ks < 4; ++ks) { const bf16x8 kf = *(const LAS bf16x8*)(lds + L_KBM + (((dir * 4 + jt) * 4 + ks) * 64 + lane) * 16); at[jt] = __builtin_amdgcn_mfma_f32_16x16x32_bf16(kf, qf[ks], at[jt], 0, 0, 0); }
#pragma unroll
        for (int rg = 0; rg < 4; ++rg) { const int j = 16 * jt + 4 * g + rg, i = 16 * it + li; const bool keep = dir ? (j >= i) : (j <= i); at[jt][rg] = keep ? at[jt][rg] : 0.f; } }
#pragma unroll
    for (int ks2 = 0; ks2 < 2; ++ks2) { v4u w; w.x = cvtpk(at[2 * ks2][0], at[2 * ks2][1]); w.y = cvtpk(at[2 * ks2][2], at[2 * ks2][3]); w.z = cvtpk(at[2 * ks2 + 1][0], at[2 * ks2 + 1][1]); w.w = cvtpk(at[2 * ks2 + 1][2], at[2 * ks2 + 1][3]);
        __builtin_nontemporal_store((v4u)(w), (GAS v4u*)(att_pack + ((it * 2 + ks2) * 64 + lane) * 16)); }
#pragma unroll
    for (int q2 = 0; q2 < 4; ++q2) { const int ct = 2 * it + (q2 >> 1), ks2 = q2 & 1, c = 16 * ct + li; const float te = TOT[dir * 128 + c]; float v[8];
#pragma unroll
        for (int jj = 0; jj < 8; ++jj) { const int j = 32 * ks2 + idx32(g, jj); const float kx = bf2f(*(const LAS bf16*)(lds + L_KT + j * ROWB + c * 2)); v[jj] = kx * fexp(te - Gd[j * GROW + c]); }
        v4u w; w.x = cvtpk(v[0], v[1]); w.y = cvtpk(v[2], v[3]); w.z = cvtpk(v[4], v[5]); w.w = cvtpk(v[6], v[7]);
        __builtin_nontemporal_store((v4u)(w), (GAS v4u*)(qk_pack + 16384 + ((ct * 2 + ks2) * 64 + lane) * 16)); }
    if (tid < 256) { const int d2 = tid >> 7, c = tid & 127; *(float*)(a.ws + WS_ATT + (size_t)(((b * 4 + h) * 2 + d2) * 128 + n) * PACK_ATT + 8192 + c * 4) = fexp(TOT[d2 * 128 + c]); }
    __syncthreads();
}
__device__ __forceinline__ void prep_phase(Frame& F, const Args& a, int set, int c, int ncu, const int knobs = 0) {
    for (int u = c; u < 1024; u += ncu) { const int nn = u & 63, n = set == 0 ? (nn < 32 ? nn : 64 + nn) : 32 + nn; prep_unit(F, a, ((u >> 6) << 7) | n, knobs); }
}

constexpr int S_ATT = 0, S_DEC = 8192, S_QK = 9216, S_V = 9216 + 32768, S_BUF = S_V + 16384;
constexpr int S_O = 2 * S_BUF, OROW = 272, S_OT = 64 * OROW;
static_assert(S_O + 2 * S_OT <= RING_BYTES && (S_BUF % 1024) == 0, "scan LDS map");
template <class MidFn> __device__ __forceinline__ void scan_unit(Frame& F, const Args& a, int su, const MidFn& mid, const int knobs = 0) {
    const bool nodma = knobs & 1, nomath = knobs & 2, nostore = knobs & 4;
    const int bh = su >> 2, dir = (su >> 1) & 1, half = su & 1, b = bh >> 2, h = bh & 3;
    const int cid0 = ((b * 4 + h) * 2 + dir) * 128;
    LAS unsigned char* lds = F.lds; const int tid = F.tid, lane = F.lane, wid = F.wave, li = lane & 15, g = lane >> 4;
    const unsigned char* gvb = a.ws + WS_GV + (size_t)b * SEQ * 2048 + h * 512 + half * 256;
    unsigned char* ob = a.ws + (dir ? WS_OB : WS_OF) + (size_t)b * SEQ * 2048 + h * 512 + half * 256 + (size_t)(tid >> 4) * 2048 + (tid & 15) * 16;
    const int ow = (16 * wid + 4 * g) * 2 + li * OROW;
    const unsigned lds0 = (unsigned)(size_t)lds;
    int pk[8]; unsigned pvo[8], plo[8];
#pragma unroll
    for (int j = 0; j < 8; ++j) { const int p = wid + 8 * j;
        if (p < 9) { pk[j] = 0; pvo[j] = p * 1024 + lane * 16; plo[j] = S_ATT + p * 1024; }
        else if (p < 41) { pk[j] = 1; pvo[j] = (p - 9) * 1024 + lane * 16; plo[j] = S_QK + (p - 9) * 1024; }
        else if (p < 57) { const int pv = p - 41, row = 4 * pv + (lane >> 4), c = (lane & 15) ^ (2 * (row & 7)); pk[j] = 2; pvo[j] = row * 2048 + c * 16; plo[j] = S_V + pv * 1024; }
        else { pk[j] = 3; pvo[j] = 0; plo[j] = 0; } }
    auto issue = [&](int n, int bufoff) {
        const int cid = cid0 + n; const unsigned char* b0 = a.ws + WS_ATT + (size_t)cid * PACK_ATT; const unsigned char* b1 = a.ws + WS_H + (size_t)cid * PACK_QK; const unsigned char* b2 = gvb + (size_t)(64 * n) * 2048;
#pragma unroll
        for (int j = 0; j < 8; ++j) { if (pk[j] == 2) glds16s<true>(b2, pvo[j], lds0 + bufoff + plo[j]);
            else if (pk[j] != 3) glds16s<false>(pk[j] == 0 ? b0 : b1, pvo[j], lds0 + bufoff + plo[j]); }
    };
    f32x4 S[8];
#pragma unroll
    for (int ct = 0; ct < 8; ++ct) S[ct] = (f32x4){0.f, 0.f, 0.f, 0.f};
    const int vq = li >> 2, vp = li & 3;
    const int voff = (4 * g + vq) * 256 + (((2 * wid + (vp >> 1)) ^ (2 * ((4 * (g & 1) + vq)))) * 16) + 8 * (vp & 1);
    __builtin_amdgcn_s_waitcnt(0);
    auto step = [&](int s, int sb, int se) __attribute__((always_inline)) {
        const int n = dir ? 127 - s : s; const int bufoff = (s & 1) * S_BUF;
        if (!nostore && s > sb) { unsigned char* op = ob + (size_t)(64 * (dir ? n + 1 : n - 1)) * 2048; const LAS unsigned char* ot = lds + S_O + ((s - 1) & 1) * S_OT + (tid >> 4) * OROW + (tid & 15) * 16;
#pragma unroll
          for (int p = 0; p < 2; ++p) *(GAS v4u*)(op + (size_t)(32 * p) * 2048) = *(const LAS v4u*)(ot + 32 * p * OROW); }
        if (s + 1 < se && !nodma) issue(dir ? 126 - s : s + 1, S_BUF - bufoff);
        const LAS unsigned char* B = lds + bufoff;
        if (!nomath) {
        bf16x8 vf[2];
#pragma unroll
        for (int ks2 = 0; ks2 < 2; ++ks2) { const s16x4 lo = vtr(B + S_V + voff + ks2 * 8192), hh = vtr(B + S_V + voff + ks2 * 8192 + 4096); vf[ks2] = (bf16x8){lo[0], lo[1], lo[2], lo[3], hh[0], hh[1], hh[2], hh[3]}; }
        bf16x8 sf[4];
#pragma unroll
        for (int ks = 0; ks < 4; ++ks) { v4u w; w.x = cvtpk(S[2 * ks][0], S[2 * ks][1]); w.y = cvtpk(S[2 * ks][2], S[2 * ks][3]); w.z = cvtpk(S[2 * ks + 1][0], S[2 * ks + 1][1]); w.w = cvtpk(S[2 * ks + 1][2], S[2 * ks + 1][3]); sf[ks] = __builtin_bit_cast(bf16x8, w); }
#define SB() __builtin_amdgcn_sched_barrier(0)
#define LOADO(D, mt) do { _Pragma("unroll") for (int k_ = 0; k_ < 4; ++k_) D[k_] = *(const LAS bf16x8*)(B + S_QK + (((mt) * 4 + k_) * 64 + lane) * 16); \
                          _Pragma("unroll") for (int k_ = 0; k_ < 2; ++k_) D[4 + k_] = *(const LAS bf16x8*)(B + S_ATT + (((mt) * 2 + k_) * 64 + lane) * 16); } while (0)
#define MMAO(D, mt) do { f32x4 o_ = (f32x4){0.f, 0.f, 0.f, 0.f}; _Pragma("unroll") for (int k_ = 0; k_ < 4; ++k_) o_ = __builtin_amdgcn_mfma_f32_16x16x32_bf16(sf[k_], D[k_], o_, 0, 0, 0); \
                         _Pragma("unroll") for (int k_ = 0; k_ < 2; ++k_) o_ = __builtin_amdgcn_mfma_f32_16x16x32_bf16(vf[k_], D[4 + k_], o_, 0, 0, 0); *(LAS v2u*)(otile + (16 * (mt)) * OROW) = (v2u){cvtpk(o_[0], o_[1]), cvtpk(o_[2], o_[3])}; } while (0)
#define LOADS(D, V, c2) do { _Pragma("unroll") for (int k_ = 0; k_ < 4; ++k_) D[k_] = *(const LAS bf16x8*)(B + S_QK + 16384 + (((c2) * 4 + k_) * 64 + lane) * 16); \
                             V[0] = *(const LAS f32x4*)(B + S_DEC + (32 * (c2) + 4 * g) * 4); V[1] = *(const LAS f32x4*)(B + S_DEC + (32 * (c2) + 16 + 4 * g) * 4); } while (0)
#define MMAS(D, V, c2) do { _Pragma("unroll") for (int t_ = 0; t_ < 2; ++t_) { S[2 * (c2) + t_] = S[2 * (c2) + t_] * V[t_]; \
                            _Pragma("unroll") for (int k_ = 0; k_ < 2; ++k_) S[2 * (c2) + t_] = __builtin_amdgcn_mfma_f32_16x16x32_bf16(D[2 * t_ + k_], vf[k_], S[2 * (c2) + t_], 0, 0, 0); } } while (0)
        LAS unsigned char* otile = lds + S_O + (s & 1) * S_OT + ow;
        bf16x8 fa[6], fb[6]; f32x4 da[2], db[2];
        LOADO(fa, 0); SB(); LOADO(fb, 1); SB(); MMAO(fa, 0); SB(); LOADO(fa, 2); SB(); MMAO(fb, 1); SB(); LOADO(fb, 3); SB(); MMAO(fa, 2); SB();
        LOADS(fa, da, 0); SB(); MMAO(fb, 3); SB(); LOADS(fb, db, 1); SB(); MMAS(fa, da, 0); SB(); LOADS(fa, da, 2); SB(); MMAS(fb, db, 1); SB(); LOADS(fb, db, 3); SB(); MMAS(fa, da, 2); SB(); MMAS(fb, db, 3); SB();
#undef LOADO
#undef MMAO
#undef LOADS
#undef MMAS
#undef SB
        }
        asm volatile("s_waitcnt vmcnt(0) lgkmcnt(0)\n\ts_barrier" ::: "memory");
    };
    for (int seg = 0; seg < 2; ++seg) { const int sb = seg ? 32 : 0, se = seg ? 128 : 32;
        asm volatile("s_waitcnt vmcnt(0) lgkmcnt(0)\n\ts_barrier" ::: "memory");
        issue(dir ? 127 - sb : sb, (sb & 1) * S_BUF);
        asm volatile("s_waitcnt vmcnt(0) lgkmcnt(0)\n\ts_barrier" ::: "memory");
        for (int s = sb; s < se; ++s) step(s, sb, se);
        if (!nostore) { unsigned char* op = ob + (size_t)(64 * (dir ? 128 - se : se - 1)) * 2048; const LAS unsigned char* ot = lds + S_O + ((se - 1) & 1) * S_OT + (tid >> 4) * OROW + (tid & 15) * 16;
#pragma unroll
          for (int p = 0; p < 2; ++p) *(GAS v4u*)(op + (size_t)(32 * p) * 2048) = *(const LAS v4u*)(ot + 32 * p * OROW); }
        asm volatile("s_waitcnt vmcnt(0)" ::: "memory");
        if (seg == 0) mid();
    }
}
}
__global__ void __launch_bounds__(NWAVES * 64, 2) mega(Args args) {
    extern __shared__ __attribute__((aligned(16))) unsigned char lds[];
    Frame F;
    F.lds = (LAS unsigned char*)lds; F.MISC = (volatile LAS unsigned*)(F.lds + MISC_OFF);
    F.tid = threadIdx.x; F.lane = F.tid & 63; F.wave = __builtin_amdgcn_readfirstlane(F.tid >> 6);
    F.G = gridDim.x; { const int bx = blockIdx.x; F.vcu = (F.G % 8 == 0) ? (bx % 8) * (F.G / 8) + bx / 8 : bx; }
    unsigned char* ws = args.ws;
    F.ctl = (gu32*)(ws + WS_CTL);
    for (int u = F.tid; u < (LDS_BYTES - LDSCTL_OFF) / 4; u += NWAVES * 64) ((LAS unsigned*)(F.lds + LDSCTL_OFF))[u] = 0u;
    __syncthreads();
    XcdBarrier bar = xcd_barrier_post((unsigned*)(F.ctl + CW_BAR) + args.li * XCD_BAR_WORDS, F.MISC + 8);
    const int lo = args.ph_lo, hi = args.ph_hi;
#define IN(k) (lo <= (k) && (k) < hi)
#define BOTH(k) (IN(k) && IN((k) + 1))
    ProjOut P{(bf16*)(ws + WS_AQ), (bf16*)(ws + WS_AK), (bf16*)(ws + WS_AV), (bf16*)(ws + WS_SAG), (bf16*)(ws + WS_GQ), (bf16*)(ws + WS_GK), (bf16*)(ws + WS_GV), (bf16*)(ws + WS_SGG), (float*)(ws + WS_LR)};
    if (IN(0)) { p0_mod(F, args); if (BOTH(0)) xcd_barrier(bar); }
    if (IN(1)) { p1_h(F, args); p1_weights(F, args); if (BOTH(1)) xcd_barrier(bar); }
    if (IN(2)) {
        pg8::Gemm g{(const bf16*)(ws + WS_H), (const bf16*)(ws + WS_WINT), T, 7168, DM}; pg8::StaticOrder S; S.init(T, 7168, F.G, (int)blockIdx.x);
#ifdef PROBE_G2
        S.reps = 2;
#endif
        pg8::EpiProj E{P};
        pg8::gemm_phase<pg8::EpiProj, pg8::StaticOrder, true, true>(F.lds + RING_OFF, g, S, E);
        lr_tail(F, args);
        if (BOTH(2)) xcd_barrier(bar);
    }
    if (IN(3)) {
#ifdef PROBE_P
        { int q = F.vcu; asm volatile("" : "+s"(q)); gla::prep_phase(F, args, 0, q, F.G, PROBE_P); }
#endif
        gla::prep_phase(F, args, 0, F.vcu, F.G); if (BOTH(3)) xcd_barrier(bar); }
    if (IN(4)) {
        const int ac = (F.vcu >> 2) * 3 + (F.vcu & 3) - 1, anc = (F.G >> 2) * 3;
#ifdef PROBE_S
        if ((F.vcu & 3) == 0) { int q = F.vcu >> 2; asm volatile("" : "+s"(q)); gla::scan_unit(F, args, q, [&]() {}, PROBE_S); }
#endif
        if ((F.vcu & 3) == 0) gla::scan_unit(F, args, F.vcu >> 2, [&]() { xcd_barrier(bar); });
        else { gla::prep_phase(F, args, 1, ac, anc); xcd_barrier(bar);
#ifdef PROBE_A2
            { int q = ac; asm volatile("" : "+s"(q)); att::attn_phase(F, args, q, anc, PROBE_A2); }
#endif
            att::attn_phase(F, args, ac, anc);
        }
        if (BOTH(4)) xcd_barrier(bar); }
    if (IN(5)) { p5_combine(F, args); if (BOTH(5)) xcd_barrier(bar); }
    if (IN(6)) {
        pg8::Gemm g{(const bf16*)(ws + WS_H), (const bf16*)(ws + WS_WOUTT), T, DM, DM}; pg8::StaticOrder S; S.init(T, DM, F.G, (int)blockIdx.x);
#ifdef PROBE_G6
        S.reps = 2;
#endif
        pg8::EpiY E{(bf16*)(ws + WS_Y)};
        pg8::gemm_phase<pg8::EpiY, pg8::StaticOrder, true, true>(F.lds + RING_OFF, g, S, E);
        if (BOTH(6)) xcd_barrier(bar);
    }
    if (IN(7)) { p7_final(F, args); }
#undef IN
#undef BOTH
}
extern "C" void kernel_launch(void* const* d_in, const int* in_sizes, int n_in, void* d_out, int out_size, void* d_ws, size_t ws_size, hipStream_t stream) {
    static int grid = 0;
    if (grid == 0) {
        if (n_in != 13 || ws_size < WS_END || out_size != T * DM) { fprintf(stderr, "kernel_launch: unexpected problem (n_in %d, ws %zu, out %d)\n", n_in, ws_size, out_size); grid = -1; return; }
        int dev = 0, cus = 0, per_cu = 0;
        if (hipGetDevice(&dev) != hipSuccess || hipDeviceGetAttribute(&cus, hipDeviceAttributeMultiprocessorCount, dev) != hipSuccess) { grid = -1; return; }
        if (hipFuncSetAttribute((const void*)mega, hipFuncAttributeMaxDynamicSharedMemorySize, LDS_BYTES) != hipSuccess) { fprintf(stderr, "kernel_launch: hipFuncSetAttribute failed\n"); grid = -1; return; }
        if (hipOccupancyMaxActiveBlocksPerMultiprocessor(&per_cu, (const void*)mega, NWAVES * 64, LDS_BYTES) != hipSuccess || per_cu < 1) { fprintf(stderr, "kernel_launch: occupancy query says %d\n", per_cu); }
        (void)hipGetLastError();
        grid = cus;
    }
    if (grid < 0) return;
    (void)hipMemsetAsync((char*)d_ws + WS_CTL, 0, CTL_ZERO_BYTES, stream);
    Args a{};
    for (int i = 0; i < 13; ++i) a.in[i] = (const float*)d_in[i];
    a.out = (float*)d_out; a.ws = (unsigned char*)d_ws;
    unsigned char* ws = (unsigned char*)d_ws;
#ifndef PROBE_DUP
#define PROBE_DUP -1
#endif
#ifndef PROBE_REPS
#define PROBE_REPS 2
#endif
#ifndef PROBE_SUB
#define PROBE_SUB 2
#endif
    a.ph_lo = 0; a.ph_hi = 8; a.li = 0; a.dup_phase = PROBE_DUP; a.dup_reps = PROBE_REPS; a.dup_sub = PROBE_SUB;
    hipLaunchKernelGGL(mega, dim3(grid), dim3(NWAVES * 64), LDS_BYTES, stream, a);
}
```

```cpp
#include <hip/hip_runtime.h>
#include <stdint.h>
#include <cstdio>
#include <type_traits>

typedef unsigned short bf16;
constexpr int BATCH = 4, SEQ = 8192, DM = 2048, T = BATCH * SEQ;
constexpr int NPROJ = 7200, NPAD = 7424;
constexpr float EPS = 1e-6f;
constexpr float LOG2E = 1.4426950408889634f;
constexpr float C2 = 0.125f * LOG2E;
constexpr size_t MiB = 1u << 20;
constexpr size_t WS_CTL = 0, CTL_ZERO_BYTES = 384 * 1024  , WS_MOD = 1 * MiB, WS_SSP = 1 * MiB + 512 * 1024  , WS_WINT = 2 * MiB, WS_WOUTT = 32 * MiB,
                 WS_H = 40 * MiB  ,
                 WS_AQ = 168 * MiB, WS_AK = 232 * MiB, WS_AV = 296 * MiB, WS_SAG = 360 * MiB, WS_GQ = 424 * MiB, WS_GK = 456 * MiB, WS_GV = 488 * MiB,
                 WS_SGG = 552 * MiB, WS_LR = 616 * MiB, WS_OP = 620 * MiB  , WS_LSE = 812 * MiB  , WS_OF = 818 * MiB, WS_OB = 882 * MiB,
                 WS_SS = 946 * MiB  , WS_ATT = 950 * MiB  ,
                 WS_Y = WS_AQ  ,
                 WS_END = 986 * MiB;

__device__ __forceinline__ unsigned f2bf(float f) { unsigned u = __builtin_bit_cast(unsigned, f); return (u + 0x7fffu + ((u >> 16) & 1u)) >> 16; }
__device__ __forceinline__ unsigned pk2(float lo, float hi) { typedef float f2_ __attribute__((ext_vector_type(2))); typedef __bf16 b2_ __attribute__((ext_vector_type(2))); f2_ v = {lo, hi}; b2_ b = __builtin_convertvector(v, b2_); return __builtin_bit_cast(unsigned, b); }
__device__ __forceinline__ float bf2f(bf16 h) { return __builtin_bit_cast(float, (unsigned)h << 16); }
__device__ __forceinline__ float silu_f(float x) { return x / (1.f + __expf(-x)); }
__device__ __forceinline__ float log_sigmoid_f(float x) { return fminf(x, 0.f) - log1pf(__expf(-fabsf(x))); }
__device__ __forceinline__ int t5_bucket(int rel) {
    const int n = rel < 0 ? -rel : rel;
    int v;
    if (n < 8) v = n;
    else v = 8 + (n >= 15) + (n >= 27) + (n >= 50) + (n >= 91) + (n >= 166) + (n >= 305) + (n >= 559);
    return (rel > 0 ? 16 : 0) + v;
}
struct ProjOut { bf16 *aq, *ak, *av, *sag, *gq, *gk, *gv, *sgg; float* lr; };
namespace pg8 {
#define PG8_LAS __attribute__((address_space(3)))
typedef unsigned short bf16_t;
typedef short bf16x8 __attribute__((ext_vector_type(8)));
typedef float f32x4 __attribute__((ext_vector_type(4)));
typedef unsigned u32x4 __attribute__((ext_vector_type(4)));
constexpr int BM = 256, BK = 64, HALF = 128, HTB = HALF * BK * 2  , STAGE_BYTES = 8 * HTB, NXCD = 8, WGM = 8;

__host__ __device__ __forceinline__ int lds_byte(int r, int c) { const int st = (r >> 4) * 2 + (c >> 5), rr = r & 15, cc = c & 31, ob = rr * 64 + cc * 2; return st * 1024 + (ob ^ (((ob >> 9) & 1) << 5)); }
__host__ __device__ __forceinline__ void stage_rc(int b, int& R, int& C) { const int st = b / 1024, sb = b % 1024, swz = sb ^ (((sb >> 9) & 1) << 5); R = (st >> 1) * 16 + swz / 64; C = (st & 1) * 32 + (swz % 64) / 2; }
__host__ __device__ __forceinline__ int perm32(int rho) { const int n = rho >> 4, i = rho & 15; return 8 * (i >> 2) + 4 * n + (i & 3); }

struct Unit { int pm, pn; };
struct Gemm { const bf16_t* A; const bf16_t* Bt; int M, N, K; };

struct StaticOrder {
    int nM, nN, nwg, G, c, reps, wgm;
    __host__ __device__ void init(int M, int N, int G_, int c_) { nM = M / BM; nN = N / BM; nwg = nM * nN; G = G_; c = c_; reps = 1; wgm = WGM; }
    __host__ __device__ bool next(int i, Unit& u) const {
        const long L = (long)i * G + c; if (L >= (long)nwg * reps) return false;
        int wgid = (int)(L % nwg); { const int q = nwg / NXCD, r = nwg % NXCD, xcd = wgid % NXCD, off = wgid / NXCD; wgid = (xcd < r ? xcd * (q + 1) : r * (q + 1) + (xcd - r) * q) + off; }
        const int nig = wgm * nN, gid = wgid / nig, fm = gid * wgm, gsz = (nM - fm) < wgm ? (nM - fm) : wgm;
        u.pm = fm + ((wgid % nig) % gsz); u.pn = (wgid % nig) / gsz; return true;
    }
    __device__ __forceinline__ void a_ready(const Unit&) const {}
    __device__ __forceinline__ void done(const Unit&) const {}
};

__device__ __forceinline__ unsigned cvt_pk_bf16(float lo, float hi) { unsigned r; asm volatile("v_cvt_pk_bf16_f32 %0, %1, %2" : "=v"(r) : "v"(lo), "v"(hi)); return r; }
#ifndef EPI_SILU
#define EPI_SILU 0
#endif
struct EpiProj {
    static constexpr bool PERM = true, AFTER_DRAIN = false;
    ProjOut P;
    __device__ __forceinline__ void operator()(const f32x4 (&acc)[2][2][4][2], const Unit& u, int wr, int wc, int fr, int fq) const {
        const int row0 = u.pm * BM + wr * 64 + fr; const int pn = u.pn;
        if (pn == 28) {
            if (wc == 0) {
#pragma unroll
                for (int ai = 0; ai < 2; ++ai)
#pragma unroll
                    for (int m = 0; m < 4; ++m) { float* rowp = P.lr + (size_t)(row0 + ai * HALF + m * 16) * 32 + 8 * fq;
                        *(f32x4*)(rowp) = acc[ai][0][m][0]; *(f32x4*)(rowp + 4) = acc[ai][0][m][1]; }
            }
            return;
        }
        bf16_t* base; int ld, ct; int act = 0; float sc = 1.f;
        if (pn < 4) { base = P.aq; ld = 1024; ct = pn; sc = C2; }
        else if (pn < 8) { base = P.ak; ld = 1024; ct = pn - 4; }
        else if (pn < 12) { base = P.av; ld = 1024; ct = pn - 8; }
        else if (pn < 16) { base = P.sag; ld = 1024; ct = pn - 12; act = EPI_SILU; }
        else if (pn < 18) { base = P.gq; ld = 512; ct = pn - 16; }
        else if (pn < 20) { base = P.gk; ld = 512; ct = pn - 18; }
        else if (pn < 24) { base = P.gv; ld = 1024; ct = pn - 20; }
        else { base = P.sgg; ld = 1024; ct = pn - 24; act = EPI_SILU; }
        const int col0 = ct * BM + wc * 32 + 8 * fq;
#pragma unroll
        for (int ai = 0; ai < 2; ++ai)
#pragma unroll
            for (int m = 0; m < 4; ++m) { bf16_t* rowp = base + (size_t)(row0 + ai * HALF + m * 16) * ld + col0;
#pragma unroll
                for (int bj = 0; bj < 2; ++bj) { f32x4 v0 = acc[ai][bj][m][0], v1 = acc[ai][bj][m][1];
                    if (act) {
#pragma unroll
                        for (int e = 0; e < 4; ++e) { v0[e] = v0[e] * __builtin_amdgcn_rcpf(1.f + __expf(-v0[e])); v1[e] = v1[e] * __builtin_amdgcn_rcpf(1.f + __expf(-v1[e])); } }
                    v0 = v0 * sc; v1 = v1 * sc; u32x4 w; w.x = cvt_pk_bf16(v0[0], v0[1]); w.y = cvt_pk_bf16(v0[2], v0[3]); w.z = cvt_pk_bf16(v1[0], v1[1]); w.w = cvt_pk_bf16(v1[2], v1[3]);
                    __builtin_nontemporal_store(w, (u32x4*)(rowp + bj * HALF)); } }
    }
};
struct EpiY {
    static constexpr bool PERM = true, AFTER_DRAIN = false;
    bf16_t* Y;
    __device__ __forceinline__ void operator()(const f32x4 (&acc)[2][2][4][2], const Unit& u, int wr, int wc, int fr, int fq) const {
        const int row0 = u.pm * BM + wr * 64 + fr, col0 = u.pn * BM + wc * 32 + 8 * fq;
#pragma unroll
        for (int ai = 0; ai < 2; ++ai)
#pragma unroll
            for (int m = 0; m < 4; ++m) { bf16_t* rowp = Y + (size_t)(row0 + ai * HALF + m * 16) * DM + col0;
#pragma unroll
                for (int bj = 0; bj < 2; ++bj) { const f32x4 v0 = acc[ai][bj][m][0], v1 = acc[ai][bj][m][1];
                    u32x4 w; w.x = cvt_pk_bf16(v0[0], v0[1]); w.y = cvt_pk_bf16(v0[2], v0[3]); w.z = cvt_pk_bf16(v1[0], v1[1]); w.w = cvt_pk_bf16(v1[2], v1[3]);
                    *(u32x4*)(rowp + bj * HALF) = w; } }
    }
};
template <class Epi, class Sched, bool ALIGN_EPI = false, bool SP2 = false, int AUX_A = 0, int AUX_B = 0>
__device__ __forceinline__ void gemm_phase(PG8_LAS unsigned char* lds, const Gemm g, const Sched& S, const Epi& E) {
    const int tid = threadIdx.x, wid = __builtin_amdgcn_readfirstlane(tid >> 6), lane = tid & 63, wr = wid >> 2, wc = wid & 3, fr = lane & 15, fq = lane >> 4;
    const int K = g.K, nt = K / BK;
    unsigned voffA[2], voffB[2];
#pragma unroll
    for (int i = 0; i < 2; ++i) { int R, C; stage_rc(tid * 16 + i * 8192, R, C); const int Rb = Epi::PERM ? ((R & ~31) + perm32(R & 31)) : R;
        voffA[i] = (unsigned)(R * K + C) * 2u; voffB[i] = (unsigned)(Rb * K + C) * 2u; }
    const size_t kstep = (size_t)(BK * 2);
    const size_t hstep = (size_t)HALF * K * 2;
    const size_t tstep = 2 * hstep;
    const unsigned ldsw = (unsigned)wid * 1024u;
    const int aoff = lds_byte(wr * 64 + fr, fq * 8), boff = lds_byte(wc * 32 + fr, fq * 8);
#define PG8_SA(b, h) (((b) * 2 + (h)) * HTB)
#define PG8_SB(b, h) ((4 + (b) * 2 + (h)) * HTB)
#define PG8_STAGE(bufoff, gbase, voff) do { _Pragma("unroll") for (int _i = 0; _i < 2; ++_i) \
        { if ((const void*)(voff) == (const void*)voffA) __builtin_amdgcn_global_load_lds((const unsigned*)((const char*)(gbase) + (voff)[_i]), (PG8_LAS unsigned*)(lds + (bufoff) + ldsw + _i * 8192), 16, 0, AUX_A); \
          else __builtin_amdgcn_global_load_lds((const unsigned*)((const char*)(gbase) + (voff)[_i]), (PG8_LAS unsigned*)(lds + (bufoff) + ldsw + _i * 8192), 16, 0, AUX_B); } } while (0)
#define PG8_LDA(dst, b, h) do { _Pragma("unroll") for (int m = 0; m < 4; ++m) _Pragma("unroll") for (int k = 0; k < 2; ++k) dst[m][k] = *(const PG8_LAS bf16x8*)(lds + PG8_SA(b, h) + aoff + m * 2048 + k * 1024); } while (0)
#define PG8_LDB(dst, b, h) do { _Pragma("unroll") for (int n = 0; n < 2; ++n) _Pragma("unroll") for (int k = 0; k < 2; ++k) dst[n][k] = *(const PG8_LAS bf16x8*)(lds + PG8_SB(b, h) + boff + n * 2048 + k * 1024); } while (0)
#define PG8_MMA(ai, bj, At, Bt) do { __builtin_amdgcn_s_setprio(1); _Pragma("unroll") for (int m = 0; m < 4; ++m) _Pragma("unroll") for (int n = 0; n < 2; ++n) _Pragma("unroll") for (int k = 0; k < 2; ++k) \
        acc[ai][bj][m][n] = __builtin_amdgcn_mfma_f32_16x16x32_bf16(Bt[n][k], At[m][k], acc[ai][bj][m][n], 0, 0, 0); __builtin_amdgcn_s_setprio(0); } while (0)
#define PG8_WAIT_V(n) asm volatile("s_waitcnt vmcnt(" #n ")" ::: "memory")
#define PG8_WAIT_L(n) asm volatile("s_waitcnt lgkmcnt(" #n ")" ::: "memory")
#define PG8_BAR __builtin_amdgcn_s_barrier()
#define PG8_SCHED __builtin_amdgcn_sched_barrier(0)
    Unit cur, nxt; int ui = 0;
    if (!S.next(0, cur)) return;
    f32x4 acc[2][2][4][2];
#pragma unroll
    for (int a = 0; a < 2; ++a)
#pragma unroll
        for (int b = 0; b < 2; ++b)
#pragma unroll
            for (int m = 0; m < 4; ++m)
#pragma unroll
                for (int n = 0; n < 2; ++n) acc[a][b][m][n] = (f32x4){0.f, 0.f, 0.f, 0.f};
    bf16x8 At[4][2], B0[2][2], B1[2][2];
    const char* cA = (const char*)g.A + (size_t)cur.pm * tstep; const char* cB = (const char*)g.Bt + (size_t)cur.pn * tstep;
    S.a_ready(cur);
    if constexpr (SP2) {
        PG8_STAGE(PG8_SB(0, 0), cB, voffB); PG8_STAGE(PG8_SB(0, 1), cB + hstep, voffB); PG8_STAGE(PG8_SA(0, 0), cA, voffA); PG8_STAGE(PG8_SA(0, 1), cA + hstep, voffA);
        if (wr == 1) PG8_BAR;
        PG8_WAIT_V(2); PG8_BAR;
        PG8_STAGE(PG8_SB(1, 0), cB + kstep, voffB); PG8_STAGE(PG8_SA(1, 0), cA + kstep, voffA); PG8_STAGE(PG8_SB(1, 1), cB + hstep + kstep, voffB);
        PG8_WAIT_V(6); PG8_BAR;
    } else {
        PG8_STAGE(PG8_SB(0, 0), cB, voffB); PG8_STAGE(PG8_SA(0, 0), cA, voffA); PG8_STAGE(PG8_SB(0, 1), cB + hstep, voffB); PG8_STAGE(PG8_SA(0, 1), cA + hstep, voffA);
        if (wr == 1) PG8_BAR;
        PG8_WAIT_V(4); PG8_BAR;
        PG8_STAGE(PG8_SB(1, 0), cB + kstep, voffB); PG8_STAGE(PG8_SA(1, 0), cA + kstep, voffA); PG8_STAGE(PG8_SB(1, 1), cB + hstep + kstep, voffB);
        PG8_WAIT_V(6); PG8_BAR;
    }
    for (;;) {
        const bool has_next = S.next(ui + 1, nxt);
        const char* nA = has_next ? (const char*)g.A + (size_t)nxt.pm * tstep : cA; const char* nB = has_next ? (const char*)g.Bt + (size_t)nxt.pn * tstep : cB;
        for (int t = 0; t < nt; t += 2) {
            const bool last = (t == nt - 2);
            const char* a1 = cA + (size_t)(t + 1) * kstep;
            const char* a2 = last ? nA : cA + (size_t)(t + 2) * kstep; const char* b2 = last ? nB : cB + (size_t)(t + 2) * kstep;
            const char* a3 = a2 + kstep; const char* b3 = b2 + kstep;
            if (last && has_next) S.a_ready(nxt);
            if constexpr (SP2) {
            PG8_LDB(B0, 0, 0); PG8_LDB(B1, 0, 1); PG8_SCHED; PG8_LDA(At, 0, 0); PG8_STAGE(PG8_SA(1, 1), a1 + hstep, voffA);
            PG8_WAIT_V(8); PG8_WAIT_L(0); PG8_BAR; PG8_MMA(0, 0, At, B0); PG8_MMA(0, 1, At, B1); PG8_BAR; PG8_SCHED;
            PG8_LDA(At, 0, 1); PG8_STAGE(PG8_SB(0, 0), b2, voffB); PG8_STAGE(PG8_SB(0, 1), b2 + hstep, voffB); PG8_STAGE(PG8_SA(0, 0), a2, voffA);
            PG8_WAIT_V(8); PG8_WAIT_L(0); PG8_BAR; PG8_MMA(1, 0, At, B0); PG8_MMA(1, 1, At, B1); PG8_BAR; PG8_SCHED;
            PG8_LDB(B0, 1, 0); PG8_LDB(B1, 1, 1); PG8_SCHED; PG8_LDA(At, 1, 0); PG8_STAGE(PG8_SA(0, 1), a2 + hstep, voffA);
            PG8_WAIT_V(8); PG8_WAIT_L(0); PG8_BAR; PG8_MMA(0, 0, At, B0); PG8_MMA(0, 1, At, B1); PG8_BAR; PG8_SCHED;
            PG8_LDA(At, 1, 1); PG8_STAGE(PG8_SB(1, 0), b3, voffB); PG8_STAGE(PG8_SB(1, 1), b3 + hstep, voffB); PG8_STAGE(PG8_SA(1, 0), a3, voffA);
            PG8_WAIT_V(8); PG8_WAIT_L(0); PG8_BAR; PG8_MMA(1, 0, At, B0); PG8_MMA(1, 1, At, B1); PG8_BAR; PG8_SCHED;
            } else {
            PG8_LDB(B0, 0, 0); PG8_SCHED; PG8_LDA(At, 0, 0); PG8_STAGE(PG8_SA(1, 1), a1 + hstep, voffA);
            PG8_WAIT_L(8); PG8_BAR; PG8_WAIT_L(0); PG8_MMA(0, 0, At, B0); PG8_BAR; PG8_SCHED;
            PG8_LDB(B1, 0, 1); PG8_STAGE(PG8_SB(0, 0), b2, voffB);
            PG8_BAR; PG8_WAIT_L(0); PG8_MMA(0, 1, At, B1); PG8_BAR;
            PG8_LDA(At, 0, 1); PG8_STAGE(PG8_SA(0, 0), a2, voffA);
            PG8_BAR; PG8_WAIT_L(0); PG8_MMA(1, 0, At, B0); PG8_BAR; PG8_SCHED;
            PG8_STAGE(PG8_SB(0, 1), b2 + hstep, voffB);
            PG8_WAIT_V(6); PG8_BAR; PG8_MMA(1, 1, At, B1); PG8_BAR;
            PG8_LDB(B0, 1, 0); PG8_SCHED; PG8_LDA(At, 1, 0); PG8_STAGE(PG8_SA(0, 1), a2 + hstep, voffA);
            PG8_WAIT_L(8); PG8_BAR; PG8_WAIT_L(0); PG8_MMA(0, 0, At, B0); PG8_BAR; PG8_SCHED;
            PG8_LDB(B1, 1, 1); PG8_STAGE(PG8_SB(1, 0), b3, voffB);
            PG8_BAR; PG8_WAIT_L(0); PG8_MMA(0, 1, At, B1); PG8_BAR;
            PG8_LDA(At, 1, 1); PG8_STAGE(PG8_SA(1, 0), a3, voffA);
            PG8_BAR; PG8_WAIT_L(0); PG8_MMA(1, 0, At, B0); PG8_BAR; PG8_SCHED;
            PG8_STAGE(PG8_SB(1, 1), b3 + hstep, voffB);
            PG8_WAIT_V(6); PG8_BAR; PG8_MMA(1, 1, At, B1); PG8_BAR;
            }
        }
        if constexpr (ALIGN_EPI) { if (wr == 0) PG8_BAR; }
        if constexpr (!Epi::AFTER_DRAIN) { E(acc, cur, wr, wc, fr, fq); S.done(cur); }
        if (!has_next) break;
#pragma unroll
        for (int a = 0; a < 2; ++a)
#pragma unroll
            for (int b = 0; b < 2; ++b)
#pragma unroll
                for (int m = 0; m < 4; ++m)
#pragma unroll
                    for (int n = 0; n < 2; ++n) acc[a][b][m][n] = (f32x4){0.f, 0.f, 0.f, 0.f};
        cur = nxt; cA = nA; cB = nB; ++ui;
        if constexpr (ALIGN_EPI) { if (wr == 1) PG8_BAR; }
    }
    PG8_WAIT_V(0);
    if constexpr (!ALIGN_EPI) { if (wr == 0) PG8_BAR; }
    PG8_BAR;
    if constexpr (Epi::AFTER_DRAIN) { E.fused(acc, cur, wr, wc, fr, fq, lds, wid, lane); S.done(cur); }
#undef PG8_SA
#undef PG8_SB
#undef PG8_STAGE
#undef PG8_LDA
#undef PG8_LDB
#undef PG8_MMA
#undef PG8_WAIT_V
#undef PG8_WAIT_L
#undef PG8_BAR
#undef PG8_SCHED
}
}
constexpr int NWAVES = 8;
constexpr int RING_OFF = 0, RING_BYTES = 153600;
constexpr int LDSCTL_OFF = RING_BYTES, MISC_OFF = LDSCTL_OFF + 320;
constexpr int LDS_BYTES = 154624;
constexpr int CW_TMO = 0, CW_CODE = 1, CW_P4PUB = 2048, CW_MODRDY = 3072, CW_BAR = 4096, CW_P4CEN = 16384, CW_P4ARR = 16384 + 1024, CW_P3ARR = 16384 + 2048, CW_P3CNT = 16384 + 3072, CW_PUB = 65536  ;
#define GAS __attribute__((address_space(1)))
#define LAS __attribute__((address_space(3)))
typedef unsigned v4u __attribute__((ext_vector_type(4)));
typedef unsigned v2u __attribute__((ext_vector_type(2)));
typedef float f32x4 __attribute__((ext_vector_type(4)));
typedef float f32x16 __attribute__((ext_vector_type(16)));
typedef short bf16x8 __attribute__((ext_vector_type(8)));
typedef short s16x4 __attribute__((ext_vector_type(4)));
typedef GAS unsigned gu32;
typedef GAS unsigned long long gu64;
#define RLX_AGENT __ATOMIC_RELAXED, __HIP_MEMORY_SCOPE_AGENT
#define LDS_WAIT() asm volatile("s_waitcnt lgkmcnt(0)" ::: "memory")
#define VM_WAIT() asm volatile("s_waitcnt vmcnt(0)" ::: "memory")
__device__ __forceinline__ void glds16(const void* gsrc, unsigned lds_dst) { unsigned keep; const unsigned dst = (unsigned)__builtin_amdgcn_readfirstlane((int)lds_dst);
    asm volatile("s_mov_b32 %0, m0\n\ts_mov_b32 m0, %2\n\ts_nop 0\n\tglobal_load_lds_dwordx4 %1, off\n\ts_mov_b32 m0, %0" : "=&s"(keep) : "v"(gsrc), "s"(dst) : "memory"); }
template <bool NT = false> __device__ __forceinline__ void glds16s(const void* sbase, unsigned voff, unsigned lds_dst) { unsigned keep; const unsigned dst = (unsigned)__builtin_amdgcn_readfirstlane((int)lds_dst);
    const unsigned long long b = (unsigned long long)sbase; const unsigned blo = (unsigned)__builtin_amdgcn_readfirstlane((int)(unsigned)b), bhi = (unsigned)__builtin_amdgcn_readfirstlane((int)(unsigned)(b >> 32));
    const unsigned long long bs = ((unsigned long long)bhi << 32) | blo;
    if constexpr (NT) asm volatile("s_mov_b32 %0, m0\n\ts_mov_b32 m0, %3\n\ts_nop 0\n\tglobal_load_lds_dwordx4 %1, %2 nt\n\ts_mov_b32 m0, %0" : "=&s"(keep) : "v"(voff), "s"(bs), "s"(dst) : "memory");
    else              asm volatile("s_mov_b32 %0, m0\n\ts_mov_b32 m0, %3\n\ts_nop 0\n\tglobal_load_lds_dwordx4 %1, %2\n\ts_mov_b32 m0, %0" : "=&s"(keep) : "v"(voff), "s"(bs), "s"(dst) : "memory"); }
#define XB_TMO      128
#define XB_XCNT(j)  (256  + 64 * (j))
#define XB_XSUB(j)  (1280 + 64 * (j))
#define XB_XGEN(j)  (2304 + 64 * (j))
#define XB_TOP      3328
#define XB_TOPGEN   3392
#define XCD_BAR_WORDS 3456
#define XB_SPIN_CAP (1u << 18)

__device__ __forceinline__ unsigned xb_ld(unsigned* p)              { return __hip_atomic_load(p, __ATOMIC_RELAXED, __HIP_MEMORY_SCOPE_AGENT); }
__device__ __forceinline__ unsigned xb_add(unsigned* p, unsigned v) { return __hip_atomic_fetch_add(p, v, __ATOMIC_RELAXED, __HIP_MEMORY_SCOPE_AGENT); }
__device__ __forceinline__ unsigned xb_xcc_id() { return (unsigned)__builtin_amdgcn_s_getreg((3 << 11) | 20) & 0xFu; }
#define XB_SPIN(cond, bar) do { unsigned _sp = 0; while (cond) { __builtin_amdgcn_s_sleep(1); \
    if ((++_sp & 255u) == 0u) { if (xb_ld(&(bar)[XB_TMO])) break; if (_sp > XB_SPIN_CAP) { atomicAdd(&(bar)[XB_TMO], 1u); break; } } } } while (0)

struct XcdBarrier {
    unsigned* bar; unsigned x;
    volatile LAS unsigned* st;
};

__device__ __forceinline__ XcdBarrier xcd_barrier_post(unsigned* bar, volatile LAS unsigned* st) {
    XcdBarrier b; b.bar = bar; b.x = xb_xcc_id(); b.st = st;
    if (threadIdx.x == 0) (void)xb_add(&bar[XB_XCNT(b.x)], 1u);
    return b;
}
__device__ __forceinline__ void xcd_barrier_complete(unsigned* bar, unsigned x, unsigned& nloc, unsigned& nx) {
    const unsigned G = gridDim.x * gridDim.y * gridDim.z;
    unsigned sum, cnt, mine, sp = 0u;
    for (;;) {
        sum = 0u; cnt = 0u; mine = 0u;
#pragma unroll
        for (unsigned j = 0; j < 16; ++j) { const unsigned c = xb_ld(&bar[XB_XCNT(j)]); sum += c; cnt += (c > 0u) ? 1u : 0u; mine = (j == x) ? c : mine; }
        if (sum == G) break;
        __builtin_amdgcn_s_sleep(1);
        if ((++sp & 255u) == 0u) { if (xb_ld(&bar[XB_TMO])) break; if (sp > XB_SPIN_CAP) { atomicAdd(&bar[XB_TMO], 1u); break; } }
    }
    nloc = mine > 0u ? mine : 1u; nx = cnt > 0u ? cnt : 1u;
}

__device__ __forceinline__ void xcd_barrier(const XcdBarrier& b) {
    asm volatile("s_waitcnt vmcnt(0)" ::: "memory");
    __syncthreads();
    if (threadIdx.x == 0) {
        unsigned* bar = b.bar;
        __builtin_amdgcn_s_waitcnt(0);
        unsigned nloc = b.st[0], nx = b.st[1];
        if (nloc == 0u) { xcd_barrier_complete(bar, b.x, nloc, nx); b.st[0] = nloc; b.st[1] = nx; }
        const unsigned old = xb_add(&bar[XB_XSUB(b.x)], 1u);
        const unsigned gen = old / nloc;
        if (old + 1u == (gen + 1u) * nloc) {
            __builtin_amdgcn_fence(__ATOMIC_RELEASE, "agent");
            asm volatile("s_waitcnt vmcnt(0)" ::: "memory");
            const unsigned og = xb_add(&bar[XB_TOP], 1u);
            const unsigned tg = og / nx;
            if (og + 1u == (tg + 1u) * nx) xb_add(&bar[XB_TOPGEN], 1u);
            else XB_SPIN(xb_ld(&bar[XB_TOPGEN]) == tg, bar);
            __builtin_amdgcn_fence(__ATOMIC_ACQUIRE, "agent");
            xb_add(&bar[XB_XGEN(b.x)], 1u);
            asm volatile("s_waitcnt vmcnt(0)" ::: "memory");
        } else {
            XB_SPIN(xb_ld(&bar[XB_XGEN(b.x)]) == gen, bar);
            __builtin_amdgcn_fence(__ATOMIC_ACQUIRE, "agent");
            asm volatile("s_waitcnt vmcnt(0)" ::: "memory");
        }
    }
    __syncthreads();
}

struct Args { const float* in[13]; float* out; unsigned char* ws; int ph_lo, ph_hi, li, dup_phase, dup_reps, dup_sub; };
struct Frame {
    LAS unsigned char* lds; volatile LAS unsigned* MISC; gu32* ctl;
    int tid, lane, wave, vcu, G;
};
__device__ __forceinline__ float wave_sum(float v) {
#pragma unroll
    for (int o = 1; o < 64; o <<= 1) v += __shfl_xor(v, o);
    return v;
}
__device__ __forceinline__ void p0_transpose_item(const float* W, int K, int N, bf16* WT, LAS float* scr, int item, int lane) {
    const int nblk = N / 32, kb = item / nblk, nb = item % nblk, k0 = 64 * kb, n0 = 32 * nb;
#pragma unroll
    for (int i = 0; i < 8; ++i) { const int kk = 8 * i + (lane >> 3), cg = lane & 7;
        const f32x4 v = __builtin_nontemporal_load((const GAS f32x4*)(W + (size_t)(k0 + kk) * N + n0 + 4 * cg));
        LAS float* d = scr + kk * 33 + 4 * cg; d[0] = v.x; d[1] = v.y; d[2] = v.z; d[3] = v.w; }
    LDS_WAIT(); asm volatile("" ::: "memory");
    const int c = lane & 7;
#pragma unroll
    for (int j = 0; j < 4; ++j) { const int n = (lane >> 3) + 8 * j; const LAS float* s = scr + (8 * c) * 33 + n;
        v4u o; o.x = pk2(s[0 * 33], s[1 * 33]); o.y = pk2(s[2 * 33], s[3 * 33]); o.z = pk2(s[4 * 33], s[5 * 33]); o.w = pk2(s[6 * 33], s[7 * 33]);
        *(GAS v4u*)(WT + (size_t)(n0 + n) * K + k0 + 8 * c) = o; }
    LDS_WAIT(); asm volatile("" ::: "memory");
}
__device__ __forceinline__ void p0_mod(Frame& F, const Args& a) {
    const float* c = a.in[1]; const float* w_cond = a.in[2]; const float* b_cond = a.in[3];
    float* mod = (float*)(a.ws + WS_MOD);
    if (F.vcu < 192) {
        LAS float* sc = (LAS float*)(F.lds);
        LAS float* red = (LAS float*)(F.lds + 32768);
        for (int i = F.tid; i < 4 * DM; i += NWAVES * 64) sc[i] = silu_f(c[i]);
        __syncthreads();
        const int cg = F.lane & 7, kr = F.lane >> 3, n0 = 32 * F.vcu + 4 * cg;
        f32x4 acc[4];
#pragma unroll
        for (int b = 0; b < 4; ++b) acc[b] = (f32x4){0.f, 0.f, 0.f, 0.f};
#pragma unroll 8
        for (int it = 0; it < 32; ++it) { const int k = 256 * F.wave + 8 * it + kr;
            const f32x4 w = __builtin_nontemporal_load((const GAS f32x4*)(w_cond + (size_t)k * (3 * DM) + n0));
#pragma unroll
            for (int b = 0; b < 4; ++b) acc[b] += w * sc[b * DM + k]; }
#pragma unroll
        for (int b = 0; b < 4; ++b)
#pragma unroll
            for (int e = 0; e < 4; ++e) { float v = acc[b][e]; v += __shfl_xor(v, 8); v += __shfl_xor(v, 16); v += __shfl_xor(v, 32); acc[b][e] = v; }
        if (kr == 0) {
#pragma unroll
            for (int b = 0; b < 4; ++b) *(LAS f32x4*)(red + (F.wave * 4 + b) * 32 + 4 * cg) = acc[b]; }
        __syncthreads();
        if (F.tid < 128) { const int b = F.tid >> 5, col = F.tid & 31; float s = b_cond[32 * F.vcu + col];
#pragma unroll
            for (int w = 0; w < 8; ++w) s += red[(w * 4 + b) * 32 + col];
            __hip_atomic_store((unsigned*)(mod + b * 3 * DM + 32 * F.vcu + col), __builtin_bit_cast(unsigned, s), __ATOMIC_RELAXED, __HIP_MEMORY_SCOPE_AGENT); }
        __syncthreads();
    }
}
__device__ __forceinline__ void p1_weights(Frame& F, const Args& a) {
    LAS float* scr = (LAS float*)(F.lds + RING_OFF + F.wave * 16384);
    const int gw = F.vcu * NWAVES + F.wave, NGW = F.G * NWAVES;
    bf16* wint = (bf16*)(a.ws + WS_WINT); bf16* woutt = (bf16*)(a.ws + WS_WOUTT);
    constexpr int I_IN = (DM / 64) * (NPROJ / 32), I_OUT = (DM / 64) * (DM / 32);
    for (int it = gw; it < I_IN; it += NGW) p0_transpose_item(a.in[4], DM, NPROJ, wint, scr, it, F.lane);
    (void)woutt; (void)I_OUT;
}
__device__ __forceinline__ void p1_wout(Frame& F, const Args& a, int c, int ncu) {
    LAS float* scr = (LAS float*)(F.lds + RING_OFF + F.wave * 16384);
    const int gw = c * NWAVES + F.wave, NGW = ncu * NWAVES;
    bf16* woutt = (bf16*)(a.ws + WS_WOUTT);
    constexpr int I_OUT = (DM / 64) * (DM / 32);
    for (int it = gw; it < I_OUT; it += NGW) p0_transpose_item(a.in[11], DM, DM, woutt, scr, it, F.lane);
}
__device__ __forceinline__ void p1_h(Frame& F, const Args& a) {
    const float* x = a.in[0]; const float* mod = (const float*)(a.ws + WS_MOD); bf16* h = (bf16*)(a.ws + WS_H);
    const int gw = F.vcu * NWAVES + F.wave, NGW = F.G * NWAVES;
    for (int blk = gw; blk < T / 16; blk += NGW) {
        const int b = (blk * 16) / SEQ;
        const GAS f32x4* shp = (const GAS f32x4*)(mod + b * 3 * DM) + F.lane; const GAS f32x4* scp = (const GAS f32x4*)(mod + b * 3 * DM + DM) + F.lane;
        f32x4 sh[8], sc[8];
#pragma unroll
        for (int j = 0; j < 8; ++j) { sh[j] = shp[64 * j]; sc[j] = scp[64 * j] + 1.0f; }
        for (int r = 0; r < 16; ++r) { const int m = blk * 16 + r;
            const GAS f32x4* xr = (const GAS f32x4*)(x + (size_t)m * DM) + F.lane;
            f32x4 v[8]; float s = 0.f;
#pragma unroll
            for (int j = 0; j < 8; ++j) { v[j] = __builtin_nontemporal_load(xr + 64 * j); s += (v[j].x * v[j].x + v[j].y * v[j].y) + (v[j].z * v[j].z + v[j].w * v[j].w); }
            const float rs = rsqrtf(wave_sum(s) * (1.f / DM) + EPS);
            GAS unsigned long long* o8 = (GAS unsigned long long*)(h + (size_t)m * DM) + F.lane;
#pragma unroll
            for (int j = 0; j < 8; ++j) { const f32x4 o = v[j] * rs * sc[j] + sh[j];
                o8[64 * j] = (unsigned long long)pk2(o.x, o.y) | ((unsigned long long)pk2(o.z, o.w) << 32); } }
    }
}
__device__ __forceinline__ void lr_tail(Frame& F, const Args& a) {
    const bf16* h = (const bf16*)(a.ws + WS_H); const unsigned char* wl = a.ws + WS_WINT + (size_t)7168 * DM * 2; float* lr = (float*)(a.ws + WS_LR);
    constexpr int WROW = 4096 + 32;
    for (int i = F.tid; i < 32 * 256; i += NWAVES * 64) { const int r = i >> 8, c = i & 255; *(LAS v4u*)(F.lds + r * WROW + c * 16) = *(const GAS v4u*)(wl + (size_t)r * 4096 + c * 16); }
    __syncthreads();
    const int gw = F.vcu * NWAVES + F.wave, NGW = F.G * NWAVES, li = F.lane & 15, g = F.lane >> 4;
    const LAS unsigned char* bp0 = F.lds + li * WROW + g * 16; const LAS unsigned char* bp1 = bp0 + 16 * WROW;
    for (int rb = gw; rb < T / 16; rb += NGW) {
        const bf16* ap = h + (size_t)(rb * 16 + li) * DM + 8 * g;
        f32x4 c0 = (f32x4){0.f, 0.f, 0.f, 0.f}, c1 = c0;
        bf16x8 avA[16], avB[16];
#define LRLOAD(D, kb) do { _Pragma("unroll") for (int i_ = 0; i_ < 16; ++i_) D[i_] = __builtin_nontemporal_load((const GAS bf16x8*)(ap + 32 * (16 * (kb) + i_))); } while (0)
#define LRMMA(D, kb) do { _Pragma("unroll") for (int i_ = 0; i_ < 16; ++i_) { const bf16x8 b0_ = *(const LAS bf16x8*)(bp0 + 64 * (16 * (kb) + i_)), b1_ = *(const LAS bf16x8*)(bp1 + 64 * (16 * (kb) + i_)); \
            c0 = __builtin_amdgcn_mfma_f32_16x16x32_bf16(D[i_], b0_, c0, 0, 0, 0); c1 = __builtin_amdgcn_mfma_f32_16x16x32_bf16(D[i_], b1_, c1, 0, 0, 0); } } while (0)
        LRLOAD(avA, 0); __builtin_amdgcn_sched_barrier(0); LRLOAD(avB, 1); __builtin_amdgcn_sched_barrier(0); LRMMA(avA, 0); __builtin_amdgcn_sched_barrier(0);
        LRLOAD(avA, 2); __builtin_amdgcn_sched_barrier(0); LRMMA(avB, 1); __builtin_amdgcn_sched_barrier(0); LRLOAD(avB, 3); __builtin_amdgcn_sched_barrier(0);
        LRMMA(avA, 2); __builtin_amdgcn_sched_barrier(0); LRMMA(avB, 3); __builtin_amdgcn_sched_barrier(0);
#undef LRLOAD
#undef LRMMA
#pragma unroll
        for (int rg = 0; rg < 4; ++rg) { float* o = lr + (size_t)(rb * 16 + 4 * g + rg) * 32 + li; o[0] = c0[rg]; o[16] = c1[rg]; }
    }
    __syncthreads();
}
__device__ __forceinline__ void unpack8(const v4u w, float (&f)[8]) {
    f[0] = __builtin_bit_cast(float, w.x << 16); f[1] = __builtin_bit_cast(float, w.x & 0xffff0000u); f[2] = __builtin_bit_cast(float, w.y << 16); f[3] = __builtin_bit_cast(float, w.y & 0xffff0000u);
    f[4] = __builtin_bit_cast(float, w.z << 16); f[5] = __builtin_bit_cast(float, w.z & 0xffff0000u); f[6] = __builtin_bit_cast(float, w.w << 16); f[7] = __builtin_bit_cast(float, w.w & 0xffff0000u);
}
__device__ __forceinline__ v4u pack8(const float (&f)[8]) { v4u w; w.x = pk2(f[0], f[1]); w.y = pk2(f[2], f[3]); w.z = pk2(f[4], f[5]); w.w = pk2(f[6], f[7]); return w; }
__device__ __forceinline__ void p5_combine(Frame& F, const Args& a) {
    const bf16* op = (const bf16*)(a.ws + WS_OP); const float* lse = (const float*)(a.ws + WS_LSE); const bf16* sag = (const bf16*)(a.ws + WS_SAG);
    const bf16* of = (const bf16*)(a.ws + WS_OF); const bf16* ob = (const bf16*)(a.ws + WS_OB); const bf16* sgg = (const bf16*)(a.ws + WS_SGG); const float* gain = a.in[9];
    bf16* cat = (bf16*)(a.ws + WS_H);
    const int gw = F.vcu * NWAVES + F.wave, NGW = F.G * NWAVES, lane = F.lane;
    float gn[16];
#pragma unroll
    for (int j = 0; j < 4; ++j) { const f32x4 g = *(const GAS f32x4*)(gain + 16 * lane + 4 * j); gn[4 * j] = g.x; gn[4 * j + 1] = g.y; gn[4 * j + 2] = g.z; gn[4 * j + 3] = g.w; }
    for (int t = gw; t < T; t += NGW) {
        const size_t e = (size_t)t * 1024 + 16 * lane; const int hh = lane >> 2;
        const float l0 = __builtin_nontemporal_load(lse + (size_t)t * 16 + hh), l1 = __builtin_nontemporal_load(lse + (size_t)T * 16 + (size_t)t * 16 + hh), l2 = __builtin_nontemporal_load(lse + (size_t)2 * T * 16 + (size_t)t * 16 + hh);
        const float mx = fmaxf(l0, fmaxf(l1, l2)); float w0 = exp2f(l0 - mx), w1 = exp2f(l1 - mx), w2 = exp2f(l2 - mx); const float wi = 1.f / (w0 + w1 + w2); w0 *= wi; w1 *= wi; w2 *= wi;
#pragma unroll
        for (int hf = 0; hf < 2; ++hf) { float p0[8], p1[8], p2[8], g[8], o[8];
            unpack8(__builtin_nontemporal_load((const GAS v4u*)(op + e + 8 * hf)), p0); unpack8(__builtin_nontemporal_load((const GAS v4u*)(op + (size_t)T * 1024 + e + 8 * hf)), p1); unpack8(__builtin_nontemporal_load((const GAS v4u*)(op + (size_t)2 * T * 1024 + e + 8 * hf)), p2);
            unpack8(__builtin_nontemporal_load((const GAS v4u*)(sag + e + 8 * hf)), g);
#if !EPI_SILU
#pragma unroll
            for (int i = 0; i < 8; ++i) g[i] = g[i] * __builtin_amdgcn_rcpf(1.f + __builtin_amdgcn_exp2f(-LOG2E * g[i]));
#endif
#pragma unroll
            for (int i = 0; i < 8; ++i) o[i] = (w0 * p0[i] + w1 * p1[i] + w2 * p2[i]) * g[i];
            *(GAS v4u*)(cat + (size_t)t * 2048 + 16 * lane + 8 * hf) = pack8(o); }
        float xv[16], ss = 0.f;
#pragma unroll
        for (int hf = 0; hf < 2; ++hf) { float f[8], b[8]; unpack8(__builtin_nontemporal_load((const GAS v4u*)(of + e + 8 * hf)), f); unpack8(__builtin_nontemporal_load((const GAS v4u*)(ob + e + 8 * hf)), b);
#pragma unroll
            for (int i = 0; i < 8; ++i) { xv[8 * hf + i] = f[i] + b[i]; ss += xv[8 * hf + i] * xv[8 * hf + i]; } }
        ss += __shfl_xor(ss, 1); ss += __shfl_xor(ss, 2); ss += __shfl_xor(ss, 4); ss += __shfl_xor(ss, 8);
        const float r = rsqrtf(ss * (1.f / 256.f) + EPS);
#pragma unroll
        for (int hf = 0; hf < 2; ++hf) { float g[8], o[8]; unpack8(__builtin_nontemporal_load((const GAS v4u*)(sgg + e + 8 * hf)), g);
#if !EPI_SILU
#pragma unroll
            for (int i = 0; i < 8; ++i) g[i] = g[i] * __builtin_amdgcn_rcpf(1.f + __builtin_amdgcn_exp2f(-LOG2E * g[i]));
#endif
#pragma unroll
            for (int i = 0; i < 8; ++i) o[i] = xv[8 * hf + i] * r * gn[8 * hf + i] * g[i];
            *(GAS v4u*)(cat + (size_t)t * 2048 + 1024 + 16 * lane + 8 * hf) = pack8(o); }
    }
}
__device__ __forceinline__ void p7_final(Frame& F, const Args& a) {
    float* out = a.out; const float* x = a.in[0]; const float* fg = a.in[12]; const float* mod = (const float*)(a.ws + WS_MOD); const bf16* Y = (const bf16*)(a.ws + WS_Y);
    const int gw = F.vcu * NWAVES + F.wave, NGW = F.G * NWAVES;
    f32x4 g[8];
#pragma unroll
    for (int j = 0; j < 8; ++j) g[j] = *((const GAS f32x4*)fg + F.lane + 64 * j);
    for (int blk = gw; blk < T / 16; blk += NGW) {
        const int b = (blk * 16) / SEQ;
        f32x4 gt[8];
#pragma unroll
        for (int j = 0; j < 8; ++j) gt[j] = *((const GAS f32x4*)(mod + b * 3 * DM + 2 * DM) + F.lane + 64 * j);
        for (int r = 0; r < 16; ++r) { const int m = blk * 16 + r;
            const GAS f32x4* xr = (const GAS f32x4*)(x + (size_t)m * DM) + F.lane; const GAS v2u* yr = (const GAS v2u*)(Y + (size_t)m * DM) + F.lane;
            f32x4 v[8]; float s = 0.f;
#pragma unroll
            for (int j = 0; j < 8; ++j) { const f32x4 xv = __builtin_nontemporal_load(xr + 64 * j); const v2u yw = __builtin_nontemporal_load(yr + 64 * j);
                const f32x4 yv = (f32x4){__builtin_bit_cast(float, yw.x << 16), __builtin_bit_cast(float, yw.x & 0xffff0000u), __builtin_bit_cast(float, yw.y << 16), __builtin_bit_cast(float, yw.y & 0xffff0000u)};
                v[j] = xv + gt[j] * yv; s += (v[j].x * v[j].x + v[j].y * v[j].y) + (v[j].z * v[j].z + v[j].w * v[j].w); }
            const float rs = rsqrtf(wave_sum(s) * (1.f / DM) + EPS);
            GAS f32x4* orow = (GAS f32x4*)(out + (size_t)m * DM) + F.lane;
#pragma unroll
            for (int j = 0; j < 8; ++j) orow[64 * j] = v[j] * rs * g[j]; }
    }
}

namespace att {
constexpr int KCH = 384 * 16, VDH = 384 * 64, K_OFF = 0, V_OFF = 8 * KCH, VBUF = 2 * VDH, BIAS_OFF = V_OFF + 2 * VBUF, BCOPY = 832, RB_OFF = BIAS_OFF + 4 * BCOPY, ATT_LDS = RB_OFF + 2048;
static_assert(ATT_LDS <= RING_BYTES && (V_OFF % 1024) == 0 && (BIAS_OFF % 16) == 0, "attention LDS map");
constexpr int NUNITS = BATCH * 16 * 3 * 32;
__device__ __forceinline__ int crow(int r, int hi) { return (r & 3) + 8 * (r >> 2) + 4 * hi; }
typedef short v4i16_t __attribute__((ext_vector_type(4)));
__device__ __forceinline__ s16x4 vtr(const LAS unsigned char* p) { return __builtin_bit_cast(s16x4, __builtin_amdgcn_ds_read_tr16_b64_v4i16((LAS v4i16_t*)p)); }
__device__ __forceinline__ unsigned cvtpk(float lo, float hi) { typedef float f2 __attribute__((ext_vector_type(2))); typedef __bf16 b2 __attribute__((ext_vector_type(2))); f2 v = {lo, hi}; b2 b = __builtin_convertvector(v, b2); return __builtin_bit_cast(unsigned, b); }
#define ATT_BAR() asm volatile("s_waitcnt lgkmcnt(0)\n\ts_barrier" ::: "memory")

struct UnitGeo { int b, h, p, d, r, L, m0; unsigned rowb; size_t base; };
__device__ __forceinline__ UnitGeo decode(int uid) {
    UnitGeo u; const int bh = uid / 96, w96 = uid % 96, rs = w96 & 31; u.p = w96 >> 5; u.b = bh >> 4; u.h = bh & 15;
    u.d = (u.p == 0) ? 1 : (u.p == 1 ? 4 : 16);
    u.r = (u.p == 0) ? 0 : (u.p == 1 ? (rs >> 3) : (rs >> 1)); const int seg = (u.p == 0) ? rs : (u.p == 1 ? (rs & 7) : (rs & 1));
    u.L = SEQ / u.d; u.m0 = seg * 256; u.rowb = (unsigned)u.d * 2048u; u.base = ((size_t)u.b * SEQ + u.r) * 2048 + u.h * 128; return u;
}
__device__ __forceinline__ void dma_k(const Args& a, const UnitGeo& u, LAS unsigned char* lds, int wid, int lane) {
    const unsigned char* Kb = a.ws + WS_AK + u.base + (lane >> 3) * 16; const unsigned rowb = u.rowb;
#pragma unroll
    for (int j = 0; j < 6; ++j) { const int blk = wid + 8 * j; int m = u.m0 - 64 + 8 * blk + (lane & 7); m = m < 0 ? 0 : (m > u.L - 1 ? u.L - 1 : m);
        glds16(Kb + (size_t)m * rowb, (unsigned)(size_t)lds + K_OFF + blk * 1024); }
}
__device__ __forceinline__ void dma_v(const Args& a, const UnitGeo& u, LAS unsigned char* lds, int vbuf, int wid, int lane) {
    const unsigned char* Vb = a.ws + WS_AV + u.base + (lane >> 5) * 64 + (lane & 3) * 16; const unsigned rowb = u.rowb;
#pragma unroll
    for (int j = 0; j < 6; ++j) { const int blk = wid + 8 * j; int m = u.m0 - 64 + 8 * blk + ((lane >> 2) & 7); m = m < 0 ? 0 : (m > u.L - 1 ? u.L - 1 : m);
        glds16(Vb + (size_t)m * rowb, (unsigned)(size_t)lds + V_OFF + vbuf * VBUF + blk * 1024); }
}
__device__ __forceinline__ void load_q(bf16x8 (&q)[4], const Args& a, const UnitGeo& u, int wid, int r32, int hi) {
    const unsigned char* Qb = a.ws + WS_AQ + u.base + (size_t)(u.m0 + 32 * wid + r32) * u.rowb + hi * 16;
    asm volatile("global_load_dwordx4 %0, %1, off" : "=&v"(q[0]) : "v"(Qb) : "memory");
    asm volatile("global_load_dwordx4 %0, %1, off offset:32" : "=&v"(q[1]) : "v"(Qb) : "memory");
    asm volatile("global_load_dwordx4 %0, %1, off offset:64" : "=&v"(q[2]) : "v"(Qb) : "memory");
    asm volatile("global_load_dwordx4 %0, %1, off offset:96" : "=&v"(q[3]) : "v"(Qb) : "memory");
}
__device__ __forceinline__ void write_bias(const Args& a, const UnitGeo& u, LAS unsigned char* lds, int tid) {
    for (int e = tid; e < 4 * 192; e += 512) { const int s = e / 192, i = e % 192, sp = i + s - 95;
        *(LAS float*)(lds + BIAS_OFF + s * BCOPY + i * 4) = (sp >= -64 && sp <= 64) ? ((const LAS float*)(lds + RB_OFF))[t5_bucket(sp * u.d) * 16 + u.h] : -1e30f; }
}
#define DECODE(x) decode(unit_of(x))
__device__ __forceinline__ UnitGeo decode_p(int uid, bool contig) { UnitGeo u = decode(uid); if (contig) { u.rowb = 128u; u.base = (size_t)(uid / 96) * SEQ * 128 + (size_t)((uid % 96) >> 5) * 16 * 2048; } return u; }
__device__ __forceinline__ void attn_phase(Frame& F, const Args& a, int c, int ncu, const int knobs = 0) {
    const bool nodma = knobs & 1, nomath = knobs & 2, nostore = knobs & 4, noq = knobs & 16;
    if (c < 0 || c >= ncu) return;
    const bool coop = (ncu == 192);
    const int per = coop ? 32 : (NUNITS + ncu - 1) / ncu, u0 = coop ? 0 : c * per, u1 = coop ? 32 : ((u0 + per < NUNITS) ? u0 + per : NUNITS);
    if (u0 >= u1) return;
    const int cx = c / 24, cj = c % 24;
    auto unit_of = [&](int i) -> int { return coop ? ((8 * cx + (i >> 2)) * 96 + cj + 24 * (i & 3)) : i; };
    LAS unsigned char* lds = F.lds;
    const int tid = F.tid, lane = F.lane, wid = F.wave, r32 = lane & 31, hi = lane >> 5;
    UnitGeo cur = DECODE(u0);
    __builtin_amdgcn_s_waitcnt(0);
    asm volatile("s_waitcnt vmcnt(0) lgkmcnt(0)\n\ts_barrier" ::: "memory");
    ((LAS float*)(lds + RB_OFF))[tid] = a.in[10][tid] * LOG2E;
    asm volatile("s_waitcnt vmcnt(0) lgkmcnt(0)\n\ts_barrier" ::: "memory");
    dma_k(a, cur, lds, wid, lane); dma_v(a, cur, lds, 0, wid, lane); write_bias(a, cur, lds, tid);
    bf16x8 qr[4]; load_q(qr, a, cur, wid, r32, hi);
    int vb = 0;
    float* pl = nullptr; float plv = 0.f; GAS unsigned char* po = nullptr; size_t postep = 0; v4u pov[4] = {};
    const int e31 = 31 - r32;
    const LAS unsigned char* bias_b = lds + BIAS_OFF + (e31 & 3) * BCOPY + ((e31 >> 2) + hi) * 16;
    const LAS unsigned char* kb0 = lds + K_OFF + (4 * wid + (r32 >> 3)) * 1024 + hi * 128 + (r32 & 7) * 16;
    for (int uid = u0; uid < u1; ++uid) {
        asm volatile("s_waitcnt vmcnt(0) lgkmcnt(0)\n\ts_barrier" : "+v"(qr[0]), "+v"(qr[1]), "+v"(qr[2]), "+v"(qr[3]) :: "memory");
        if (uid != u0 && !nostore) {
            if (hi == 0) *pl = plv;
#pragma unroll
            for (int i = 0; i < 4; ++i) *(GAS v4u*)(po + i * postep) = pov[i]; }
        const bool has_next = uid + 1 < u1; UnitGeo nxt = cur;
        if (has_next) { nxt = DECODE(uid + 1); if (!nodma) dma_v(a, nxt, lds, vb ^ 1, wid, lane); }
        const int b = cur.b, h = cur.h, d = cur.d, r = cur.r, L = cur.L, m0 = cur.m0;
        {
        f32x16 pS[5];
#define SB() __builtin_amdgcn_sched_barrier(0)
#define LOADKB(KF, kb) do { _Pragma("unroll") for (int k_ = 0; k_ < 4; ++k_) { const f32x4 t_ = *(const LAS f32x4*)(bias_b + 32 * k_ + 128 * (kb)); pS[kb][4 * k_] = t_.x; pS[kb][4 * k_ + 1] = t_.y; pS[kb][4 * k_ + 2] = t_.z; pS[kb][4 * k_ + 3] = t_.w; } \
                            _Pragma("unroll") for (int d_ = 0; d_ < 4; ++d_) KF[d_] = *(const LAS bf16x8*)(kb0 + d_ * 256 + (kb) * 4096); } while (0)
#define MMAKB(KF, kb) do { _Pragma("unroll") for (int d_ = 0; d_ < 4; ++d_) pS[kb] = __builtin_amdgcn_mfma_f32_32x32x16_bf16(KF[d_], qr[d_], pS[kb], 0, 0, 0); } while (0)
        { bf16x8 ka[4], kc[4];
          LOADKB(ka, 0); SB(); LOADKB(kc, 1); SB(); MMAKB(ka, 0); SB(); LOADKB(ka, 2); SB(); MMAKB(kc, 1); SB(); LOADKB(kc, 3); SB(); MMAKB(ka, 2); SB(); LOADKB(ka, 4); SB(); MMAKB(kc, 3); SB(); MMAKB(ka, 4); SB(); }
#undef LOADKB
#undef MMAKB
        {
        ATT_BAR();
        if (has_next) { if (!nodma) dma_k(a, nxt, lds, wid, lane); if (nxt.p != cur.p || nxt.h != cur.h) write_bias(a, nxt, lds, tid); if (!noq) load_q(qr, a, nxt, wid, r32, hi); }
        }
        const int mb = m0 - 64 + 32 * wid;
        if (mb < 0 || mb + 160 > L) {
            const int mbl = mb + 4 * hi;
#pragma unroll
            for (int kb = 0; kb < 5; ++kb)
#pragma unroll
                for (int rg = 0; rg < 16; ++rg) { const int kr0 = 32 * kb + crow(rg, 0); pS[kb][rg] = ((unsigned)(mbl + kr0) < (unsigned)L) ? pS[kb][rg] : -1e30f; }
        }
        float mx = -1e30f;
#pragma unroll
        for (int kb = 0; kb < 5; ++kb)
#pragma unroll
            for (int rg = 0; rg < 16; rg += 2) mx = fmaxf(fmaxf(mx, pS[kb][rg]), pS[kb][rg + 1]);
        mx = fmaxf(mx, __shfl_xor(mx, 32));
        float l = 0.f;
#pragma unroll
        for (int kb = 0; kb < 5; ++kb)
#pragma unroll
            for (int rg = 0; rg < 16; ++rg) { const float e = __builtin_amdgcn_exp2f(pS[kb][rg] - mx); pS[kb][rg] = e; l += e; }
        l += __shfl_xor(l, 32);
        f32x16 o[2];
        o[0] = (f32x16){0.f, 0.f, 0.f, 0.f, 0.f, 0.f, 0.f, 0.f, 0.f, 0.f, 0.f, 0.f, 0.f, 0.f, 0.f, 0.f}; o[1] = o[0];
        const LAS unsigned char* vb0 = lds + V_OFF + vb * VBUF + (4 * wid) * 1024 + (4 * hi + ((lane & 15) >> 2)) * 64 + ((lane >> 4) & 1) * 32 + (lane & 3) * 8;
#define LOADV(VF, kb) do { _Pragma("unroll") for (int s_ = 0; s_ < 2; ++s_) _Pragma("unroll") for (int d_ = 0; d_ < 2; ++d_) { \
            const s16x4 lo_ = vtr(vb0 + d_ * 512 + (2 * (kb) + s_) * 2048), hh_ = vtr(vb0 + d_ * 512 + (2 * (kb) + s_) * 2048 + 1024); \
            VF[s_ * 2 + d_] = (bf16x8){lo_[0], lo_[1], lo_[2], lo_[3], hh_[0], hh_[1], hh_[2], hh_[3]}; } } while (0)
#define MMAV(VF, kb) do { _Pragma("unroll") for (int s_ = 0; s_ < 2; ++s_) { v4u pw_; pw_.x = cvtpk(pS[kb][8 * s_ + 0], pS[kb][8 * s_ + 1]); pw_.y = cvtpk(pS[kb][8 * s_ + 2], pS[kb][8 * s_ + 3]); \
            pw_.z = cvtpk(pS[kb][8 * s_ + 4], pS[kb][8 * s_ + 5]); pw_.w = cvtpk(pS[kb][8 * s_ + 6], pS[kb][8 * s_ + 7]); const bf16x8 pa_ = __builtin_bit_cast(bf16x8, pw_); \
            _Pragma("unroll") for (int d_ = 0; d_ < 2; ++d_) o[d_] = __builtin_amdgcn_mfma_f32_32x32x16_bf16(VF[s_ * 2 + d_], pa_, o[d_], 0, 0, 0); } } while (0)
        { bf16x8 va[4], vc[4];
          LOADV(va, 0); SB(); LOADV(vc, 1); SB(); MMAV(va, 0); SB(); LOADV(va, 2); SB(); MMAV(vc, 1); SB(); LOADV(vc, 3); SB(); MMAV(va, 2); SB(); LOADV(va, 4); SB(); MMAV(vc, 3); SB(); MMAV(va, 4); SB(); }
#undef LOADV
#undef MMAV
#undef SB
        const float li = 1.f / l;
        const size_t tq = (size_t)b * SEQ + (size_t)(m0 + 32 * wid + r32) * d + r;
        {
        pl = (float*)(a.ws + WS_LSE) + (size_t)cur.p * T * 16 + tq * 16 + h; plv = mx + __builtin_amdgcn_logf(l);
        ATT_BAR();
        LAS unsigned char* stg = lds + V_OFF + vb * VBUF + wid * (32 * 144);
#pragma unroll
        for (int d0 = 0; d0 < 2; ++d0)
#pragma unroll
            for (int k = 0; k < 4; ++k)
                *(LAS v2u*)(stg + r32 * 144 + (32 * d0 + 8 * k + 4 * hi) * 2) = (v2u){cvtpk(o[d0][4 * k] * li, o[d0][4 * k + 1] * li), cvtpk(o[d0][4 * k + 2] * li, o[d0][4 * k + 3] * li)};
        LDS_WAIT();
        { const int row = lane >> 3, ch = lane & 7;
          po = (GAS unsigned char*)(a.ws + WS_OP) + ((size_t)cur.p * T + (size_t)b * SEQ + (size_t)(m0 + 32 * wid + row) * d + r) * 2048 + h * 128 + ch * 16; postep = (size_t)8 * d * 2048;
#pragma unroll
          for (int i = 0; i < 4; ++i) pov[i] = *(const LAS v4u*)(stg + (row + 8 * i) * 144 + ch * 16); }
        LDS_WAIT();
        }
        }
        vb ^= 1; cur = nxt;
    }
    { if (hi == 0) *pl = plv;
#pragma unroll
        for (int i = 0; i < 4; ++i) *(GAS v4u*)(po + i * postep) = pov[i]; }
    asm volatile("s_waitcnt vmcnt(0) lgkmcnt(0)\n\ts_barrier" ::: "memory");
}
#undef ATT_BAR
}
namespace gla {
#ifndef JIT_PREP
#define JIT_PREP 1
#endif
#ifndef JIT_LEAD
#define JIT_LEAD 8
#endif
#ifndef KSEG_
#if JIT_PREP
#define KSEG_ 128
#else
#define KSEG_ 32
#endif
#endif
constexpr int KSEG = KSEG_;
constexpr int PACK_QK = 32768, PACK_ATT = 9216;
constexpr float DKS = 0.08838834764831845f;
__device__ __forceinline__ unsigned cvtpk(float lo, float hi) { typedef float f2 __attribute__((ext_vector_type(2))); typedef __bf16 b2 __attribute__((ext_vector_type(2))); f2 v = {lo, hi}; b2 b = __builtin_convertvector(v, b2); return __builtin_bit_cast(unsigned, b); }
__device__ __forceinline__ int idx32(int g, int jj) { return 16 * (jj >> 2) + 4 * g + (jj & 3); }
__device__ __forceinline__ float fexp(float x) { return __builtin_amdgcn_exp2f(x * LOG2E); }
__device__ __forceinline__ float logsig16(float x) { return (fminf(x, 0.f) - __builtin_amdgcn_logf(1.f + fexp(-fabsf(x))) * 0.6931471805599453f) * (1.f / 16.f); }
typedef short v4i16_t __attribute__((ext_vector_type(4)));
__device__ __forceinline__ s16x4 vtr(const LAS unsigned char* p) { return __builtin_bit_cast(s16x4, __builtin_amdgcn_ds_read_tr16_b64_v4i16((LAS v4i16_t*)p)); }
constexpr int ROWB = 272  , GROW = 136  ;
constexpr int LRROW = 36  ;
constexpr int L_QT = 0, L_KT = 64 * ROWB, L_LR = 2 * 64 * ROWB, L_G = L_LR + 64 * LRROW * 4, L_GT = L_G + 2 * 64 * GROW * 4, L_TOT = L_GT + 4096, L_KBM = L_TOT + 1024  , L_PREP_END = L_KBM + 32768;
static_assert(L_PREP_END <= RING_BYTES, "prep LDS map");

struct PrepIn { v4u q[2], k[2], l; };
__device__ __forceinline__ void prep_load(const Args& a, int uid, int tid, PrepIn& in) {
    const int b = uid >> 9, h = (uid >> 7) & 3, n = uid & 127; const size_t t0 = (size_t)b * SEQ + 64 * n;
    const bf16* gq = (const bf16*)(a.ws + WS_GQ); const bf16* gk = (const bf16*)(a.ws + WS_GK); const float* lr = (const float*)(a.ws + WS_LR);
#pragma unroll
    for (int i = 0; i < 2; ++i) { const int pid = tid + 512 * i, row = pid >> 4, c16 = pid & 15; const size_t off = (t0 + row) * 512 + h * 128 + c16 * 8;
        in.q[i] = __builtin_nontemporal_load((const GAS v4u*)(gq + off)); in.k[i] = __builtin_nontemporal_load((const GAS v4u*)(gk + off)); }
    { const int row = tid >> 3, c16 = tid & 7; in.l = __builtin_nontemporal_load((const GAS v4u*)(lr + (t0 + row) * 32 + c16 * 4)); }
}
struct NoHook { __device__ __forceinline__ void operator()() const {} };
template <class Hook = NoHook> __device__ __forceinline__ void prep_unit(Frame& F, const Args& a, int uid, PrepIn& in, int next_uid, const int knobs = 0, const Hook& hook = Hook()) {
    const int b = uid >> 9, h = (uid >> 7) & 3, n = uid & 127; const size_t t0 = (size_t)b * SEQ + 64 * n;
    const bf16* gq = (const bf16*)(a.ws + WS_GQ); const bf16* gk = (const bf16*)(a.ws + WS_GK); const float* lr = (const float*)(a.ws + WS_LR);
    LAS unsigned char* lds = F.lds; const int tid = F.tid, lane = F.lane, wid = F.wave;
    float upb[2][4], bsv[2];
#pragma unroll
    for (int dir = 0; dir < 2; ++dir) { const float* up = a.in[dir ? 7 : 5] + h * 128 + 16 * wid + (lane & 15); bsv[dir] = a.in[dir ? 8 : 6][h * 128 + 16 * wid + (lane & 15)];
#pragma unroll
        for (int ks = 0; ks < 4; ++ks) upb[dir][ks] = up[(4 * ks + (lane >> 4)) * 512]; }
#pragma unroll
    for (int i = 0; i < 2; ++i) { const int pid = tid + 512 * i, row = pid >> 4, c16 = pid & 15;
        *(LAS v4u*)(lds + L_QT + row * ROWB + c16 * 16) = in.q[i]; *(LAS v4u*)(lds + L_KT + row * ROWB + c16 * 16) = in.k[i]; }
    { const int row = tid >> 3, c16 = tid & 7; *(LAS v4u*)(lds + L_LR + row * (LRROW * 4) + c16 * 16) = in.l; }
    __syncthreads();
    if (next_uid >= 0) prep_load(a, next_uid, tid, in);
    LAS float* G = (LAS float*)(lds + L_G); LAS float* TOT = (LAS float*)(lds + L_TOT); const LAS float* LR = (const LAS float*)(lds + L_LR);
    if (!(knobs & 1)) { const int li2 = lane & 15, g2 = lane >> 4, c = 16 * wid + li2;
#pragma unroll
      for (int dir = 0; dir < 2; ++dir) { f32x4 gl[4];
#pragma unroll
          for (int mt = 0; mt < 4; ++mt) { f32x4 acc = (f32x4){0.f, 0.f, 0.f, 0.f};
#pragma unroll
              for (int ks = 0; ks < 4; ++ks) acc = __builtin_amdgcn_mfma_f32_16x16x4f32(LR[(16 * mt + li2) * LRROW + dir * 16 + 4 * ks + g2], upb[dir][ks], acc, 0, 0, 0);
#pragma unroll
              for (int rg = 0; rg < 4; ++rg) gl[mt][rg] = logsig16(acc[rg] + bsv[dir]); }
          float off = 0.f;
#pragma unroll
          for (int m2 = 0; m2 < 4; ++m2) { const int mt = dir ? 3 - m2 : m2; f32x4 p; float t;
              if (!dir) { p[0] = gl[mt][0]; p[1] = p[0] + gl[mt][1]; p[2] = p[1] + gl[mt][2]; p[3] = p[2] + gl[mt][3]; t = p[3]; }
              else      { p[3] = gl[mt][3]; p[2] = p[3] + gl[mt][2]; p[1] = p[2] + gl[mt][1]; p[0] = p[1] + gl[mt][0]; t = p[0]; }
              float sc = t, u;
              if (!dir) { u = __shfl_up(sc, 16); if (g2 >= 1) sc += u; u = __shfl_up(sc, 32); if (g2 >= 2) sc += u; }
              else      { u = __shfl_down(sc, 16); if (g2 <= 2) sc += u; u = __shfl_down(sc, 32); if (g2 <= 1) sc += u; }
              const float add = sc - t + off;
#pragma unroll
              for (int rg = 0; rg < 4; ++rg) G[(dir * 64 + 16 * mt + 4 * g2 + rg) * GROW + c] = p[rg] + add;
              off += __shfl(sc, (dir ? 0 : 48) + li2); }
          if (g2 == 0) TOT[dir * 128 + c] = off; } }
    __syncthreads();
    hook();
    if (knobs & 2) { __syncthreads(); return; }
    const int dir = wid >> 2, it = wid & 3, li = lane & 15, g = lane >> 4;
    const int cid = ((b * 4 + h) * 2 + dir) * 128 + n;
    unsigned char* qk_pack = a.ws + WS_H + (size_t)cid * PACK_QK; unsigned char* att_pack = a.ws + WS_ATT + (size_t)cid * PACK_ATT;
    const LAS float* Gd = G + dir * 64 * GROW;
    auto frag = [&](int tile_off, int row, int ks, float sgn, float mul) -> bf16x8 {
        float v[8];
#pragma unroll
        for (int hf = 0; hf < 2; ++hf) { const int c = 32 * ks + 16 * hf + 4 * g;
            const v2u xw = *(const LAS v2u*)(lds + tile_off + row * ROWB + c * 2); const f32x4 bb = *(const LAS f32x4*)(Gd + row * GROW + c);
            v[4 * hf + 0] = __builtin_bit_cast(float, xw.x << 16) * fexp(sgn * bb.x) * mul; v[4 * hf + 1] = __builtin_bit_cast(float, xw.x & 0xffff0000u) * fexp(sgn * bb.y) * mul;
            v[4 * hf + 2] = __builtin_bit_cast(float, xw.y << 16) * fexp(sgn * bb.z) * mul; v[4 * hf + 3] = __builtin_bit_cast(float, xw.y & 0xffff0000u) * fexp(sgn * bb.w) * mul; }
        v4u w; w.x = cvtpk(v[0], v[1]); w.y = cvtpk(v[2], v[3]); w.z = cvtpk(v[4], v[5]); w.w = cvtpk(v[6], v[7]); return __builtin_bit_cast(bf16x8, w); };
    bf16x8 qf[4];
#pragma unroll
    for (int ks = 0; ks < 4; ++ks) { qf[ks] = frag(L_QT, 16 * it + li, ks, 1.f, DKS); *((GAS v4u*)(qk_pack + ((it * 4 + ks) * 64 + lane) * 16)) = __builtin_bit_cast(v4u, qf[ks]); }
#pragma unroll
    for (int ks = 0; ks < 4; ++ks) *(LAS v4u*)(lds + L_KBM + (((dir * 4 + it) * 4 + ks) * 64 + lane) * 16) = __builtin_bit_cast(v4u, frag(L_KT, 16 * it + li, ks, -1.f, 1.f));
    __syncthreads();
    f32x4 at[4];
#pragma unroll
    for (int jt = 0; jt < 4; ++jt) { at[jt] = (f32x4){0.f, 0.f, 0.f, 0.f};
#pragma unroll
        for (int ks = 0; ks < 4; ++ks) { const bf16x8 kf = *(const LAS bf16x8*)(lds + L_KBM + (((dir * 4 + jt) * 4 + ks) * 64 + lane) * 16); at[jt] = __builtin_amdgcn_mfma_f32_16x16x32_bf16(kf, qf[ks], at[jt], 0, 0, 0); }
#pragma unroll
        for (int rg = 0; rg < 4; ++rg) { const int j = 16 * jt + 4 * g + rg, i = 16 * it + li; const bool keep = dir ? (j >= i) : (j <= i); at[jt][rg] = keep ? at[jt][rg] : 0.f; } }
#pragma unroll
    for (int ks2 = 0; ks2 < 2; ++ks2) { v4u w; w.x = cvtpk(at[2 * ks2][0], at[2 * ks2][1]); w.y = cvtpk(at[2 * ks2][2], at[2 * ks2][3]); w.z = cvtpk(at[2 * ks2 + 1][0], at[2 * ks2 + 1][1]); w.w = cvtpk(at[2 * ks2 + 1][2], at[2 * ks2 + 1][3]);
        if (!(dir ? (it >= 2 && ks2 == 0) : (it < 2 && ks2 == 1))) *((GAS v4u*)(att_pack + ((it * 2 + ks2) * 64 + lane) * 16)) = w; }
#pragma unroll
    for (int q2 = 0; q2 < 4; ++q2) { const int ct = 2 * it + (q2 >> 1), ks2 = q2 & 1, c = 16 * ct + li; const float te = TOT[dir * 128 + c]; float v[8];
#pragma unroll
        for (int jj = 0; jj < 8; ++jj) { const int j = 32 * ks2 + idx32(g, jj); const float kx = bf2f(*(const LAS bf16*)(lds + L_KT + j * ROWB + c * 2)); v[jj] = kx * fexp(te - Gd[j * GROW + c]); }
        v4u w; w.x = cvtpk(v[0], v[1]); w.y = cvtpk(v[2], v[3]); w.z = cvtpk(v[4], v[5]); w.w = cvtpk(v[6], v[7]);
        *((GAS v4u*)(qk_pack + 16384 + ((ct * 2 + ks2) * 64 + lane) * 16)) = w; }
    if (tid < 256) { const int d2 = tid >> 7, c = tid & 127; *(float*)(a.ws + WS_ATT + (size_t)(((b * 4 + h) * 2 + d2) * 128 + n) * PACK_ATT + 8192 + c * 4) = fexp(TOT[d2 * 128 + c]); }
    __syncthreads();
}
__device__ __forceinline__ void prep_phase(Frame& F, const Args& a, int set, int c, int ncu, const int knobs = 0) {
    const int per = set == 0 ? 2 * KSEG : 128 - 2 * KSEG;
    auto uid_of = [&](int u) { const int nn = u % per, n = set == 0 ? (nn < KSEG ? nn : 128 - 2 * KSEG + nn) : KSEG + nn; return ((u / per) << 7) | n; };
    PrepIn in;
    if (c < 16 * per) prep_load(a, uid_of(c), F.tid, in);
    for (int u = c; u < 16 * per; u += ncu) prep_unit(F, a, uid_of(u), in, (u + ncu < 16 * per) ? uid_of(u + ncu) : -1, knobs);
}

__device__ __forceinline__ int uid_of_q(int q) { const int sg = q >> 5, side = (q >> 4) & 1, bh = q & 15; return (bh << 7) | (side ? 127 - sg : sg); }
template <class Pub> __device__ __forceinline__ void prep_list(Frame& F, const Args& a, int q0, int stride, int count, const Pub& pub) {
    PrepIn in;
    if (count > 0 && q0 < 2048) prep_load(a, uid_of_q(q0), F.tid, in);
    for (int k = 0; k < count; ++k) { const int q = q0 + stride * k;
        if (q < 2048) prep_unit(F, a, uid_of_q(q), in, (k + 1 < count && q + stride < 2048) ? uid_of_q(q + stride) : -1, 0, [&]() { if (k > 0) pub(k - 1); });
        else if (k > 0) pub(k - 1); }
    if (count > 0) pub(count - 1);
}

__device__ __forceinline__ void wait_bar(int n) {
    switch (n) {
        case -1: asm volatile("s_waitcnt lgkmcnt(0)\n\ts_barrier" ::: "memory"); break;
        case 10: asm volatile("s_waitcnt vmcnt(10) lgkmcnt(0)\n\ts_barrier" ::: "memory"); break;
        case 9: asm volatile("s_waitcnt vmcnt(9) lgkmcnt(0)\n\ts_barrier" ::: "memory"); break;
        case 15: asm volatile("s_waitcnt vmcnt(15) lgkmcnt(0)\n\ts_barrier" ::: "memory"); break;
        case 14: asm volatile("s_waitcnt vmcnt(14) lgkmcnt(0)\n\ts_barrier" ::: "memory"); break;
        case 13: asm volatile("s_waitcnt vmcnt(13) lgkmcnt(0)\n\ts_barrier" ::: "memory"); break;
        case 5: asm volatile("s_waitcnt vmcnt(5) lgkmcnt(0)\n\ts_barrier" ::: "memory"); break;
        case 4: asm volatile("s_waitcnt vmcnt(4) lgkmcnt(0)\n\ts_barrier" ::: "memory"); break;
        case 8: asm volatile("s_waitcnt vmcnt(8) lgkmcnt(0)\n\ts_barrier" ::: "memory"); break;
        case 7: asm volatile("s_waitcnt vmcnt(7) lgkmcnt(0)\n\ts_barrier" ::: "memory"); break;
        case 3: asm volatile("s_waitcnt vmcnt(3) lgkmcnt(0)\n\ts_barrier" ::: "memory"); break;
        case 2: asm volatile("s_waitcnt vmcnt(2) lgkmcnt(0)\n\ts_barrier" ::: "memory"); break;
        default: asm volatile("s_waitcnt vmcnt(0) lgkmcnt(0)\n\ts_barrier" ::: "memory"); break;
    }
}
constexpr int S_ATT = 0, S_DEC = 8192, S_QK = 9216, S_V = 9216 + 32768, S_BUF = S_V + 16384;
constexpr int S_O = 2 * S_BUF, OROW = 272, S_OT = 64 * OROW;
static_assert(S_O + 2 * S_OT <= RING_BYTES && (S_BUF % 1024) == 0, "scan LDS map");
struct NoPoll { __device__ __forceinline__ void operator()(int) const {} };
template <class MidFn, class PollFn = NoPoll> __device__ __forceinline__ void scan_unit(Frame& F, const Args& a, int su, const MidFn& mid, const int knobs = 0, const PollFn& poll = PollFn()) {
    (void)knobs;
    const int bh = su >> 2, dir = (su >> 1) & 1, half = su & 1, b = bh >> 2, h = bh & 3;
    const int cid0 = ((b * 4 + h) * 2 + dir) * 128;
    LAS unsigned char* lds = F.lds; const int lane = F.lane, wid = F.wave, li = lane & 15, g = lane >> 4;
    const bool comp = wid < 4; const int cw = wid & 3;
    const unsigned char* gvb = a.ws + WS_GV + (size_t)b * SEQ * 2048 + h * 512 + half * 256;
    const int ctid = cw * 64 + lane;
    unsigned char* ob = a.ws + (dir ? WS_OB : WS_OF) + (size_t)b * SEQ * 2048 + h * 512 + half * 256 + (size_t)(ctid >> 4) * 2048 + (ctid & 15) * 16;
    const int ow = (32 * cw + 4 * g) * 2 + li * OROW;
    const unsigned lds0 = (unsigned)(size_t)lds;
    int xk[10]; unsigned xvo[10], xlo[10]; int yk[5]; unsigned yvo[5], ylo[5];
#pragma unroll
    for (int j = 0; j < 10; ++j) { const int iq = cw + 4 * j;
        if (iq < 6) { const int ix = dir ? (iq < 4 ? iq : 2 * iq - 3) : (iq < 2 ? 2 * iq : iq + 2); xk[j] = 0; xvo[j] = ix * 1024 + lane * 16; xlo[j] = S_ATT + ix * 1024; }
        else if (iq < 22) { xk[j] = 1; xvo[j] = (iq - 6) * 1024 + lane * 16; xlo[j] = S_QK + (iq - 6) * 1024; }
        else if (iq < 38) { const int pv = iq - 22, row = 4 * pv + (lane >> 4), c = (lane & 15) ^ (2 * (row & 7)); xk[j] = 2; xvo[j] = row * 2048 + c * 16; xlo[j] = S_V + pv * 1024; }
        else { xk[j] = 3; xvo[j] = 0; xlo[j] = 0; } }
    const int nx = (cw < 2) ? 10 : 9;
#pragma unroll
    for (int j = 0; j < 5; ++j) { const int iy = cw + 4 * j;
        if (iy == 0) { yk[j] = 0; yvo[j] = 8 * 1024 + lane * 16; ylo[j] = S_ATT + 8 * 1024; }
        else if (iy < 17) { yk[j] = 1; yvo[j] = (16 + iy - 1) * 1024 + lane * 16; ylo[j] = S_QK + (16 + iy - 1) * 1024; }
        else { yk[j] = 3; yvo[j] = 0; ylo[j] = 0; } }
    const int ny = (cw == 0) ? 5 : 4;
    auto issue_x = [&](int n, int bufoff) {
        const int cid = cid0 + n; const unsigned char* b0 = a.ws + WS_ATT + (size_t)cid * PACK_ATT; const unsigned char* b1 = a.ws + WS_H + (size_t)cid * PACK_QK; const unsigned char* b2 = gvb + (size_t)(64 * n) * 2048;
#pragma unroll
        for (int j = 0; j < 10; ++j) { if (xk[j] == 2) glds16s<true>(b2, xvo[j], lds0 + bufoff + xlo[j]);
            else if (xk[j] != 3) glds16s<false>(xk[j] == 0 ? b0 : b1, xvo[j], lds0 + bufoff + xlo[j]); }
    };
    auto issue_y = [&](int n, int bufoff) {
        const int cid = cid0 + n; const unsigned char* b0 = a.ws + WS_ATT + (size_t)cid * PACK_ATT; const unsigned char* b1 = a.ws + WS_H + (size_t)cid * PACK_QK;
#pragma unroll
        for (int j = 0; j < 5; ++j) if (yk[j] != 3) glds16s<false>(yk[j] == 0 ? b0 : b1, yvo[j], lds0 + bufoff + ylo[j]);
    };
    f32x4 S[8][2];
#pragma unroll
    for (int ct = 0; ct < 8; ++ct) { S[ct][0] = (f32x4){0.f, 0.f, 0.f, 0.f}; S[ct][1] = S[ct][0]; }
    const int vq = li >> 2, vp = li & 3;
    int voff[2];
#pragma unroll
    for (int vt = 0; vt < 2; ++vt) voff[vt] = (4 * g + vq) * 256 + (((2 * (2 * cw + vt) + (vp >> 1)) ^ (2 * ((4 * (g & 1) + vq)))) * 16) + 8 * (vp & 1);
    { const int z0 = dir ? 4 : 1, z1 = dir ? 6 : 3;
      if (F.tid < 256) { const int q = F.tid >> 6, l = F.tid & 63; *(LAS v4u*)(lds + (q >> 1) * S_BUF + S_ATT + ((q & 1) ? z1 : z0) * 1024 + l * 16) = (v4u){0u, 0u, 0u, 0u}; } }
    __builtin_amdgcn_s_waitcnt(0);
#define SCAN_BAR() asm volatile("s_waitcnt lgkmcnt(0)\n\ts_barrier" ::: "memory")
    auto store_tile = [&](int buf, int n) __attribute__((always_inline)) {
        unsigned char* op = ob + (size_t)(64 * n) * 2048; const LAS unsigned char* ot = lds + S_O + buf * S_OT + (ctid >> 4) * OROW + (ctid & 15) * 16;
#pragma unroll
        for (int p = 0; p < 4; ++p) *(GAS v4u*)(op + (size_t)(16 * p) * 2048) = *(const LAS v4u*)(ot + 16 * p * OROW); };
    auto cstep = [&](int s, int sb) __attribute__((always_inline)) {
        const int n = dir ? 127 - s : s; const int bufoff = (s & 1) * S_BUF;
#if JIT_PREP
        { const int d_ = s + 2 - JIT_LEAD; if (cw == 0 && d_ >= 0 && d_ < 64 - JIT_LEAD && d_ % 6 == 0) poll(d_ / 6); }
#endif
        if (s > sb) store_tile((s - 1) & 1, dir ? n + 1 : n - 1);
        const LAS unsigned char* B = lds + bufoff;
        bf16x8 vf[2][2];
#pragma unroll
        for (int vt = 0; vt < 2; ++vt)
#pragma unroll
            for (int ks2 = 0; ks2 < 2; ++ks2) { const s16x4 lo = vtr(B + S_V + voff[vt] + ks2 * 8192), hh = vtr(B + S_V + voff[vt] + ks2 * 8192 + 4096); vf[vt][ks2] = (bf16x8){lo[0], lo[1], lo[2], lo[3], hh[0], hh[1], hh[2], hh[3]}; }
        bf16x8 sf[2][4];
#pragma unroll
        for (int vt = 0; vt < 2; ++vt)
#pragma unroll
            for (int ks = 0; ks < 4; ++ks) { v4u w; w.x = cvtpk(S[2 * ks][vt][0], S[2 * ks][vt][1]); w.y = cvtpk(S[2 * ks][vt][2], S[2 * ks][vt][3]); w.z = cvtpk(S[2 * ks + 1][vt][0], S[2 * ks + 1][vt][1]); w.w = cvtpk(S[2 * ks + 1][vt][2], S[2 * ks + 1][vt][3]); sf[vt][ks] = __builtin_bit_cast(bf16x8, w); }
#define SB() __builtin_amdgcn_sched_barrier(0)
#define LOADO(D, mt) do { _Pragma("unroll") for (int k_ = 0; k_ < 4; ++k_) D[k_] = *(const LAS bf16x8*)(B + S_QK + (((mt) * 4 + k_) * 64 + lane) * 16); \
                          _Pragma("unroll") for (int k_ = 0; k_ < 2; ++k_) D[4 + k_] = *(const LAS bf16x8*)(B + S_ATT + (((mt) * 2 + k_) * 64 + lane) * 16); } while (0)
#define MMAO(D, mt) do { f32x4 o0_ = (f32x4){0.f, 0.f, 0.f, 0.f}, o1_ = o0_; \
                         _Pragma("unroll") for (int k_ = 0; k_ < 4; ++k_) { o0_ = __builtin_amdgcn_mfma_f32_16x16x32_bf16(sf[0][k_], D[k_], o0_, 0, 0, 0); o1_ = __builtin_amdgcn_mfma_f32_16x16x32_bf16(sf[1][k_], D[k_], o1_, 0, 0, 0); } \
                         _Pragma("unroll") for (int k_ = 0; k_ < 2; ++k_) { o0_ = __builtin_amdgcn_mfma_f32_16x16x32_bf16(vf[0][k_], D[4 + k_], o0_, 0, 0, 0); o1_ = __builtin_amdgcn_mfma_f32_16x16x32_bf16(vf[1][k_], D[4 + k_], o1_, 0, 0, 0); } \
                         *(LAS v2u*)(otile + (16 * (mt)) * OROW) = (v2u){cvtpk(o0_[0], o0_[1]), cvtpk(o0_[2], o0_[3])}; *(LAS v2u*)(otile + 32 + (16 * (mt)) * OROW) = (v2u){cvtpk(o1_[0], o1_[1]), cvtpk(o1_[2], o1_[3])}; } while (0)
#define LOADS(D, V, c2) do { _Pragma("unroll") for (int k_ = 0; k_ < 4; ++k_) D[k_] = *(const LAS bf16x8*)(B + S_QK + 16384 + (((c2) * 4 + k_) * 64 + lane) * 16); \
                             V[0] = *(const LAS f32x4*)(B + S_DEC + (32 * (c2) + 4 * g) * 4); V[1] = *(const LAS f32x4*)(B + S_DEC + (32 * (c2) + 16 + 4 * g) * 4); } while (0)
#define MMAS(D, V, c2) do { _Pragma("unroll") for (int t_ = 0; t_ < 2; ++t_) { S[2 * (c2) + t_][0] = S[2 * (c2) + t_][0] * V[t_]; S[2 * (c2) + t_][1] = S[2 * (c2) + t_][1] * V[t_]; \
                            _Pragma("unroll") for (int k_ = 0; k_ < 2; ++k_) { S[2 * (c2) + t_][0] = __builtin_amdgcn_mfma_f32_16x16x32_bf16(D[2 * t_ + k_], vf[0][k_], S[2 * (c2) + t_][0], 0, 0, 0); \
                                                                               S[2 * (c2) + t_][1] = __builtin_amdgcn_mfma_f32_16x16x32_bf16(D[2 * t_ + k_], vf[1][k_], S[2 * (c2) + t_][1], 0, 0, 0); } } } while (0)
        LAS unsigned char* otile = lds + S_O + (s & 1) * S_OT + ow;
        bf16x8 fa[6], fb[6]; f32x4 da[2], db[2];
        LOADO(fa, 0); SB(); LOADO(fb, 1); SB(); MMAO(fa, 0); SB(); LOADO(fa, 2); SB(); MMAO(fb, 1); SB(); LOADO(fb, 3); SB(); MMAO(fa, 2); SB();
        MMAO(fb, 3); SB();
        SCAN_BAR();
        SB(); LOADS(fa, da, 0); SB(); LOADS(fb, db, 1); SB(); MMAS(fa, da, 0); SB(); LOADS(fa, da, 2); SB(); MMAS(fb, db, 1); SB(); LOADS(fb, db, 3); SB(); MMAS(fa, da, 2); SB(); MMAS(fb, db, 3); SB();
#undef LOADO
#undef MMAO
#undef LOADS
#undef MMAS
#undef SB
        SCAN_BAR();
    };
    auto lstep = [&](int s, int sb, int se) __attribute__((always_inline)) {
        const int bufoff = (s & 1) * S_BUF;
        if (s + 1 < se) issue_y(dir ? 126 - s : s + 1, S_BUF - bufoff);
        wait_bar(s + 1 < se ? nx + ny : 0);
        if (s + 2 < se) issue_x(dir ? 125 - s : s + 2, bufoff);
        wait_bar((s + 1 < se ? ny : 0) + (s + 2 < se ? nx : 0));
    };
    for (int seg = 0; seg < 2; ++seg) { const int sb = seg ? KSEG : 0, se = seg ? 128 : KSEG;
        if (sb < se) {
        asm volatile("s_waitcnt vmcnt(0) lgkmcnt(0)\n\ts_barrier" ::: "memory");
        if (!comp) { issue_x(dir ? 127 - sb : sb, (sb & 1) * S_BUF); issue_y(dir ? 127 - sb : sb, (sb & 1) * S_BUF);
            if (sb + 1 < se) issue_x(dir ? 126 - sb : sb + 1, S_BUF - (sb & 1) * S_BUF); }
        asm volatile("s_waitcnt vmcnt(0) lgkmcnt(0)\n\ts_barrier" ::: "memory");
        if (comp) { for (int s = sb; s < se; ++s) cstep(s, sb);
            store_tile((se - 1) & 1, dir ? 128 - se : se - 1); }
        else for (int s = sb; s < se; ++s) lstep(s, sb, se);
        asm volatile("s_waitcnt vmcnt(0)" ::: "memory");
        }
        if (seg == 0) mid();
    }
#undef SCAN_BAR
}
}
#ifndef P2_ALIGN
#define P2_ALIGN true
#endif
#ifndef P6_ALIGN
#define P6_ALIGN true
#endif
#ifndef P6_AUXA
#define P6_AUXA 0
#endif
#ifndef P2_AUXA
#define P2_AUXA 0
#endif
#ifndef P2_AUXB
#define P2_AUXB 0
#endif
__global__ void __launch_bounds__(NWAVES * 64, 2) mega(Args args) {
    extern __shared__ __attribute__((aligned(16))) unsigned char lds[];
    Frame F;
    F.lds = (LAS unsigned char*)lds; F.MISC = (volatile LAS unsigned*)(F.lds + MISC_OFF);
    F.tid = threadIdx.x; F.lane = F.tid & 63; F.wave = __builtin_amdgcn_readfirstlane(F.tid >> 6);
    F.G = gridDim.x; { const int bx = blockIdx.x; F.vcu = (F.G % 8 == 0) ? (bx % 8) * (F.G / 8) + bx / 8 : bx; }
    unsigned char* ws = args.ws;
    F.ctl = (gu32*)(ws + WS_CTL);
    for (int u = F.tid; u < (LDS_BYTES - LDSCTL_OFF) / 4; u += NWAVES * 64) ((LAS unsigned*)(F.lds + LDSCTL_OFF))[u] = 0u;
    __syncthreads();
    XcdBarrier bar = xcd_barrier_post((unsigned*)(F.ctl + CW_BAR) + args.li * XCD_BAR_WORDS, F.MISC + 8);
    if (F.tid == 0 && (F.vcu & 3) != 0) (void)xb_add((unsigned*)(F.ctl + CW_P4CEN) + bar.x * 64, 1u);
    const int lo = args.ph_lo, hi = args.ph_hi;
#define IN(k) (lo <= (k) && (k) < hi)
#define BOTH(k) (IN(k) && IN((k) + 1))
    ProjOut P{(bf16*)(ws + WS_AQ), (bf16*)(ws + WS_AK), (bf16*)(ws + WS_AV), (bf16*)(ws + WS_SAG), (bf16*)(ws + WS_GQ), (bf16*)(ws + WS_GK), (bf16*)(ws + WS_GV), (bf16*)(ws + WS_SGG), (float*)(ws + WS_LR)};
    if (IN(0)) { p0_mod(F, args);
        if (F.vcu < 192) { asm volatile("s_waitcnt vmcnt(0)" ::: "memory"); __syncthreads(); if (F.tid == 0) (void)xb_add((unsigned*)(F.ctl + CW_MODRDY) + args.li * 64, 1u); } }
    if (IN(1)) { p1_weights(F, args);
        if (F.tid == 0) { unsigned* cnt = (unsigned*)(F.ctl + CW_MODRDY) + args.li * 64; XB_SPIN(xb_ld(cnt) < 192u, bar.bar); __builtin_amdgcn_fence(__ATOMIC_ACQUIRE, "agent"); asm volatile("s_waitcnt vmcnt(0)" ::: "memory"); }
        __syncthreads();
        p1_h(F, args); if (BOTH(1)) xcd_barrier(bar); }
    if (IN(2)) {
        pg8::Gemm g{(const bf16*)(ws + WS_H), (const bf16*)(ws + WS_WINT), T, 7168, DM}; pg8::StaticOrder S; S.init(T, 7168, F.G, (int)blockIdx.x);
#ifdef P2_WGM
        S.wgm = P2_WGM;
#endif
#ifdef PROBE_G2
        S.reps = 2;
#endif
        pg8::EpiProj E{P};
        pg8::gemm_phase<pg8::EpiProj, pg8::StaticOrder, P2_ALIGN, true, P2_AUXA, P2_AUXB>(F.lds + RING_OFF, g, S, E);
        lr_tail(F, args);
        if (BOTH(2)) xcd_barrier(bar);
    }
#if JIT_PREP
    if (IN(3)) {
        gla::prep_list(F, args, F.vcu, 256, JIT_LEAD / 8, [&](int) {});
        asm volatile("s_waitcnt vmcnt(0)" ::: "memory"); __syncthreads();
        unsigned* c3 = (unsigned*)(F.ctl + CW_P3CNT) + args.li * 64;
        if (F.tid == 0) { __builtin_amdgcn_s_waitcnt(0);
            const unsigned nmine = xb_ld(&bar.bar[XB_XCNT(bar.x)]);
            const unsigned old = xb_add((unsigned*)(F.ctl + CW_P3ARR) + bar.x * 64, 1u);
            if (old + 1u == nmine) { __builtin_amdgcn_fence(__ATOMIC_RELEASE, "agent"); asm volatile("s_waitcnt vmcnt(0)" ::: "memory"); (void)xb_add(c3, nmine); }
            if ((F.vcu & 3) == 0) { XB_SPIN(xb_ld(c3) < (unsigned)F.G, bar.bar); __builtin_amdgcn_fence(__ATOMIC_ACQUIRE, "agent"); asm volatile("s_waitcnt vmcnt(0)" ::: "memory"); } }
        __syncthreads(); }
    if (IN(4)) {
        const int ac = (F.vcu >> 2) * 3 + (F.vcu & 3) - 1, anc = (F.G >> 2) * 3;
        if ((F.vcu & 3) == 0) gla::scan_unit(F, args, F.vcu >> 2, [&]() {}, 0, [&](int j) {
            if (F.lane == 0) { unsigned* pj = (unsigned*)(F.ctl + CW_PUB) + j * 2048 + 1024; XB_SPIN(xb_ld(pj) < (unsigned)anc, bar.bar); }
            __builtin_amdgcn_fence(__ATOMIC_ACQUIRE, "agent"); asm volatile("s_waitcnt vmcnt(0)" ::: "memory"); });
        else {
            gla::prep_list(F, args, 32 * JIT_LEAD + ac, anc, (2048 - 32 * JIT_LEAD + 191) / 192, [&](int k) {
                asm volatile("s_waitcnt vmcnt(0)" ::: "memory"); __syncthreads();
                if (F.tid == 0) { __builtin_amdgcn_s_waitcnt(0);
                    const unsigned nmine = xb_ld((unsigned*)(F.ctl + CW_P4CEN) + bar.x * 64);
                    const unsigned old = xb_add((unsigned*)(F.ctl + CW_PUB) + k * 2048 + bar.x * 64, 1u);
                    if (old + 1u == nmine) { __builtin_amdgcn_fence(__ATOMIC_RELEASE, "agent"); asm volatile("s_waitcnt vmcnt(0)" ::: "memory"); (void)xb_add((unsigned*)(F.ctl + CW_PUB) + k * 2048 + 1024, nmine); } } });
            att::attn_phase(F, args, ac, anc);
            p1_wout(F, args, ac, anc);
        }
#else
    if (IN(3)) {
#ifdef PROBE_P
        { int q = F.vcu; asm volatile("" : "+s"(q)); gla::prep_phase(F, args, 0, q, F.G, PROBE_P); }
#endif
        gla::prep_phase(F, args, 0, F.vcu, F.G);
        if (BOTH(3)) {
            asm volatile("s_waitcnt vmcnt(0)" ::: "memory"); __syncthreads();
            unsigned* c3 = (unsigned*)(F.ctl + CW_P3CNT) + args.li * 64;
            if (F.tid == 0) { __builtin_amdgcn_s_waitcnt(0);
                const unsigned nmine = xb_ld(&bar.bar[XB_XCNT(bar.x)]);
                const unsigned old = xb_add((unsigned*)(F.ctl + CW_P3ARR) + bar.x * 64, 1u);
                if (old + 1u == nmine) { __builtin_amdgcn_fence(__ATOMIC_RELEASE, "agent"); asm volatile("s_waitcnt vmcnt(0)" ::: "memory"); (void)xb_add(c3, nmine); }
                if ((F.vcu & 3) == 0) { XB_SPIN(xb_ld(c3) < (unsigned)F.G, bar.bar); __builtin_amdgcn_fence(__ATOMIC_ACQUIRE, "agent"); asm volatile("s_waitcnt vmcnt(0)" ::: "memory"); } }
            __syncthreads(); } }
    if (IN(4)) {
        const int ac = (F.vcu >> 2) * 3 + (F.vcu & 3) - 1, anc = (F.G >> 2) * 3;
#ifdef PROBE_S
        if ((F.vcu & 3) == 0) { int q = F.vcu >> 2; asm volatile("" : "+s"(q)); gla::scan_unit(F, args, q, [&]() {}, PROBE_S); }
#endif
        unsigned* p4cnt = (unsigned*)(F.ctl + CW_P4PUB) + args.li * 64;
        if ((F.vcu & 3) == 0) gla::scan_unit(F, args, F.vcu >> 2, [&]() {
            if (F.tid == 0) { XB_SPIN(xb_ld(p4cnt) < (unsigned)anc, bar.bar); __builtin_amdgcn_fence(__ATOMIC_ACQUIRE, "agent"); asm volatile("s_waitcnt vmcnt(0)" ::: "memory"); }
            __syncthreads(); });
        else { gla::prep_phase(F, args, 1, ac, anc);
            asm volatile("s_waitcnt vmcnt(0)" ::: "memory"); __syncthreads();
            if (F.tid == 0) { __builtin_amdgcn_s_waitcnt(0);
                const unsigned nmine = xb_ld((unsigned*)(F.ctl + CW_P4CEN) + bar.x * 64);
                const unsigned old = xb_add((unsigned*)(F.ctl + CW_P4ARR) + bar.x * 64, 1u);
                if (old + 1u == nmine) { __builtin_amdgcn_fence(__ATOMIC_RELEASE, "agent"); asm volatile("s_waitcnt vmcnt(0)" ::: "memory"); (void)xb_add(p4cnt, nmine); } }
#ifdef PROBE_A2
            { int q = ac; asm volatile("" : "+s"(q)); att::attn_phase(F, args, q, anc, PROBE_A2); }
#endif
            att::attn_phase(F, args, ac, anc);
            p1_wout(F, args, ac, anc);
        }
#endif
        if (BOTH(4)) xcd_barrier(bar); }
    if (IN(5)) { p5_combine(F, args); if (BOTH(5)) xcd_barrier(bar); }
    if (IN(6)) {
        pg8::Gemm g{(const bf16*)(ws + WS_H), (const bf16*)(ws + WS_WOUTT), T, DM, DM}; pg8::StaticOrder S; S.init(T, DM, F.G, (int)blockIdx.x);
        S.wgm = 4;
#ifdef PROBE_G6
        S.reps = 2;
#endif
        pg8::EpiY E{(bf16*)(ws + WS_Y)};
        pg8::gemm_phase<pg8::EpiY, pg8::StaticOrder, P6_ALIGN, true, P6_AUXA, 0>(F.lds + RING_OFF, g, S, E);
        if (BOTH(6)) xcd_barrier(bar);
    }
    if (IN(7)) { p7_final(F, args); }
#undef IN
#undef BOTH
}
extern "C" void kernel_launch(void* const* d_in, const int* in_sizes, int n_in, void* d_out, int out_size, void* d_ws, size_t ws_size, hipStream_t stream) {
    static int grid = 0;
    if (grid == 0) {
        if (n_in != 13 || ws_size < WS_END || out_size != T * DM) { fprintf(stderr, "kernel_launch: unexpected problem (n_in %d, ws %zu, out %d)\n", n_in, ws_size, out_size); grid = -1; return; }
        int dev = 0, cus = 0, per_cu = 0;
        if (hipGetDevice(&dev) != hipSuccess || hipDeviceGetAttribute(&cus, hipDeviceAttributeMultiprocessorCount, dev) != hipSuccess) { grid = -1; return; }
        if (hipFuncSetAttribute((const void*)mega, hipFuncAttributeMaxDynamicSharedMemorySize, LDS_BYTES) != hipSuccess) { fprintf(stderr, "kernel_launch: hipFuncSetAttribute failed\n"); grid = -1; return; }
        if (hipOccupancyMaxActiveBlocksPerMultiprocessor(&per_cu, (const void*)mega, NWAVES * 64, LDS_BYTES) != hipSuccess || per_cu < 1) { fprintf(stderr, "kernel_launch: occupancy query says %d\n", per_cu); }
        (void)hipGetLastError();
        grid = cus;
    }
    if (grid < 0) return;
    (void)hipMemsetAsync((char*)d_ws + WS_CTL, 0, CTL_ZERO_BYTES, stream);
    Args a{};
    for (int i = 0; i < 13; ++i) a.in[i] = (const float*)d_in[i];
    a.out = (float*)d_out; a.ws = (unsigned char*)d_ws;
    unsigned char* ws = (unsigned char*)d_ws;
#ifndef PROBE_DUP
#define PROBE_DUP -1
#endif
#ifndef PROBE_REPS
#define PROBE_REPS 2
#endif
#ifndef PROBE_SUB
#define PROBE_SUB 2
#endif
    a.ph_lo = 0; a.ph_hi = 8; a.li = 0; a.dup_phase = PROBE_DUP; a.dup_reps = PROBE_REPS; a.dup_sub = PROBE_SUB;
    hipLaunchKernelGGL(mega, dim3(grid), dim3(NWAVES * 64), LDS_BYTES, stream, a);
}
```
